# Optimizing an MI355X kernel written in HIP

```python
import math
import jax
import jax.numpy as jnp
from jax import lax
import numpy as np

D_MODEL = 2048
BATCH = 4
SEQ = 2048
DEPTH = 2

HEAD_DIM = 64
Q_BLOCK = 128
NEG_INF = -1e30
EPS = 1e-6

NSA_HEADS = 8
NSA_KV_HEADS = 2
NSA_GQA = NSA_HEADS // NSA_KV_HEADS
NSA_WIDTH = NSA_HEADS * HEAD_DIM
CMP_BLOCK = 32
CMP_STRIDE = 16
SEL_BLOCK = 64
SEL_TOPK = 8
FORCE_SCORE = 1e3
WINDOW = 512

SB_HEADS = 8
SB_WIDTH = SB_HEADS * HEAD_DIM

SSD_HEADS = 16
SSD_HEAD_DIM = 64
SSD_INNER = SSD_HEADS * SSD_HEAD_DIM
SSD_GROUPS = 2
SSD_HEADS_PER_GROUP = SSD_HEADS // SSD_GROUPS
SSD_STATE = 128
SSD_CONV = 4
SSD_CHUNK = 128
SSD_CONV_DIM = SSD_INNER + 2 * SSD_GROUPS * SSD_STATE

D_MIX = NSA_WIDTH + SB_WIDTH + SSD_INNER

D_FF = 5632

REL_BUCKETS = 32
REL_MAX_DIST = 128

IN_COLS = (NSA_WIDTH,
           3 * 2 * NSA_KV_HEADS * HEAD_DIM,
           3 * NSA_HEADS,
           3 * SB_WIDTH,
           SSD_INNER,
           SSD_CONV_DIM,
           SSD_HEADS)
D_IN_PROJ = sum(IN_COLS)

kernel_name = 'hybrid_nsa_stickbreak_ssd_macaron'


def rmsnorm(x, g):
    xf = x.astype(jnp.float32)
    y = xf * lax.rsqrt(jnp.mean(xf * xf, axis=-1, keepdims=True) + EPS)
    return (y * g.astype(jnp.float32)).astype(x.dtype)


def swiglu(x, w_gate, w_up, w_down):
    return (jax.nn.silu(x @ w_gate) * (x @ w_up)) @ w_down


def rel_bucket(dist):
    dist = jnp.maximum(dist, 0)
    max_exact = REL_BUCKETS // 2
    log_ratio = jnp.log(jnp.maximum(dist, 1).astype(jnp.float32) / max_exact) / math.log(REL_MAX_DIST / max_exact)
    large = jnp.minimum(max_exact + (log_ratio * (REL_BUCKETS - max_exact)).astype(jnp.int32), REL_BUCKETS - 1)
    return jnp.where(dist < max_exact, dist, large)


def compress_blocks(u, pos, w):
    B_, T, Hk, D = u.shape
    n_cmp = (T - CMP_BLOCK) // CMP_STRIDE + 1
    idx = jnp.arange(n_cmp)[:, None] * CMP_STRIDE + jnp.arange(CMP_BLOCK)[None, :]
    blk = u[:, idx] + pos[:, None, :]
    blk = blk.transpose(0, 1, 3, 2, 4).reshape(B_, n_cmp, Hk, CMP_BLOCK * D)
    return blk @ w


def native_sparse_attention(q, kv, gate_logits, cmp_pos, cmp_w, rel_bias):
    B_, T, _, D = q.shape
    Hk, G = NSA_KV_HEADS, NSA_GQA
    scale = D ** -0.5
    n_qb = T // Q_BLOCK
    t_pos = jnp.arange(T)
    qg = q.reshape(B_, T, Hk, G, D)
    bias_tab = rel_bias.reshape(REL_BUCKETS, Hk, G)

    k_cmp = compress_blocks(kv[:, :, 0, 0], cmp_pos[0], cmp_w[0])
    v_cmp = compress_blocks(kv[:, :, 0, 1], cmp_pos[1], cmp_w[1])
    n_cmp = k_cmp.shape[1]
    cmp_start = jnp.arange(n_cmp) * CMP_STRIDE
    cmp_end = cmp_start + CMP_BLOCK - 1
    dist_c = t_pos[:, None] - cmp_end[None, :]
    valid_c = dist_c >= 0
    bias_c = bias_tab[rel_bucket(dist_c)].transpose(2, 3, 0, 1)
    s_c = jnp.einsum('bthgd,bchd->bhgtc', qg, k_cmp, preferred_element_type=jnp.float32) * scale
    p_c = jax.nn.softmax(jnp.where(valid_c, s_c + bias_c, NEG_INF), axis=-1)
    p_c = jnp.where(jnp.any(valid_c, axis=-1)[:, None], p_c, 0.0)
    o_cmp = jnp.einsum('bhgtc,bchd->bthgd', p_c.astype(v_cmp.dtype), v_cmp)

    n_sel = T // SEL_BLOCK
    top_k = min(SEL_TOPK, n_sel)
    sel_start = jnp.arange(n_sel) * SEL_BLOCK
    overlap = jnp.maximum(jnp.minimum(cmp_end[:, None], sel_start[None, :] + SEL_BLOCK - 1)
                          - jnp.maximum(cmp_start[:, None], sel_start[None, :]) + 1, 0).astype(jnp.float32) / CMP_BLOCK
    p_sel = jnp.einsum('bhgtc,cj->bhtj', p_c, overlap)
    cur = t_pos // SEL_BLOCK
    jj = jnp.arange(n_sel)[None, :]
    eligible = sel_start[None, :] <= t_pos[:, None]
    forced = (jj == 0) | (jj == cur[:, None]) | (jj == cur[:, None] - 1)
    score = jnp.where(eligible, p_sel + FORCE_SCORE * forced.astype(jnp.float32), NEG_INF)
    top_val, top_idx = lax.top_k(score, top_k)
    top_ok = top_val > 0.5 * NEG_INF

    k_sel = kv[:, :, 1, 0].transpose(0, 2, 1, 3).reshape(B_, Hk, n_sel, SEL_BLOCK, D)
    v_sel = kv[:, :, 1, 1].transpose(0, 2, 1, 3).reshape(B_, Hk, n_sel, SEL_BLOCK, D)
    b_ix = jnp.arange(B_)[:, None, None, None]
    h_ix = jnp.arange(Hk)[None, :, None, None]

    def sel_block(args):
        q_blk, idx_blk, ok_blk, i = args
        k_g = k_sel[b_ix, h_ix, idx_blk]
        v_g = v_sel[b_ix, h_ix, idx_blk]
        t_q = i * Q_BLOCK + jnp.arange(Q_BLOCK)
        key_pos = idx_blk[..., None] * SEL_BLOCK + jnp.arange(SEL_BLOCK)
        dist = t_q[:, None, None] - key_pos
        ok = (dist >= 0) & ok_blk[..., None]
        bias = bias_tab[rel_bucket(dist), h_ix[..., None]].transpose(0, 1, 5, 2, 3, 4)
        s = jnp.einsum('bhgqd,bhqkld->bhgqkl', q_blk, k_g, preferred_element_type=jnp.float32) * scale
        s = jnp.where(ok[:, :, None], s + bias, NEG_INF).reshape(B_, Hk, G, Q_BLOCK, top_k * SEL_BLOCK)
        p = jax.nn.softmax(s, axis=-1).reshape(B_, Hk, G, Q_BLOCK, top_k, SEL_BLOCK)
        return jnp.einsum('bhgqkl,bhqkld->bqhgd', p.astype(v_g.dtype), v_g)

    q_chunks = qg.reshape(B_, n_qb, Q_BLOCK, Hk, G, D).transpose(1, 0, 3, 4, 2, 5)
    idx_chunks = top_idx.reshape(B_, Hk, n_qb, Q_BLOCK, top_k).transpose(2, 0, 1, 3, 4)
    ok_chunks = top_ok.reshape(B_, Hk, n_qb, Q_BLOCK, top_k).transpose(2, 0, 1, 3, 4)
    o_sel = lax.map(sel_block, (q_chunks, idx_chunks, ok_chunks, jnp.arange(n_qb)))
    o_sel = o_sel.transpose(1, 0, 2, 3, 4, 5).reshape(B_, T, Hk, G, D)

    n_wb = WINDOW // Q_BLOCK

    def band(u):
        up = jnp.pad(u, ((0, 0), (WINDOW, 0), (0, 0), (0, 0)))
        ub = up.reshape(B_, n_qb + n_wb, Q_BLOCK, Hk, D)
        return jnp.concatenate([ub[:, j:j + n_qb] for j in range(n_wb + 1)], axis=2)

    k_win = band(kv[:, :, 2, 0])
    v_win = band(kv[:, :, 2, 1])
    r_ix = jnp.arange(Q_BLOCK)
    m_ix = jnp.arange(WINDOW + Q_BLOCK)
    dist_w = WINDOW + r_ix[:, None] - m_ix[None, :]
    key_pos_w = jnp.arange(n_qb)[:, None] * Q_BLOCK - WINDOW + m_ix[None, :]
    ok_w = (dist_w >= 0) & (dist_w < WINDOW) & (key_pos_w >= 0)[:, None, :]
    bias_w = bias_tab[rel_bucket(dist_w)].transpose(2, 3, 0, 1)[:, :, None]
    q_w = qg.reshape(B_, n_qb, Q_BLOCK, Hk, G, D)
    s_w = jnp.einsum('bnqhgd,bnmhd->bhgnqm', q_w, k_win, preferred_element_type=jnp.float32) * scale
    p_w = jax.nn.softmax(jnp.where(ok_w, s_w + bias_w, NEG_INF), axis=-1)
    o_win = jnp.einsum('bhgnqm,bnmhd->bnqhgd', p_w.astype(v_win.dtype), v_win).reshape(B_, T, Hk, G, D)

    g = jax.nn.sigmoid(gate_logits.astype(jnp.float32)).reshape(B_, T, Hk, G, 3)
    o = g[..., 0:1] * o_cmp + g[..., 1:2] * o_sel + g[..., 2:3] * o_win
    return o.reshape(B_, T, NSA_WIDTH).astype(q.dtype)


def stick_breaking_attention(q, k, v):
    B_, T, H, D = q.shape
    n_qb = T // Q_BLOCK
    scale = D ** -0.5
    key_pos = jnp.arange(T)
    q_chunks = q.reshape(B_, n_qb, Q_BLOCK, H, D).transpose(1, 0, 2, 3, 4)

    def block(args):
        q_blk, i = args
        z = jnp.einsum('bqhd,bshd->bhqs', q_blk, k, preferred_element_type=jnp.float32) * scale
        t_q = i * Q_BLOCK + jnp.arange(Q_BLOCK)
        mask = key_pos[None, :] < t_q[:, None]
        log_not = jnp.where(mask, jax.nn.log_sigmoid(-z), 0.0)
        between = lax.cumsum(log_not, axis=3, reverse=True) - log_not
        a = jnp.where(mask, jnp.exp(jax.nn.log_sigmoid(z) + between), 0.0)
        return jnp.einsum('bhqs,bshd->bqhd', a.astype(v.dtype), v)

    out = lax.map(block, (q_chunks, jnp.arange(n_qb)))
    return out.transpose(1, 0, 2, 3, 4).reshape(B_, T, H * D)


def causal_depthwise_conv(u, w, b):
    out = lax.conv_general_dilated(u, w[:, None, :], window_strides=(1,), padding=[(SSD_CONV - 1, 0)],
                                   dimension_numbers=('NWC', 'WIO', 'NWC'), feature_group_count=u.shape[-1])
    return out + b


def ssd_chunked_scan(x, a_dt, bm, cm):
    B_, T, G, E, P = x.shape
    N = bm.shape[-1]
    nc, L = T // SSD_CHUNK, SSD_CHUNK
    xc = x.reshape(B_, nc, L, G, E, P)
    bc = bm.reshape(B_, nc, L, G, N)
    cc = cm.reshape(B_, nc, L, G, N)
    a_cs = jnp.cumsum(a_dt.reshape(B_, nc, L, G, E).transpose(0, 3, 4, 1, 2), axis=-1)
    li = jnp.arange(L)
    causal = li[:, None] >= li[None, :]
    seg = jnp.exp(jnp.where(causal, a_cs[..., :, None] - a_cs[..., None, :], -jnp.inf))
    cb = jnp.einsum('bclgn,bcsgn->bgcls', cc, bc)
    y_diag = jnp.einsum('bgcls,bgecls,bcsgep->bclgep', cb, seg, xc)
    decay_to_end = jnp.exp(a_cs[..., -1:] - a_cs)
    chunk_states = jnp.einsum('bclgn,bgecl,bclgep->bcgepn', bc, decay_to_end, xc)
    chunk_decay = jnp.exp(a_cs[..., -1])

    def step(h, inp):
        st, dec = inp
        return h * dec[..., None, None] + st, h

    h0 = jnp.zeros((B_, G, E, P, N), chunk_states.dtype)
    _, h_in = lax.scan(step, h0, (chunk_states.transpose(1, 0, 2, 3, 4, 5), chunk_decay.transpose(3, 0, 1, 2)))
    h_in = h_in.transpose(1, 0, 2, 3, 4, 5)
    y_off = jnp.einsum('bclgn,bcgepn,bgecl->bclgep', cc, h_in, jnp.exp(a_cs))
    return (y_diag + y_off).reshape(B_, T, G, E, P)


def mamba2_ssd(z, xbc, dt, conv_w, conv_b, dt_bias, a_log, d_skip, norm_g):
    B_, T, _ = xbc.shape
    G, E, P, N = SSD_GROUPS, SSD_HEADS_PER_GROUP, SSD_HEAD_DIM, SSD_STATE
    xbc = jax.nn.silu(causal_depthwise_conv(xbc, conv_w, conv_b))
    xs, bm, cm = jnp.split(xbc, [SSD_INNER, SSD_INNER + G * N], axis=-1)
    xs = xs.reshape(B_, T, G, E, P).astype(jnp.float32)
    bm = bm.reshape(B_, T, G, N).astype(jnp.float32)
    cm = cm.reshape(B_, T, G, N).astype(jnp.float32)
    dt = jax.nn.softplus(dt.astype(jnp.float32) + dt_bias.astype(jnp.float32)).reshape(B_, T, G, E)
    a = -jnp.exp(a_log.astype(jnp.float32)).reshape(G, E)
    y = ssd_chunked_scan(xs * dt[..., None], dt * a, bm, cm)
    y = y + d_skip.astype(jnp.float32).reshape(G, E)[:, :, None] * xs
    y = y.reshape(B_, T, SSD_INNER) * jax.nn.silu(z.astype(jnp.float32))
    yg = y.reshape(B_, T, G, SSD_INNER // G)
    yg = yg * lax.rsqrt(jnp.mean(yg * yg, axis=-1, keepdims=True) + EPS)
    return (yg.reshape(B_, T, SSD_INNER) * norm_g.astype(jnp.float32)).astype(z.dtype)


def hybrid_mixer(h, rel_bias, w_in, w_out, cmp_pos, cmp_w, nsa_norm, sb_norm,
                 conv_w, conv_b, dt_bias, a_log, d_skip, ssd_norm):
    B_, T, _ = h.shape
    cuts = np.cumsum(IN_COLS)[:-1].tolist()
    nsa_q, nsa_kv, nsa_gate, sb_qkv, ssd_z, ssd_xbc, ssd_dt = jnp.split(h @ w_in, cuts, axis=-1)
    o_nsa = native_sparse_attention(nsa_q.reshape(B_, T, NSA_HEADS, HEAD_DIM),
                                    nsa_kv.reshape(B_, T, 3, 2, NSA_KV_HEADS, HEAD_DIM),
                                    nsa_gate.reshape(B_, T, NSA_HEADS, 3), cmp_pos, cmp_w, rel_bias)
    sb = sb_qkv.reshape(B_, T, 3, SB_HEADS, HEAD_DIM)
    o_sb = stick_breaking_attention(sb[:, :, 0], sb[:, :, 1], sb[:, :, 2])
    o_ssd = mamba2_ssd(ssd_z, ssd_xbc, ssd_dt, conv_w, conv_b, dt_bias, a_log, d_skip, ssd_norm)
    mixed = jnp.concatenate([rmsnorm(o_nsa, nsa_norm), rmsnorm(o_sb, sb_norm), o_ssd], axis=-1)
    return mixed @ w_out


def setup_inputs(seed: int = 0) -> dict:
    key = jax.random.key(seed)
    ks = iter(jax.random.split(key, 32))

    def nrm(shape, scale):
        return jax.random.normal(next(ks), shape, jnp.float32) * scale

    def gain(shape):
        return 1.0 + 0.01 * jax.random.normal(next(ks), shape, jnp.float32)

    dt_init = jnp.exp(math.log(1e-3) + jax.random.uniform(next(ks), (DEPTH, SSD_HEADS), jnp.float32)
                      * (math.log(1e-1) - math.log(1e-3)))
    return {
        'x': nrm((BATCH, SEQ, D_MODEL), 1.0),
        'rel_bias': nrm((REL_BUCKETS, NSA_HEADS), 0.5),
        'ffn1_norm': gain((DEPTH, D_MODEL)),
        'ffn1_w_gate': nrm((DEPTH, D_MODEL, D_FF), D_MODEL ** -0.5),
        'ffn1_w_up': nrm((DEPTH, D_MODEL, D_FF), D_MODEL ** -0.5),
        'ffn1_w_down': nrm((DEPTH, D_FF, D_MODEL), D_FF ** -0.5),
        'mix_norm': gain((DEPTH, D_MODEL)),
        'w_in': nrm((DEPTH, D_MODEL, D_IN_PROJ), D_MODEL ** -0.5),
        'w_out': nrm((DEPTH, D_MIX, D_MODEL), D_MIX ** -0.5),
        'nsa_cmp_pos': nrm((DEPTH, 2, CMP_BLOCK, HEAD_DIM), 0.1),
        'nsa_cmp_w': nrm((DEPTH, 2, CMP_BLOCK * HEAD_DIM, HEAD_DIM), (CMP_BLOCK * HEAD_DIM) ** -0.5),
        'nsa_out_norm': gain((DEPTH, NSA_WIDTH)),
        'sb_out_norm': gain((DEPTH, SB_WIDTH)),
        'ssd_conv_w': nrm((DEPTH, SSD_CONV, SSD_CONV_DIM), SSD_CONV ** -0.5),
        'ssd_conv_b': nrm((DEPTH, SSD_CONV_DIM), 0.01),
        'ssd_dt_bias': dt_init + jnp.log(-jnp.expm1(-dt_init)),
        'ssd_a_log': jnp.log(jax.random.uniform(next(ks), (DEPTH, SSD_HEADS), jnp.float32, 1.0, 16.0)),
        'ssd_d': gain((DEPTH, SSD_HEADS)),
        'ssd_out_norm': gain((DEPTH, SSD_INNER)),
        'ffn2_norm': gain((DEPTH, D_MODEL)),
        'ffn2_w_gate': nrm((DEPTH, D_MODEL, D_FF), D_MODEL ** -0.5),
        'ffn2_w_up': nrm((DEPTH, D_MODEL, D_FF), D_MODEL ** -0.5),
        'ffn2_w_down': nrm((DEPTH, D_FF, D_MODEL), D_FF ** -0.5),
        'final_norm': gain((D_MODEL,)),
    }


def reference(x, rel_bias, ffn1_norm, ffn1_w_gate, ffn1_w_up, ffn1_w_down, mix_norm, w_in, w_out,
              nsa_cmp_pos, nsa_cmp_w, nsa_out_norm, sb_out_norm, ssd_conv_w, ssd_conv_b, ssd_dt_bias,
              ssd_a_log, ssd_d, ssd_out_norm, ffn2_norm, ffn2_w_gate, ffn2_w_up, ffn2_w_down, final_norm):
    for l in range(DEPTH):
        x = x + 0.5 * swiglu(rmsnorm(x, ffn1_norm[l]), ffn1_w_gate[l], ffn1_w_up[l], ffn1_w_down[l])
        x = x + hybrid_mixer(rmsnorm(x, mix_norm[l]), rel_bias, w_in[l], w_out[l], nsa_cmp_pos[l], nsa_cmp_w[l],
                             nsa_out_norm[l], sb_out_norm[l], ssd_conv_w[l], ssd_conv_b[l], ssd_dt_bias[l],
                             ssd_a_log[l], ssd_d[l], ssd_out_norm[l])
        x = x + 0.5 * swiglu(rmsnorm(x, ffn2_norm[l]), ffn2_w_gate[l], ffn2_w_up[l], ffn2_w_down[l])
    return rmsnorm(x, final_norm)
```

```cpp
#include <hip/hip_runtime.h>
#include <cstdio>
#include <cstdint>

#ifndef GEMM_SP2
#define GEMM_SP2 true
#endif
#ifndef REP_PRO
#define REP_PRO 1
#endif
#ifndef REP_GU
#define REP_GU 1
#endif
#ifndef REP_WIN
#define REP_WIN 1
#endif
#ifndef REP_M1
#define REP_M1 1
#endif
#ifndef REP_M2
#define REP_M2 1
#endif
#ifndef REP_M3
#define REP_M3 1
#endif
#ifndef REP_CMP
#define REP_CMP 1
#endif
#ifndef REP_S1
#define REP_S1 1
#endif
#ifndef REP_SB
#define REP_SB 1
#endif
#ifndef REP_S2
#define REP_S2 1
#endif
#ifndef REP_NSA
#define REP_NSA 1
#endif
#ifndef REP_S1A
#define REP_S1A 1
#endif
#ifndef REP_S1B
#define REP_S1B 1
#endif
#ifndef REP_S1C
#define REP_S1C 1
#endif
#ifndef REP_CMPA
#define REP_CMPA 1
#endif
#ifndef REP_CMPB
#define REP_CMPB 1
#endif
#ifndef REP_S3
#define REP_S3 1
#endif
#ifndef REP_N2
#define REP_N2 1
#endif
#ifndef REP_PA
#define REP_PA 1
#endif
#ifndef REP_PB
#define REP_PB 1
#endif
#ifndef REP_AMAX
#define REP_AMAX 1
#endif
#define REPEAT(N, ...) do { __VA_ARGS__; if ((N) > 1) { __VA_ARGS__; } } while (0)
#ifndef GU8_MASK
#define GU8_MASK 0xE
#endif
#ifndef GU_I8
#define GU_I8 1
#endif
#ifndef FUSE_X
#define FUSE_X 1
#endif
#ifndef WIN_I8
#define WIN_I8 2
#endif
#ifndef DN8_MASK
#define DN8_MASK 0xF
#endif
#ifndef MK_ONE_LAUNCH
#define MK_ONE_LAUNCH 1
#endif

namespace pg8 {
#define PG8_LAS __attribute__((address_space(3)))
typedef unsigned short bf16_t;
typedef short bf16x8 __attribute__((ext_vector_type(8)));
typedef float f32x4 __attribute__((ext_vector_type(4)));
typedef unsigned u32x4 __attribute__((ext_vector_type(4)));
typedef int i32x4 __attribute__((ext_vector_type(4)));
typedef int i32x8 __attribute__((ext_vector_type(8)));
constexpr int BM = 256, BK = 64, HALF = 128, HTB = HALF * BK * 2  , STAGE_BYTES = 8 * HTB, NXCD = 8, WGM = 8;

__host__ __device__ __forceinline__ int lds_byte(int r, int c) { const int st = (r >> 4) * 2 + (c >> 5), rr = r & 15, cc = c & 31, ob = rr * 64 + cc * 2; return st * 1024 + (ob ^ (((ob >> 9) & 1) << 5)); }
__host__ __device__ __forceinline__ void stage_rc(int b, int& R, int& C) { const int st = b / 1024, sb = b % 1024, swz = sb ^ (((sb >> 9) & 1) << 5); R = (st >> 1) * 16 + swz / 64; C = (st & 1) * 32 + (swz % 64) / 2; }
__host__ __device__ __forceinline__ int perm32(int rho) { const int n = rho >> 4, i = rho & 15; return 8 * (i >> 2) + 4 * n + (i & 3); }

struct Unit { int pm, pn; };
struct Gemm { const bf16_t* A; const bf16_t* Bt; int M, N, K; };

struct StaticOrder {
    int nM, nN, nwg, G, c;
    __host__ __device__ void init(int M, int N, int G_, int c_) { nM = M / BM; nN = N / BM; nwg = nM * nN; G = G_; c = c_; }
    __host__ __device__ bool next(int i, Unit& u) const {
        const long L = (long)i * G + c; if (L >= nwg) return false;
        int wgid = (int)L; { const int q = nwg / NXCD, r = nwg % NXCD, xcd = wgid % NXCD, off = wgid / NXCD; wgid = (xcd < r ? xcd * (q + 1) : r * (q + 1) + (xcd - r) * q) + off; }
        const int nig = WGM * nN, gid = wgid / nig, fm = gid * WGM, gsz = (nM - fm) < WGM ? (nM - fm) : WGM;
        u.pm = fm + ((wgid % nig) % gsz); u.pn = (wgid % nig) / gsz; return true;
    }
    __device__ __forceinline__ void a_ready(const Unit&) const {}
    __device__ __forceinline__ void done(const Unit&) const {}
};

__device__ __forceinline__ unsigned cvt_pk_bf16(float lo, float hi) { unsigned r; asm volatile("v_cvt_pk_bf16_f32 %0, %1, %2" : "=v"(r) : "v"(lo), "v"(hi)); return r; }

template <class Epi, class Sched, bool ALIGN_EPI = false, bool SP2 = false, int QM = 0>
__device__ __forceinline__ void gemm_phase(PG8_LAS unsigned char* lds, const Gemm g, const Sched& S, const Epi& E) {
    constexpr bool FP8 = (QM == 1);
    int tid = threadIdx.x; asm volatile("" : "+v"(tid));
    const int wid = __builtin_amdgcn_readfirstlane(tid >> 6), lane = tid & 63, wr = wid >> 2, wc = wid & 3, fr = lane & 15, fq = lane >> 4;
    const int K = g.K, nt = K / BK;
    unsigned voffA[2], voffB[2];
#pragma unroll
    for (int i = 0; i < 2; ++i) { int R, C; stage_rc(tid * 16 + i * 8192, R, C); const int Rb = Epi::PERM ? ((R & ~31) + perm32(R & 31)) : R;
        voffA[i] = (unsigned)(R * K + C) * 2u; voffB[i] = (unsigned)(Rb * K + C) * 2u; }
    const size_t kstep = (size_t)(BK * 2);
    const size_t hstep = (size_t)HALF * K * 2;
    const size_t tstep = 2 * hstep;
    const unsigned ldsw = (unsigned)wid * 1024u;
    const int aoff = lds_byte(wr * 64 + fr, fq * 8), boff = lds_byte(wc * 32 + fr, fq * 8);
#define PG8_SA(b, h) (((b) * 2 + (h)) * HTB)
#define PG8_SB(b, h) ((4 + (b) * 2 + (h)) * HTB)
#define PG8_STAGE(bufoff, gbase, voff) do { _Pragma("unroll") for (int _i = 0; _i < 2; ++_i) \
        __builtin_amdgcn_global_load_lds((const unsigned*)((const char*)(gbase) + (voff)[_i]), (PG8_LAS unsigned*)(lds + (bufoff) + ldsw + _i * 8192), 16, 0, 0); } while (0)
#define PG8_LDA(dst, b, h) do { _Pragma("unroll") for (int m = 0; m < 4; ++m) { if constexpr (FP8) { dst##8[m] = __builtin_shufflevector(*(const PG8_LAS i32x4*)(lds + PG8_SA(b, h) + aoff + m * 2048), *(const PG8_LAS i32x4*)(lds + PG8_SA(b, h) + aoff + m * 2048 + 1024), 0, 1, 2, 3, 4, 5, 6, 7); } \
        else { _Pragma("unroll") for (int k = 0; k < 2; ++k) dst[m][k] = *(const PG8_LAS bf16x8*)(lds + PG8_SA(b, h) + aoff + m * 2048 + k * 1024); } } } while (0)
#define PG8_LDB(dst, b, h) do { _Pragma("unroll") for (int n = 0; n < 2; ++n) { if constexpr (FP8) { dst##8[n] = __builtin_shufflevector(*(const PG8_LAS i32x4*)(lds + PG8_SB(b, h) + boff + n * 2048), *(const PG8_LAS i32x4*)(lds + PG8_SB(b, h) + boff + n * 2048 + 1024), 0, 1, 2, 3, 4, 5, 6, 7); } \
        else { _Pragma("unroll") for (int k = 0; k < 2; ++k) dst[n][k] = *(const PG8_LAS bf16x8*)(lds + PG8_SB(b, h) + boff + n * 2048 + k * 1024); } } } while (0)
#define PG8_MMA(ai, bj, At, Bt) do { __builtin_amdgcn_s_setprio(1); _Pragma("unroll") for (int m = 0; m < 4; ++m) _Pragma("unroll") for (int n = 0; n < 2; ++n) { \
        if constexpr (FP8) { asm("v_mfma_f32_16x16x128_f8f6f4 %0, %1, %2, %0" : "+v"(acc[ai][bj][m][n]) : "v"(Bt##8[n]), "v"(At##8[m])); }   \
        else if constexpr (QM == 2) { _Pragma("unroll") for (int k = 0; k < 2; ++k) acc[ai][bj][m][n] = __builtin_bit_cast(f32x4, __builtin_amdgcn_mfma_i32_16x16x64_i8(__builtin_bit_cast(i32x4, Bt[n][k]), __builtin_bit_cast(i32x4, At[m][k]), __builtin_bit_cast(i32x4, acc[ai][bj][m][n]), 0, 0, 0)); }   \
        else { _Pragma("unroll") for (int k = 0; k < 2; ++k) acc[ai][bj][m][n] = __builtin_amdgcn_mfma_f32_16x16x32_bf16(Bt[n][k], At[m][k], acc[ai][bj][m][n], 0, 0, 0); } } \
        __builtin_amdgcn_s_setprio(0); } while (0)
#define PG8_WAIT_V(n) asm volatile("s_waitcnt vmcnt(" #n ")" ::: "memory")
#define PG8_WAIT_L(n) asm volatile("s_waitcnt lgkmcnt(" #n ")" ::: "memory")
#define PG8_BAR __builtin_amdgcn_s_barrier()
#define PG8_SCHED __builtin_amdgcn_sched_barrier(0)
    Unit cur, nxt; int ui = 0;
    if (!S.next(0, cur)) return;
    f32x4 acc[2][2][4][2];
#pragma unroll
    for (int a = 0; a < 2; ++a)
#pragma unroll
        for (int b = 0; b < 2; ++b)
#pragma unroll
            for (int m = 0; m < 4; ++m)
#pragma unroll
                for (int n = 0; n < 2; ++n) acc[a][b][m][n] = (f32x4){0.f, 0.f, 0.f, 0.f};
    bf16x8 At[4][2], B0[2][2], B1[2][2]; i32x8 At8[4], B08[2], B18[2];
    const char* cA = (const char*)g.A + (size_t)cur.pm * tstep; const char* cB = (const char*)g.Bt + (size_t)cur.pn * tstep;
    S.a_ready(cur);
    if constexpr (SP2) {
        PG8_STAGE(PG8_SB(0, 0), cB, voffB); PG8_STAGE(PG8_SB(0, 1), cB + hstep, voffB); PG8_STAGE(PG8_SA(0, 0), cA, voffA); PG8_STAGE(PG8_SA(0, 1), cA + hstep, voffA);
        if (wr == 1) PG8_BAR;
        PG8_WAIT_V(2); PG8_BAR;
        PG8_STAGE(PG8_SB(1, 0), cB + kstep, voffB); PG8_STAGE(PG8_SA(1, 0), cA + kstep, voffA); PG8_STAGE(PG8_SB(1, 1), cB + hstep + kstep, voffB);
        PG8_WAIT_V(6); PG8_BAR;
    } else {
        PG8_STAGE(PG8_SB(0, 0), cB, voffB); PG8_STAGE(PG8_SA(0, 0), cA, voffA); PG8_STAGE(PG8_SB(0, 1), cB + hstep, voffB); PG8_STAGE(PG8_SA(0, 1), cA + hstep, voffA);
        if (wr == 1) PG8_BAR;
        PG8_WAIT_V(4); PG8_BAR;
        PG8_STAGE(PG8_SB(1, 0), cB + kstep, voffB); PG8_STAGE(PG8_SA(1, 0), cA + kstep, voffA); PG8_STAGE(PG8_SB(1, 1), cB + hstep + kstep, voffB);
        PG8_WAIT_V(6); PG8_BAR;
    }
    for (;;) {
        const bool has_next = S.next(ui + 1, nxt);
        const char* nA = has_next ? (const char*)g.A + (size_t)nxt.pm * tstep : cA; const char* nB = has_next ? (const char*)g.Bt + (size_t)nxt.pn * tstep : cB;
        for (int t = 0; t < nt; t += 2) {
            const bool last = (t == nt - 2);
            const char* a1 = cA + (size_t)(t + 1) * kstep;
            const char* a2 = last ? nA : cA + (size_t)(t + 2) * kstep; const char* b2 = last ? nB : cB + (size_t)(t + 2) * kstep;
            const char* a3 = a2 + kstep; const char* b3 = b2 + kstep;
            if (last && has_next) S.a_ready(nxt);
            if constexpr (SP2) {
            PG8_LDB(B0, 0, 0); PG8_LDB(B1, 0, 1); PG8_SCHED; PG8_LDA(At, 0, 0); PG8_STAGE(PG8_SA(1, 1), a1 + hstep, voffA);
            PG8_WAIT_V(8); PG8_WAIT_L(0); PG8_BAR; PG8_MMA(0, 0, At, B0); PG8_MMA(0, 1, At, B1); PG8_BAR; PG8_SCHED;
            PG8_LDA(At, 0, 1); PG8_STAGE(PG8_SB(0, 0), b2, voffB); PG8_STAGE(PG8_SB(0, 1), b2 + hstep, voffB); PG8_STAGE(PG8_SA(0, 0), a2, voffA);
            PG8_WAIT_V(8); PG8_WAIT_L(0); PG8_BAR; PG8_MMA(1, 0, At, B0); PG8_MMA(1, 1, At, B1); PG8_BAR; PG8_SCHED;
            PG8_LDB(B0, 1, 0); PG8_LDB(B1, 1, 1); PG8_SCHED; PG8_LDA(At, 1, 0); PG8_STAGE(PG8_SA(0, 1), a2 + hstep, voffA);
            PG8_WAIT_V(8); PG8_WAIT_L(0); PG8_BAR; PG8_MMA(0, 0, At, B0); PG8_MMA(0, 1, At, B1); PG8_BAR; PG8_SCHED;
            PG8_LDA(At, 1, 1); PG8_STAGE(PG8_SB(1, 0), b3, voffB); PG8_STAGE(PG8_SB(1, 1), b3 + hstep, voffB); PG8_STAGE(PG8_SA(1, 0), a3, voffA);
            PG8_WAIT_V(8); PG8_WAIT_L(0); PG8_BAR; PG8_MMA(1, 0, At, B0); PG8_MMA(1, 1, At, B1); PG8_BAR; PG8_SCHED;
            } else {
            PG8_LDB(B0, 0, 0); PG8_SCHED; PG8_LDA(At, 0, 0); PG8_STAGE(PG8_SA(1, 1), a1 + hstep, voffA);
            PG8_WAIT_L(8); PG8_BAR; PG8_WAIT_L(0); PG8_MMA(0, 0, At, B0); PG8_BAR; PG8_SCHED;
            PG8_LDB(B1, 0, 1); PG8_STAGE(PG8_SB(0, 0), b2, voffB);
            PG8_BAR; PG8_WAIT_L(0); PG8_MMA(0, 1, At, B1); PG8_BAR;
            PG8_LDA(At, 0, 1); PG8_STAGE(PG8_SA(0, 0), a2, voffA);
            PG8_BAR; PG8_WAIT_L(0); PG8_MMA(1, 0, At, B0); PG8_BAR; PG8_SCHED;
            PG8_STAGE(PG8_SB(0, 1), b2 + hstep, voffB);
            PG8_WAIT_V(6); PG8_BAR; PG8_MMA(1, 1, At, B1); PG8_BAR;
            PG8_LDB(B0, 1, 0); PG8_SCHED; PG8_LDA(At, 1, 0); PG8_STAGE(PG8_SA(0, 1), a2 + hstep, voffA);
            PG8_WAIT_L(8); PG8_BAR; PG8_WAIT_L(0); PG8_MMA(0, 0, At, B0); PG8_BAR; PG8_SCHED;
            PG8_LDB(B1, 1, 1); PG8_STAGE(PG8_SB(1, 0), b3, voffB);
            PG8_BAR; PG8_WAIT_L(0); PG8_MMA(0, 1, At, B1); PG8_BAR;
            PG8_LDA(At, 1, 1); PG8_STAGE(PG8_SA(1, 0), a3, voffA);
            PG8_BAR; PG8_WAIT_L(0); PG8_MMA(1, 0, At, B0); PG8_BAR; PG8_SCHED;
            PG8_STAGE(PG8_SB(1, 1), b3 + hstep, voffB);
            PG8_WAIT_V(6); PG8_BAR; PG8_MMA(1, 1, At, B1); PG8_BAR;
            }
        }
        if constexpr (ALIGN_EPI) { if (wr == 0) PG8_BAR; }
        if constexpr (!Epi::AFTER_DRAIN) E(acc, cur, wr, wc, fr, fq);
        S.done(cur);
        if (!has_next) break;
#pragma unroll
        for (int a = 0; a < 2; ++a)
#pragma unroll
            for (int b = 0; b < 2; ++b)
#pragma unroll
                for (int m = 0; m < 4; ++m)
#pragma unroll
                    for (int n = 0; n < 2; ++n) acc[a][b][m][n] = (f32x4){0.f, 0.f, 0.f, 0.f};
        cur = nxt; cA = nA; cB = nB; ++ui;
        if constexpr (ALIGN_EPI) { if (wr == 1) PG8_BAR; }
    }
    PG8_WAIT_V(0);
    if constexpr (!ALIGN_EPI) { if (wr == 0) PG8_BAR; }
    PG8_BAR;
    if constexpr (Epi::AFTER_DRAIN) E.fused(acc, cur, wr, wc, fr, fq, lds);
#undef PG8_SA
#undef PG8_SB
#undef PG8_STAGE
#undef PG8_LDA
#undef PG8_LDB
#undef PG8_MMA
#undef PG8_WAIT_V
#undef PG8_WAIT_L
#undef PG8_BAR
#undef PG8_SCHED
}
}

constexpr int NWAVES = 8, NTHR = 512;
constexpr int BATCH = 4, T = 2048, M = BATCH * T, D = 2048, FF = 5632, DEPTH = 2;
constexpr int NIN_SRC = 5416, NIN = 5632;
constexpr int NGU = 2 * FF;
constexpr float EPS = 1e-6f;
constexpr float LOG2E = 1.4426950408889634f;
constexpr float QSCALE = 0.125f * LOG2E;
constexpr int NSS = 7;

constexpr size_t MiB = 1u << 20;
constexpr size_t WS_CTL = 0, CTL_ZERO_BYTES = 1 * MiB;
constexpr int CW_TMO = 0, CW_BAR = 4096, CW_PX = 8192  , CW_SS = 16384;
static_assert((CW_SS + 2 * NSS * M) * 4 <= (int)CTL_ZERO_BYTES, "ctl");
typedef unsigned long long u64;
constexpr float SS_SCALE = 1048576.0f, SS_INV = 1.0f / 1048576.0f;
constexpr size_t WS_TAB = 1 * MiB;
constexpr size_t WS_W = 2 * MiB;
constexpr size_t W_GU = (size_t)NGU * D * 2, W_DN = (size_t)D * FF * 2, W_IN = (size_t)NIN * D * 2, W_OUT = (size_t)D * D * 2;
constexpr size_t WL_GU1 = 0, WL_DN1 = WL_GU1 + W_GU, WL_IN = WL_DN1 + W_DN, WL_OUT = WL_IN + W_IN, WL_GU2 = WL_OUT + W_OUT, WL_DN2 = WL_GU2 + W_GU, WL_SIZE = WL_DN2 + W_DN;
static_assert(WL_SIZE == 162 * MiB, "weights per layer");
constexpr size_t WS_XB = WS_W + DEPTH * WL_SIZE;
constexpr size_t WS_CW = WS_XB + (size_t)M * D * 2;
constexpr size_t WS_R = WS_CW + 1 * MiB;
constexpr size_t TAB_PB = 8192;
constexpr size_t R_H = 0;
constexpr size_t R_QN = 0, R_QS = R_QN + 8 * MiB, R_KS = R_QS + 8 * MiB, R_KN = R_KS + 8 * MiB, R_CMPRAW = R_KN + 4 * MiB, R_VNT = R_CMPRAW + 8 * MiB,
                 R_VST = R_VNT + 4 * MiB, R_Z = R_VST + 8 * MiB, R_XBC = R_Z + 16 * MiB, R_DTG = R_XBC + 24 * MiB, R_XT = R_DTG + 2 * MiB, R_BM = R_XT + 16 * MiB,
                 R_CM = R_BM + 4 * MiB, R_DT = R_CM + 4 * MiB, R_KCMP = R_DT + 1 * MiB, R_VCMPT = R_KCMP + 1 * MiB, R_SELM = R_VCMPT + 1 * MiB, R_MIXED = R_SELM + 1 * MiB,
                 R_OC = R_MIXED + 32 * MiB, R_ONSA = R_OC + 16 * MiB, R_OSB = R_ONSA + 16 * MiB, R_YS = R_OSB + 16 * MiB, R_ST = R_YS + 32 * MiB, R_HIN = R_ST + 64 * MiB,
                 R_ACS = R_HIN + 32 * MiB, R_AEND = R_ACS + 1 * MiB, R_END = R_AEND + 1 * MiB;
constexpr size_t WS_END = WS_R + R_END;
static_assert((size_t)M * FF * 2 <= R_MIXED, "H must not overlay MIXED");

typedef unsigned short bf16;
typedef unsigned v4u __attribute__((ext_vector_type(4)));
typedef unsigned v2u __attribute__((ext_vector_type(2)));
typedef float f32x4 __attribute__((ext_vector_type(4)));
#define LAS __attribute__((address_space(3)))
#define LDS_WAIT() asm volatile("s_waitcnt lgkmcnt(0)" ::: "memory")

__device__ __forceinline__ float bf2f(bf16 v) { return __uint_as_float(((unsigned)v) << 16); }
__device__ __forceinline__ unsigned f2bf(float f) { unsigned u = __float_as_uint(f); return (u + 0x7fffu + ((u >> 16) & 1u)) >> 16; }
__device__ __forceinline__ unsigned pk2(float lo, float hi) { unsigned r; asm("v_cvt_pk_bf16_f32 %0, %1, %2" : "=v"(r) : "v"(lo), "v"(hi)); return r; }
__device__ __forceinline__ float wave_sum(float v) {
#pragma unroll
    for (int o = 1; o < 64; o <<= 1) v += __shfl_xor(v, o);
    return v;
}
__device__ __forceinline__ float wave_max(float v) {
#pragma unroll
    for (int o = 1; o < 64; o <<= 1) v = fmaxf(v, __shfl_xor(v, o));
    return v;
}
__device__ __forceinline__ float fexp2(float x) { return __builtin_amdgcn_exp2f(x); }
__device__ __forceinline__ float frcp(float x) { return __builtin_amdgcn_rcpf(x); }
__device__ __forceinline__ float silu_f(float v) { return v * frcp(1.0f + fexp2(-v * LOG2E)); }
__device__ __forceinline__ float sigmoid_f(float v) { return frcp(1.0f + fexp2(-v * LOG2E)); }

#define XB_TMO      128
#define XB_XCNT(j)  (256  + 64 * (j))
#define XB_XSUB(j)  (1280 + 64 * (j))
#define XB_XGEN(j)  (2304 + 64 * (j))
#define XB_TOP      3328
#define XB_TOPGEN   3392
#define XCD_BAR_WORDS 3456
#define XB_SPIN_CAP (1u << 18)
__device__ __forceinline__ unsigned xb_ld(unsigned* p)              { return __hip_atomic_load(p, __ATOMIC_RELAXED, __HIP_MEMORY_SCOPE_AGENT); }
__device__ __forceinline__ unsigned xb_add(unsigned* p, unsigned v) { return __hip_atomic_fetch_add(p, v, __ATOMIC_RELAXED, __HIP_MEMORY_SCOPE_AGENT); }
__device__ __forceinline__ unsigned xb_xcc_id() { return (unsigned)__builtin_amdgcn_s_getreg((3 << 11) | 20) & 0xFu; }
#define XB_SPIN(cond, bar) do { unsigned _sp = 0; while (cond) { __builtin_amdgcn_s_sleep(1); \
    if ((++_sp & 255u) == 0u) { if (xb_ld(&(bar)[XB_TMO])) break; if (_sp > XB_SPIN_CAP) { atomicAdd(&(bar)[XB_TMO], 1u); break; } } } } while (0)
struct XcdBarrier { unsigned* bar; unsigned x; volatile LAS unsigned* st; };
__device__ __forceinline__ XcdBarrier xcd_barrier_post(unsigned* bar, volatile LAS unsigned* st) {
    XcdBarrier b; b.bar = bar; b.x = xb_xcc_id(); b.st = st;
    if (threadIdx.x == 0) (void)xb_add(&bar[XB_XCNT(b.x)], 1u);
    return b;
}
__device__ __forceinline__ void xcd_barrier_complete(unsigned* bar, unsigned x, unsigned& nloc, unsigned& nx) {
    const unsigned G = gridDim.x * gridDim.y * gridDim.z;
    unsigned sum, cnt, mine, sp = 0u;
    for (;;) {
        sum = 0u; cnt = 0u; mine = 0u;
#pragma unroll
        for (unsigned j = 0; j < 16; ++j) { const unsigned c = xb_ld(&bar[XB_XCNT(j)]); sum += c; cnt += (c > 0u) ? 1u : 0u; mine = (j == x) ? c : mine; }
        if (sum == G) break;
        __builtin_amdgcn_s_sleep(1);
        if ((++sp & 255u) == 0u) { if (xb_ld(&bar[XB_TMO])) break; if (sp > XB_SPIN_CAP) { atomicAdd(&bar[XB_TMO], 1u); break; } }
    }
    nloc = mine > 0u ? mine : 1u; nx = cnt > 0u ? cnt : 1u;
}
__device__ __forceinline__ void xcd_barrier(const XcdBarrier& b) {
    asm volatile("s_waitcnt vmcnt(0)" ::: "memory");
    __syncthreads();
    if (threadIdx.x == 0) {
        unsigned* bar = b.bar;
        __builtin_amdgcn_s_waitcnt(0);
        unsigned nloc = b.st[0], nx = b.st[1];
        if (nloc == 0u) { xcd_barrier_complete(bar, b.x, nloc, nx); b.st[0] = nloc; b.st[1] = nx; }
        const unsigned old = xb_add(&bar[XB_XSUB(b.x)], 1u);
        const unsigned gen = old / nloc;
        if (old + 1u == (gen + 1u) * nloc) {
            __builtin_amdgcn_fence(__ATOMIC_RELEASE, "agent");
            asm volatile("s_waitcnt vmcnt(0)" ::: "memory");
            const unsigned og = xb_add(&bar[XB_TOP], 1u);
            const unsigned tg = og / nx;
            if (og + 1u == (tg + 1u) * nx) xb_add(&bar[XB_TOPGEN], 1u);
            else XB_SPIN(xb_ld(&bar[XB_TOPGEN]) == tg, bar);
            __builtin_amdgcn_fence(__ATOMIC_ACQUIRE, "agent");
            xb_add(&bar[XB_XGEN(b.x)], 1u);
            asm volatile("s_waitcnt vmcnt(0)" ::: "memory");
        } else {
            XB_SPIN(xb_ld(&bar[XB_XGEN(b.x)]) == gen, bar);
            __builtin_amdgcn_fence(__ATOMIC_ACQUIRE, "agent");
            asm volatile("s_waitcnt vmcnt(0)" ::: "memory");
        }
    }
    __syncthreads();
}


constexpr int RING_BYTES = 131072;
constexpr int MISC_OFF = RING_BYTES;
constexpr int LDS_BYTES = 147456;

__device__ __forceinline__ float rstd_of(u64 ssq) { return rsqrtf((float)ssq * (SS_INV / D) + EPS); }
constexpr bool gu8(int seg) { return seg >= 0 && seg < 4 && ((GU8_MASK >> seg) & 1); }
constexpr bool gui8(int seg) { return GU_I8 != 0 && seg == 0; }
constexpr int CW_WMAX = 8;
constexpr size_t TAB_PX = 131072;
constexpr size_t TAB_XS = 32768;
constexpr bool wini8(int l) { return l >= 0 && l < 2 && ((WIN_I8 >> l) & 1); }
constexpr bool dn8(int seg) { return seg >= 0 && seg < 4 && ((DN8_MASK >> seg) & 1); }
constexpr float H8_SCALE = 16.0f, DN8_UNSCALE = 1.0f / (16.0f * 256.0f);
constexpr float X8_SCALE = 16.0f, W8_SCALE = 256.0f, GU8_UNSCALE = 1.0f / (16.0f * 256.0f);
__device__ __forceinline__ float sat8(float v) { return __builtin_amdgcn_fmed3f(v, -448.0f, 448.0f); }
__device__ __forceinline__ unsigned pk4_fp8(float a, float b, float c, float d) { int w = 0; w = __builtin_amdgcn_cvt_pk_fp8_f32(sat8(a), sat8(b), w, false); w = __builtin_amdgcn_cvt_pk_fp8_f32(sat8(c), sat8(d), w, true); return (unsigned)w; }
__device__ __forceinline__ size_t kfrag_off(int t, int d0) { return ((size_t)((t >> 5) * 4 + (d0 >> 4)) * 64 + 32 * ((d0 >> 3) & 1) + (t & 31)) * 8; }
__device__ __forceinline__ size_t vfrag_off(int t, int d) { const int q = t & 15; return ((size_t)(((t >> 5) * 2 + (d >> 5)) * 2 + ((t >> 4) & 1)) * 64 + 32 * ((q >> 2) & 1) + (d & 31)) * 8 + 4 * (q >> 3) + (q & 3); }
struct EpiGateUp {
    static constexpr bool PERM = true, AFTER_DRAIN = false;
    bf16* H; const u64* ss; float unscale; int h8; const float* xs; int i8;
    __device__ __forceinline__ void operator()(const f32x4 (&acc)[2][2][4][2], const pg8::Unit& u, int wr, int wc, int fr, int fq) const {
        const int row0 = u.pm * 256 + wr * 64 + fr, hcol = u.pn * 128 + wc * 32 + 8 * fq;
#pragma unroll
        for (int ai = 0; ai < 2; ++ai)
#pragma unroll
            for (int m = 0; m < 4; ++m) {
                const int row = row0 + ai * 128 + m * 16;
                float r = rstd_of(ss[row]) * unscale;
                if (i8) r *= xs[row];
                float h[8];
#pragma unroll
                for (int n = 0; n < 2; ++n)
#pragma unroll
                    for (int j = 0; j < 4; ++j) {
                        const float gf = acc[ai][0][m][n][j], uf = acc[ai][1][m][n][j];
                        const float ga = i8 ? (float)__float_as_int(gf) : gf, ua = i8 ? (float)__float_as_int(uf) : uf;
                        const float g = ga * r, uu = ua * r; h[n * 4 + j] = silu_f(g) * uu; }
                if (h8) { v2u w8; w8.x = pk4_fp8(h[0] * H8_SCALE, h[1] * H8_SCALE, h[2] * H8_SCALE, h[3] * H8_SCALE); w8.y = pk4_fp8(h[4] * H8_SCALE, h[5] * H8_SCALE, h[6] * H8_SCALE, h[7] * H8_SCALE);
                    *(v2u*)((unsigned char*)H + (size_t)row * FF + hcol) = w8; }
                else { v4u w; w.x = pk2(h[0], h[1]); w.y = pk2(h[2], h[3]); w.z = pk2(h[4], h[5]); w.w = pk2(h[6], h[7]);
                    *(v4u*)(H + (size_t)row * FF + hcol) = w; }
            }
    }
};
struct EpiResid {
    static constexpr bool PERM = true, AFTER_DRAIN = false;
    const float* xin; float* xout; bf16* xb; u64* ss_out; float alpha; int out8;
    __device__ __forceinline__ void operator()(const f32x4 (&acc)[2][2][4][2], const pg8::Unit& u, int wr, int wc, int fr, int fq) const {
        const int row0 = u.pm * 256 + wr * 64 + fr, col0 = u.pn * 256 + wc * 32 + 8 * fq;
#pragma unroll
        for (int ai = 0; ai < 2; ++ai)
#pragma unroll
            for (int m = 0; m < 4; ++m) {
                const int row = row0 + ai * 128 + m * 16;
                float s = 0.f;
#pragma unroll
                for (int bj = 0; bj < 2; ++bj) {
                    const size_t off = (size_t)row * D + col0 + bj * 128;
                    const f32x4 x0 = *(const f32x4*)(xin + off), x1 = *(const f32x4*)(xin + off + 4);
                    const f32x4 y0 = x0 + acc[ai][bj][m][0] * alpha, y1 = x1 + acc[ai][bj][m][1] * alpha;
                    *(f32x4*)(xout + off) = y0; *(f32x4*)(xout + off + 4) = y1;
                    if (out8 == 2) { }
                    else if (out8) { v2u w8; w8.x = pk4_fp8(y0[0] * X8_SCALE, y0[1] * X8_SCALE, y0[2] * X8_SCALE, y0[3] * X8_SCALE); w8.y = pk4_fp8(y1[0] * X8_SCALE, y1[1] * X8_SCALE, y1[2] * X8_SCALE, y1[3] * X8_SCALE);
                        *(v2u*)((unsigned char*)xb + off) = w8; }
                    else { v4u w; w.x = pk2(y0[0], y0[1]); w.y = pk2(y0[2], y0[3]); w.z = pk2(y1[0], y1[1]); w.w = pk2(y1[2], y1[3]);
                        *(v4u*)(xb + off) = w; }
                    s += (y0[0] * y0[0] + y0[1] * y0[1]) + (y0[2] * y0[2] + y0[3] * y0[3]) + (y1[0] * y1[0] + y1[1] * y1[1]) + (y1[2] * y1[2] + y1[3] * y1[3]);
                }
                s += __shfl_xor(s, 16); s += __shfl_xor(s, 32);
                if (fq == 0) atomicAdd(ss_out + row, (u64)(s * SS_SCALE + 0.5f));
                asm volatile("" ::: "memory");
            }
    }
};
struct PanelX {
    float* slots;
    unsigned* cnt;
    template <int OP  >
    __device__ __forceinline__ void run(const float (&part)[2][4], const pg8::Unit& u, int wr, int wc, int fr, int fq, PG8_LAS unsigned char* lds) const {
        PG8_LAS float* P = (PG8_LAS float*)lds;
        PG8_LAS float* S = (PG8_LAS float*)(lds + 8192);
        int tid = threadIdx.x; asm volatile("" : "+v"(tid));
        const int wid = __builtin_amdgcn_readfirstlane(tid >> 6), lane = tid & 63;
        if (fq == 0) {
#pragma unroll
            for (int ai = 0; ai < 2; ++ai)
#pragma unroll
                for (int m = 0; m < 4; ++m) P[(ai * 128 + wr * 64 + m * 16 + fr) * 4 + wc] = part[ai][m];
        }
        asm volatile("s_waitcnt lgkmcnt(0)" ::: "memory"); __builtin_amdgcn_s_barrier(); asm volatile("" ::: "memory");
        const int row = wid * 32 + (lane & 31);
        if (lane < 32) {
            const float a = P[row * 4 + 0], b = P[row * 4 + 1], c = P[row * 4 + 2], d = P[row * 4 + 3];
            const float v = OP == 0 ? (a + b) + (c + d) : fmaxf(fmaxf(a, b), fmaxf(c, d));
            __hip_atomic_store((unsigned*)slots + (size_t)(u.pm * 256 + row) * 8 + u.pn, __float_as_uint(v), __ATOMIC_RELAXED, __HIP_MEMORY_SCOPE_AGENT);
        }
        asm volatile("s_waitcnt vmcnt(0)" ::: "memory");
        if (lane == 0) __hip_atomic_fetch_add(cnt + 64 * u.pm, 1u, __ATOMIC_RELAXED, __HIP_MEMORY_SCOPE_AGENT);
        if (wid == 0) {
            unsigned sp = 0u;
            while ((unsigned)__builtin_amdgcn_readfirstlane((int)__hip_atomic_load(cnt + 64 * u.pm, __ATOMIC_RELAXED, __HIP_MEMORY_SCOPE_AGENT)) < 64u) { __builtin_amdgcn_s_sleep(2); if (++sp > (1u << 22)) break; }
            __builtin_amdgcn_fence(__ATOMIC_ACQUIRE, "agent");
        }
        asm volatile("s_waitcnt vmcnt(0) lgkmcnt(0)" ::: "memory"); __builtin_amdgcn_s_barrier(); asm volatile("" ::: "memory");
        if (lane < 32) {
            const unsigned* sl = (const unsigned*)slots + (size_t)(u.pm * 256 + row) * 8;
            float t[8];
#pragma unroll
            for (int q = 0; q < 8; ++q) t[q] = __uint_as_float(__hip_atomic_load(sl + q, __ATOMIC_RELAXED, __HIP_MEMORY_SCOPE_AGENT));
            S[row] = OP == 0 ? ((t[0] + t[1]) + (t[2] + t[3])) + ((t[4] + t[5]) + (t[6] + t[7])) : fmaxf(fmaxf(fmaxf(t[0], t[1]), fmaxf(t[2], t[3])), fmaxf(fmaxf(t[4], t[5]), fmaxf(t[6], t[7])));
        }
        asm volatile("s_waitcnt lgkmcnt(0)" ::: "memory"); __builtin_amdgcn_s_barrier(); asm volatile("" ::: "memory");
    }
};
__device__ __forceinline__ unsigned pk4_i8(float a, float b, float c, float d);
struct EpiResidFin {
    static constexpr bool PERM = true, AFTER_DRAIN = true;
    const float* xin; float* out; const float* gain; float alpha; PanelX px;
    __device__ __forceinline__ void fused(f32x4 (&acc)[2][2][4][2], const pg8::Unit& u, int wr, int wc, int fr, int fq, PG8_LAS unsigned char* lds) const {
        const int row0 = u.pm * 256 + wr * 64 + fr, col0 = u.pn * 256 + wc * 32 + 8 * fq;
        float part[2][4];
#pragma unroll
        for (int ai = 0; ai < 2; ++ai)
#pragma unroll
            for (int m = 0; m < 4; ++m) {
                const int row = row0 + ai * 128 + m * 16;
                float s = 0.f;
#pragma unroll
                for (int bj = 0; bj < 2; ++bj) {
                    const size_t off = (size_t)row * D + col0 + bj * 128;
                    const f32x4 x0 = *(const f32x4*)(xin + off), x1 = *(const f32x4*)(xin + off + 4);
                    const f32x4 y0 = x0 + acc[ai][bj][m][0] * alpha, y1 = x1 + acc[ai][bj][m][1] * alpha;
                    acc[ai][bj][m][0] = y0; acc[ai][bj][m][1] = y1;
                    s += (y0[0] * y0[0] + y0[1] * y0[1]) + (y0[2] * y0[2] + y0[3] * y0[3]) + (y1[0] * y1[0] + y1[1] * y1[1]) + (y1[2] * y1[2] + y1[3] * y1[3]);
                }
                s += __shfl_xor(s, 16); s += __shfl_xor(s, 32);
                part[ai][m] = s;
                asm volatile("" : "+v"(acc[ai][0][m][0]), "+v"(acc[ai][0][m][1]), "+v"(acc[ai][1][m][0]), "+v"(acc[ai][1][m][1]));
            }
        px.run<0>(part, u, wr, wc, fr, fq, lds);
        const PG8_LAS float* S = (const PG8_LAS float*)(lds + 8192);
        f32x4 g[2][2];
#pragma unroll
        for (int bj = 0; bj < 2; ++bj) { g[bj][0] = *(const f32x4*)(gain + col0 + bj * 128); g[bj][1] = *(const f32x4*)(gain + col0 + bj * 128 + 4); }
#pragma unroll
        for (int ai = 0; ai < 2; ++ai)
#pragma unroll
            for (int m = 0; m < 4; ++m) {
                const int rl = ai * 128 + wr * 64 + m * 16 + fr, row = u.pm * 256 + rl;
                const float r = rsqrtf(S[rl] * (1.0f / D) + EPS);
#pragma unroll
                for (int bj = 0; bj < 2; ++bj) {
                    const size_t off = (size_t)row * D + col0 + bj * 128;
                    *(f32x4*)(out + off) = acc[ai][bj][m][0] * r * g[bj][0]; *(f32x4*)(out + off + 4) = acc[ai][bj][m][1] * r * g[bj][1];
                }
            }
    }
};
struct EpiResidQ8 {
    static constexpr bool PERM = true, AFTER_DRAIN = true;
    const float* xin; float* xout; unsigned char* xb8; float* xs; u64* ss_out; float alpha; PanelX px;
    __device__ __forceinline__ void fused(f32x4 (&acc)[2][2][4][2], const pg8::Unit& u, int wr, int wc, int fr, int fq, PG8_LAS unsigned char* lds) const {
        const int row0 = u.pm * 256 + wr * 64 + fr, col0 = u.pn * 256 + wc * 32 + 8 * fq;
        float part[2][4];
#pragma unroll
        for (int ai = 0; ai < 2; ++ai)
#pragma unroll
            for (int m = 0; m < 4; ++m) {
                const int row = row0 + ai * 128 + m * 16;
                float s = 0.f, mx = 0.f;
#pragma unroll
                for (int bj = 0; bj < 2; ++bj) {
                    const size_t off = (size_t)row * D + col0 + bj * 128;
                    const f32x4 x0 = *(const f32x4*)(xin + off), x1 = *(const f32x4*)(xin + off + 4);
                    const f32x4 y0 = x0 + acc[ai][bj][m][0] * alpha, y1 = x1 + acc[ai][bj][m][1] * alpha;
                    acc[ai][bj][m][0] = y0; acc[ai][bj][m][1] = y1;
                    *(f32x4*)(xout + off) = y0; *(f32x4*)(xout + off + 4) = y1;
                    s += (y0[0] * y0[0] + y0[1] * y0[1]) + (y0[2] * y0[2] + y0[3] * y0[3]) + (y1[0] * y1[0] + y1[1] * y1[1]) + (y1[2] * y1[2] + y1[3] * y1[3]);
                    mx = fmaxf(fmaxf(fmaxf(mx, fmaxf(fabsf(y0[0]), fabsf(y0[1]))), fmaxf(fabsf(y0[2]), fabsf(y0[3]))), fmaxf(fmaxf(fabsf(y1[0]), fabsf(y1[1])), fmaxf(fabsf(y1[2]), fabsf(y1[3]))));
                }
                s += __shfl_xor(s, 16); s += __shfl_xor(s, 32);
                mx = fmaxf(mx, __shfl_xor(mx, 16)); mx = fmaxf(mx, __shfl_xor(mx, 32));
                if (fq == 0) atomicAdd(ss_out + row, (u64)(s * SS_SCALE + 0.5f));
                part[ai][m] = mx;
                asm volatile("" : "+v"(acc[ai][0][m][0]), "+v"(acc[ai][0][m][1]), "+v"(acc[ai][1][m][0]), "+v"(acc[ai][1][m][1]) :: "memory");
            }
        px.run<1>(part, u, wr, wc, fr, fq, lds);
        const PG8_LAS float* S = (const PG8_LAS float*)(lds + 8192);
        if (u.pn == 0) { int tid = threadIdx.x; asm volatile("" : "+v"(tid)); if (tid < 256) xs[u.pm * 256 + tid] = fmaxf(S[tid], 1e-30f) * (1.0f / 127.0f); }
#pragma unroll
        for (int ai = 0; ai < 2; ++ai)
#pragma unroll
            for (int m = 0; m < 4; ++m) {
                const int rl = ai * 128 + wr * 64 + m * 16 + fr, row = u.pm * 256 + rl;
                const float inv = 127.0f / fmaxf(S[rl], 1e-30f);
#pragma unroll
                for (int bj = 0; bj < 2; ++bj) {
                    const f32x4 y0 = acc[ai][bj][m][0] * inv, y1 = acc[ai][bj][m][1] * inv;
                    v2u w8; w8.x = pk4_i8(y0[0], y0[1], y0[2], y0[3]); w8.y = pk4_i8(y1[0], y1[1], y1[2], y1[3]);
                    *(v2u*)(xb8 + (size_t)row * D + col0 + bj * 128) = w8;
                }
            }
    }
};
struct EpiWin {
    static constexpr bool PERM = true, AFTER_DRAIN = false;
    unsigned char* R; const u64* ss; const float* xs; float wsc; int i8;
    __device__ __forceinline__ void operator()(const f32x4 (&acc)[2][2][4][2], const pg8::Unit& u, int wr, int wc, int fr, int fq) const {
        const int row0 = u.pm * 256 + wr * 64 + fr;
        const int pn = u.pn;
        unsigned off = 0u; int ld = 0, cbase = 0, cls = 0, hbase = 0, nh = 0; float sc = 1.f;
        if (pn < 2)       { off = (unsigned)R_QN; ld = 512; cbase = pn * 256; sc = QSCALE; }
        else if (pn < 4)  { off = (unsigned)R_QS; ld = 512; cbase = (pn - 2) * 256; sc = QSCALE; }
        else if (pn < 6)  { cls = 4; off = (unsigned)R_KS; hbase = (pn - 4) * 4; nh = 8; }
        else if (pn == 6) { cls = 4; off = (unsigned)R_KN; hbase = 0; nh = 4; }
        else if (pn == 7) { cls = 1; off = (unsigned)R_CMPRAW; }
        else if (pn == 8) { cls = 2; off = (unsigned)R_VNT; hbase = 0; nh = 4; }
        else if (pn < 11) { cls = 2; off = (unsigned)R_VST; hbase = (pn - 9) * 4; nh = 8; }
        else if (pn < 15) { off = (unsigned)R_Z; ld = 1024; cbase = (pn - 11) * 256; }
        else if (pn < 21) { off = (unsigned)R_XBC; ld = 1536; cbase = (pn - 15) * 256; }
        else              { cls = 3; off = (unsigned)R_DTG; }
        unsigned char* const dst = R + off;
#pragma unroll
        for (int ai = 0; ai < 2; ++ai)
#pragma unroll
            for (int m = 0; m < 4; ++m) {
                const int row = row0 + ai * 128 + m * 16;
                float r = rstd_of(ss[row]) * sc;
                if (i8) r *= xs[row] * wsc;
#pragma unroll
                for (int bj = 0; bj < 2; ++bj) {
                    const int col = bj * 128 + wc * 32 + 8 * fq;
                    float v[8];
#pragma unroll
                    for (int n = 0; n < 2; ++n)
#pragma unroll
                        for (int j = 0; j < 4; ++j) { const float af = acc[ai][bj][m][n][j]; v[n * 4 + j] = (i8 ? (float)__float_as_int(af) : af) * r; }
                    if (cls == 0) {
                        v4u w; w.x = pk2(v[0], v[1]); w.y = pk2(v[2], v[3]); w.z = pk2(v[4], v[5]); w.w = pk2(v[6], v[7]);
                        *(v4u*)((bf16*)dst + (size_t)row * ld + cbase + col) = w;
                    } else if (cls == 1) {
                        v4u w; w.x = pk2(v[0], v[1]); w.y = pk2(v[2], v[3]); w.z = pk2(v[4], v[5]); w.w = pk2(v[6], v[7]);
                        const int seg = col >> 6, d0 = col & 63, b = row / T, t = row % T, c1 = t >> 4, l1 = t & 15;
                        bf16* base = (bf16*)dst + (size_t)(seg * 4 + b) * (4 * 128 * 512);
                        *(v4u*)(base + ((size_t)((c1 >> 5) * 128 + 4 * l1 + (d0 >> 4)) * 64 + 32 * ((d0 >> 3) & 1) + (c1 & 31)) * 8) = w;
                        if (c1 > 0) { const int c0 = c1 - 1, l0 = l1 + 16;
                            *(v4u*)(base + ((size_t)((c0 >> 5) * 128 + 4 * l0 + (d0 >> 4)) * 64 + 32 * ((d0 >> 3) & 1) + (c0 & 31)) * 8) = w; }
                    } else if (cls == 4) {
                        v4u w; w.x = pk2(v[0], v[1]); w.y = pk2(v[2], v[3]); w.z = pk2(v[4], v[5]); w.w = pk2(v[6], v[7]);
                        const int b = row / T, t = row % T, hs = hbase + (col >> 6), d0 = col & 63;
                        *(v4u*)((bf16*)dst + (size_t)(b * nh + hs) * (T * 64) + kfrag_off(t, d0)) = w;
                    } else if (cls == 2) {
                        const int b = row / T, t = row % T, hs = hbase + (col >> 6), d0 = col & 63;
                        bf16* tp = (bf16*)dst + (size_t)(b * nh + hs) * (T * 64) + vfrag_off(t, d0);
#pragma unroll
                        for (int j = 0; j < 8; ++j) tp[8 * j] = (bf16)f2bf(v[j]);
                    } else {
                        if (col < 64) { float* o = (float*)dst + (size_t)row * 64 + col; *(f32x4*)o = (f32x4){v[0], v[1], v[2], v[3]}; *(f32x4*)(o + 4) = (f32x4){v[4], v[5], v[6], v[7]}; }
                    }
                }
            }
    }
};

struct Args { const float* in[24]; float* out; unsigned char* ws; int ph_lo, ph_hi; };
struct Frame {
    unsigned char* lds; int tid, lane, wave, vcu, G;
    float* out; unsigned char* ws; unsigned char* R; float* ctlf;
};
__device__ __forceinline__ bf16* wptr(const Frame& F, int layer, size_t off) { return (bf16*)(F.ws + WS_W + (size_t)layer * WL_SIZE + off); }
__device__ __forceinline__ u64* ssptr(const Frame& F, int i) { return (u64*)(F.ctlf + CW_SS) + (size_t)i * M; }
typedef const __attribute__((address_space(4))) Args* KArgs;
__device__ __forceinline__ KArgs kargs() { KArgs p = (KArgs)__builtin_amdgcn_kernarg_segment_ptr(); asm volatile("" : "+s"(p)); return p; }
__device__ __forceinline__ Frame make_frame(unsigned char* ws, float* out, unsigned char* lds) {
    int tid = threadIdx.x, vcu = blockIdx.x, G = gridDim.x; asm volatile("" : "+v"(tid), "+s"(vcu), "+s"(G));
    Frame F; F.lds = lds; F.tid = tid; F.lane = F.tid & 63; F.wave = __builtin_amdgcn_readfirstlane(F.tid >> 6); F.G = G; F.vcu = vcu;
    F.out = out; F.ws = ws; F.R = ws + WS_R; F.ctlf = (float*)(ws + WS_CTL); return F;
}

__device__ __forceinline__ int win_src_col(int n) {
    if (n < 512) return n;
    if (n < 1024) return 1304 + (n - 512);
    if (n < 1536) return 1304 + 512 + (n - 1024);
    if (n < 2304) {
        const int tile = (n - 1536) >> 8, i = (n - 1536) & 255, seg = i >> 6, d = i & 63;
        int branch, kv, hk;
        if (tile == 0) { branch = 1 + (seg >> 1); kv = 0; hk = seg & 1; }
        else if (tile == 1) { branch = 0; kv = seg >> 1; hk = seg & 1; }
        else { branch = 1 + (seg >> 1); kv = 1; hk = seg & 1; }
        return 512 + ((branch * 2 + kv) * 2 + hk) * 64 + d;
    }
    if (n < 2816) return 1304 + 1024 + (n - 2304);
    if (n < 3840) return 2840 + (n - 2816);
    if (n < 5376) return 3864 + (n - 3840);
    const int i = n - 5376;
    if (i < 16) return 5400 + i;
    if (i < 40) return 1280 + (i - 16);
    return -1;
}
template <bool FRAG>
__device__ __forceinline__ void transpose_item(const float* W, int ldw, int srccol, const float* gain, bf16* WT, int K, int n0, int k0, float* scr, int lane) {
#pragma unroll
    for (int i = 0; i < 32; ++i) { const int kk = 2 * i + (lane >> 5);
        float v = 0.f; if (srccol >= 0) v = W[(size_t)(k0 + kk) * ldw + srccol]; if (gain) v *= gain[k0 + kk];
        scr[kk * 33 + (lane & 31)] = v; }
    __builtin_amdgcn_wave_barrier(); LDS_WAIT();
    const int c = lane & 7;
#pragma unroll
    for (int j = 0; j < 4; ++j) { const int n = (lane >> 3) + 8 * j; const float* s = scr + (8 * c) * 33 + n;
        v4u o; o.x = pk2(s[0 * 33], s[1 * 33]); o.y = pk2(s[2 * 33], s[3 * 33]); o.z = pk2(s[4 * 33], s[5 * 33]); o.w = pk2(s[6 * 33], s[7 * 33]);
        if (FRAG) { const int nn = n0 + n, k8 = k0 + 8 * c; *(v4u*)(WT + ((size_t)((nn >> 5) * (K / 16) + (k8 >> 4)) * 64 + 32 * ((k8 >> 3) & 1) + (nn & 31)) * 8) = o; }
        else *(v4u*)(WT + (size_t)(n0 + n) * K + k0 + 8 * c) = o; }
    __builtin_amdgcn_wave_barrier(); LDS_WAIT();
}
template <int MODE>
__device__ __forceinline__ void transpose_item4(const float* W0, const float* W1, int ldw, const float* gain, bf16* WT, int K, int n0, int k0, int lane) {
    const int kc = lane & 3, ng = lane >> 2;
#pragma unroll 1
    for (int sub = 0; sub < 4; ++sub) {
        const int nn = n0 + 64 * sub + 4 * ng;
        const float* W = W0; int col = nn;
        if (MODE == 1) { W = ((nn & 255) >= 128) ? W1 : W0; col = (nn >> 8) * 128 + (nn & 127); }
        if (MODE == 2) col = win_src_col(nn);
#pragma unroll
        for (int ks = 0; ks < 2; ++ks) {
            const int kk = k0 + 32 * ks + 8 * kc;
            const float* src = W + (size_t)kk * ldw + (col >= 0 ? col : 0);
            f32x4 v[8];
#pragma unroll
            for (int i = 0; i < 8; ++i) v[i] = *(const f32x4*)(src + (size_t)i * ldw) * (gain ? gain[kk + i] : 1.0f);
            if (MODE == 2 && col < 0) {
#pragma unroll
                for (int i = 0; i < 8; ++i) v[i] = (f32x4){0.f, 0.f, 0.f, 0.f};
            }
            bf16* drow = WT + (size_t)nn * K + kk;
#pragma unroll
            for (int j = 0; j < 4; ++j) { v4u o; o.x = pk2(v[0][j], v[1][j]); o.y = pk2(v[2][j], v[3][j]); o.z = pk2(v[4][j], v[5][j]); o.w = pk2(v[6][j], v[7][j]);
                *(v4u*)(drow + (size_t)j * K) = o; }
        }
    }
}
__device__ __forceinline__ unsigned pk4_i8(float a, float b, float c, float d) {
    const int ia = __float2int_rn(__builtin_amdgcn_fmed3f(a, -127.f, 127.f)), ib = __float2int_rn(__builtin_amdgcn_fmed3f(b, -127.f, 127.f)), ic = __float2int_rn(__builtin_amdgcn_fmed3f(c, -127.f, 127.f)), id = __float2int_rn(__builtin_amdgcn_fmed3f(d, -127.f, 127.f));
    return (unsigned)(ia & 0xff) | ((unsigned)(ib & 0xff) << 8) | ((unsigned)(ic & 0xff) << 16) | ((unsigned)id << 24);
}
template <int MODE, bool I8 = false>
__device__ __forceinline__ void transpose_item_8(const float* W0, const float* W1, int ldw, const float* gain, unsigned char* WT, int K, int n0, int k0, int lane, float wsc = W8_SCALE) {
    const int kc = lane & 3, ng = lane >> 2;
#pragma unroll 1
    for (int sub = 0; sub < 4; ++sub) {
        const int nn = n0 + 64 * sub + 4 * ng;
        const float* W = W0; int col = nn;
        if (MODE == 1) { W = ((nn & 255) >= 128) ? W1 : W0; col = (nn >> 8) * 128 + (nn & 127); }
        if (MODE == 2) col = win_src_col(nn);
#pragma unroll 1
        for (int ks = 0; ks < 2; ++ks) {
            const int kk = k0 + 64 * ks + 16 * kc;
            const float* src = W + (size_t)kk * ldw + (col >= 0 ? col : 0);
            f32x4 v[16];
#pragma unroll
            for (int i = 0; i < 16; ++i) v[i] = *(const f32x4*)(src + (size_t)i * ldw) * ((gain ? gain[kk + i] : 1.0f) * wsc);
            if (MODE == 2 && col < 0) {
#pragma unroll
                for (int i = 0; i < 16; ++i) v[i] = (f32x4){0.f, 0.f, 0.f, 0.f};
            }
            unsigned char* drow = WT + (size_t)nn * K + kk;
#pragma unroll
            for (int j = 0; j < 4; ++j) { v4u o;
                if (I8) { o.x = pk4_i8(v[0][j], v[1][j], v[2][j], v[3][j]); o.y = pk4_i8(v[4][j], v[5][j], v[6][j], v[7][j]); o.z = pk4_i8(v[8][j], v[9][j], v[10][j], v[11][j]); o.w = pk4_i8(v[12][j], v[13][j], v[14][j], v[15][j]); }
                else { o.x = pk4_fp8(v[0][j], v[1][j], v[2][j], v[3][j]); o.y = pk4_fp8(v[4][j], v[5][j], v[6][j], v[7][j]); o.z = pk4_fp8(v[8][j], v[9][j], v[10][j], v[11][j]); o.w = pk4_fp8(v[12][j], v[13][j], v[14][j], v[15][j]); }
                *(v4u*)(drow + (size_t)j * K) = o; }
        }
    }
}
__device__ __forceinline__ int t5_bucket(int dist) {
    if (dist < 16) return dist;
    return 16 + (dist >= 19) + (dist >= 21) + (dist >= 24) + (dist >= 27) + (dist >= 31) + (dist >= 35) + (dist >= 40) + (dist >= 46) + (dist >= 52) + (dist >= 59)
              + (dist >= 67) + (dist >= 77) + (dist >= 87) + (dist >= 99) + (dist >= 113);
}
struct ProIn { const float *x, *relb, *n1, *g1, *u1, *d1, *nm, *win, *wout, *nnsa, *nsb, *nssd, *n2, *g2, *u2, *d2, *cpos, *cw; };
constexpr unsigned CV_GU(int sg) { return 1u << sg; }
constexpr unsigned CV_DN(int sg) { return 16u << sg; }
constexpr unsigned CV_IN(int l) { return 256u << l; }
constexpr unsigned CV_OUT(int l) { return 1024u << l; }
template <unsigned MASK>
__device__ __forceinline__ void convert_weights(Frame& F, const ProIn I, int gw, int NGW) {
    const int lane = F.lane;
    constexpr int I_GU8 = (D / 128) * (NGU / 256), I_GU16 = (D / 64) * (NGU / 256), I_DN16 = (FF / 64) * (D / 256), I_DN8 = (FF / 128) * (D / 256), I_IN16 = (D / 64) * (NIN / 256), I_IN8 = (D / 128) * (NIN / 256), I_OUT = (D / 64) * (D / 256);
    constexpr int C_GU[4] = {(MASK & 1u) ? ((gu8(0) || gui8(0)) ? I_GU8 : I_GU16) : 0, (MASK & 2u) ? (gu8(1) ? I_GU8 : I_GU16) : 0, (MASK & 4u) ? (gu8(2) ? I_GU8 : I_GU16) : 0, (MASK & 8u) ? (gu8(3) ? I_GU8 : I_GU16) : 0};
    constexpr int C_DN[4] = {(MASK & 16u) ? (dn8(0) ? I_DN8 : I_DN16) : 0, (MASK & 32u) ? (dn8(1) ? I_DN8 : I_DN16) : 0, (MASK & 64u) ? (dn8(2) ? I_DN8 : I_DN16) : 0, (MASK & 128u) ? (dn8(3) ? I_DN8 : I_DN16) : 0};
    constexpr int C_IN[2] = {(MASK & 256u) ? (wini8(0) ? I_IN8 : I_IN16) : 0, (MASK & 512u) ? (wini8(1) ? I_IN8 : I_IN16) : 0};
    constexpr int C_OUT[2] = {(MASK & 1024u) ? I_OUT : 0, (MASK & 2048u) ? I_OUT : 0};
    constexpr int I_ALL = C_GU[0] + C_GU[1] + C_GU[2] + C_GU[3] + C_DN[0] + C_DN[1] + C_DN[2] + C_DN[3] + C_IN[0] + C_IN[1] + C_OUT[0] + C_OUT[1];
    for (int it = gw; it < I_ALL; it += NGW) {
        int r = it; bool done = false;
#pragma unroll
        for (int sg = 0; sg < 4; ++sg) {
            if (C_GU[sg] > 0 && !done && r < C_GU[sg]) {
                const int l = sg >> 1, f = sg & 1;
                const int nb = r % (NGU / 256), kb = r / (NGU / 256), n0 = nb * 256;
                const float* gain = (f == 0 ? I.n1 : I.n2) + (size_t)l * D;
                const float* Wg = (f == 0 ? I.g1 : I.g2) + (size_t)l * D * FF; const float* Wu = (f == 0 ? I.u1 : I.u2) + (size_t)l * D * FF;
                if (gui8(sg)) { const float wmax = __uint_as_float(((const unsigned*)F.ctlf)[CW_WMAX]);
                    transpose_item_8<1, true>(Wg, Wu, FF, gain, (unsigned char*)wptr(F, l, f == 0 ? WL_GU1 : WL_GU2), D, n0, kb * 128, lane, 127.0f / wmax); }
                else if (gu8(sg)) transpose_item_8<1>(Wg, Wu, FF, gain, (unsigned char*)wptr(F, l, f == 0 ? WL_GU1 : WL_GU2), D, n0, kb * 128, lane);
                else transpose_item4<1>(Wg, Wu, FF, gain, wptr(F, l, f == 0 ? WL_GU1 : WL_GU2), D, n0, kb * 64, lane);
                done = true;
            }
            if (!done) r -= C_GU[sg];
        }
        if (done) continue;
#pragma unroll
        for (int sg = 0; sg < 4; ++sg) {
            if (C_DN[sg] > 0 && !done && r < C_DN[sg]) {
                const int l = sg >> 1, f = sg & 1;
                const int nb = r % (D / 256), kb = r / (D / 256), n0 = nb * 256;
                const float* W = (f == 0 ? I.d1 : I.d2) + (size_t)l * FF * D;
                if (dn8(sg)) transpose_item_8<0>(W, W, D, nullptr, (unsigned char*)wptr(F, l, f == 0 ? WL_DN1 : WL_DN2), FF, n0, kb * 128, lane);
                else transpose_item4<0>(W, W, D, nullptr, wptr(F, l, f == 0 ? WL_DN1 : WL_DN2), FF, n0, kb * 64, lane);
                done = true;
            }
            if (!done) r -= C_DN[sg];
        }
        if (done) continue;
#pragma unroll
        for (int l = 0; l < 2; ++l) {
            if (C_IN[l] > 0 && !done && r < C_IN[l]) {
                const int nb = r % (NIN / 256), kb = r / (NIN / 256), n0 = nb * 256, k0 = kb * 64;
                const float* W = I.win + (size_t)l * D * NIN_SRC;
                if (wini8(l)) { const float wmax = __uint_as_float(((const unsigned*)F.ctlf)[CW_WMAX + 1 + l]);
                    transpose_item_8<2, true>(W, W, NIN_SRC, I.nm + (size_t)l * D, (unsigned char*)wptr(F, l, WL_IN), D, n0, kb * 128, lane, 127.0f / wmax); }
                else transpose_item4<2>(W, W, NIN_SRC, I.nm + (size_t)l * D, wptr(F, l, WL_IN), D, n0, k0, lane);
                done = true;
            }
            if (!done) r -= C_IN[l];
        }
        if (done) continue;
#pragma unroll
        for (int l = 0; l < 2; ++l) {
            if (C_OUT[l] > 0 && !done && r < C_OUT[l]) {
                const int nb = r % (D / 256), kb = r / (D / 256), n0 = nb * 256, k0 = kb * 64;
                const float* W = I.wout + (size_t)l * D * D;
                const float* gbase = (k0 < 512) ? I.nnsa + (size_t)l * 512 : (k0 < 1024) ? I.nsb + (size_t)l * 512 - 512 : I.nssd + (size_t)l * 1024 - 1024;
                transpose_item4<0>(W, W, D, gbase, wptr(F, l, WL_OUT), D, n0, k0, lane);
                done = true;
            }
            if (!done) r -= C_OUT[l];
        }
    }
}
constexpr unsigned CVM_PRO = 0xFFFu;
constexpr unsigned CVM_GU[4] = {0u, 0u, 0u, 0u};
constexpr unsigned CVM_WIN[2] = {0u, 0u};
static_assert((CVM_PRO | CVM_GU[0] | CVM_GU[1] | CVM_GU[2] | CVM_GU[3] | CVM_WIN[0] | CVM_WIN[1]) == 0xFFFu, "every matrix converted exactly once");
#ifndef COOP_CVT
#define COOP_CVT 1
#endif
constexpr bool COOP_OK = COOP_CVT && GU_I8 && GU8_MASK == 0xE && DN8_MASK == 0xF && (WIN_I8 & ~2) == 0;
struct CvtStep { const float* src; const float* gain; unsigned char* dst; float wsc; int ldw, K, i8, valid, b16; };
constexpr int CS_INB = (D / 64) * (NIN / 256), CS_OUT = (D / 64) * (D / 256);
constexpr int CS_GU = (D / 128) * (NGU / 256), CS_DN = (FF / 128) * (D / 256), CS_IN = (D / 128) * (NIN / 256);
constexpr int CS_ONE = 4 * CS_GU + 4 * CS_DN + (wini8(1) ? CS_IN : 0);
constexpr int CS_ALL = CS_ONE + (wini8(0) ? 0 : CS_INB) + (wini8(1) ? 0 : CS_INB) + 2 * CS_OUT;
__device__ __forceinline__ CvtStep cvt_decode(const Frame& F, const float* Ig1, const float* Iu1, const float* Id1, const float* Ig2, const float* Iu2, const float* Id2, const float* In1, const float* In2, const float* Inm, const float* Iwin,
                                              const float* Iwout, const float* Innsa, const float* Insb, const float* Inssd, int r, int wave, int lane) {
    CvtStep c; c.valid = 1; c.i8 = 0; c.b16 = 0; c.wsc = W8_SCALE; c.gain = nullptr;
    if (r < 4 * CS_GU) {
        const int sg = r / CS_GU, rr = r % CS_GU, l = sg >> 1, f = sg & 1, nb = rr % (NGU / 256), kb = rr / (NGU / 256), nn = nb * 256 + 4 * lane, k0 = kb * 128;
        const float* W = ((nn & 255) >= 128 ? (f == 0 ? Iu1 : Iu2) : (f == 0 ? Ig1 : Ig2)) + (size_t)l * D * FF;
        c.src = W + (size_t)(k0 + 16 * wave) * FF + (nn >> 8) * 128 + (nn & 127); c.ldw = FF; c.gain = (f == 0 ? In1 : In2) + (size_t)l * D + k0 + 16 * wave;
        c.dst = (unsigned char*)wptr(F, l, f == 0 ? WL_GU1 : WL_GU2) + (size_t)(nb * 256) * D + k0; c.K = D;
        if (sg == 0) { c.i8 = 1; c.wsc = 127.0f / __uint_as_float(((const unsigned*)F.ctlf)[CW_WMAX]); }
    } else if (r < 4 * CS_GU + 4 * CS_DN) {
        const int q = r - 4 * CS_GU, sg = q / CS_DN, rr = q % CS_DN, l = sg >> 1, f = sg & 1, nb = rr % (D / 256), kb = rr / (D / 256), nn = nb * 256 + 4 * lane, k0 = kb * 128;
        c.src = (f == 0 ? Id1 : Id2) + (size_t)l * FF * D + (size_t)(k0 + 16 * wave) * D + nn; c.ldw = D;
        c.dst = (unsigned char*)wptr(F, l, f == 0 ? WL_DN1 : WL_DN2) + (size_t)(nb * 256) * FF + k0; c.K = FF;
    } else if (r >= CS_ONE) {
        int q = r - CS_ONE; c.b16 = 1; c.wsc = 1.0f;
        constexpr int NB16 = (wini8(0) ? 0 : 1) + (wini8(1) ? 0 : 1);
        if (q < NB16 * CS_INB) {
            const int l = (NB16 == 2) ? q / CS_INB : (wini8(0) ? 1 : 0), rr = q % CS_INB, nb = rr % (NIN / 256), kb = rr / (NIN / 256), nn = nb * 256 + 4 * lane, k0 = kb * 64, col = win_src_col(nn);
            c.valid = col >= 0;
            c.src = Iwin + (size_t)l * D * NIN_SRC + (size_t)(k0 + 8 * wave) * NIN_SRC + (col >= 0 ? col : 0); c.ldw = NIN_SRC; c.gain = Inm + (size_t)l * D + k0 + 8 * wave;
            c.dst = (unsigned char*)wptr(F, l, WL_IN) + ((size_t)(nb * 256) * D + k0) * 2; c.K = 2 * D;
        } else {
            q -= NB16 * CS_INB;
            const int l = q / CS_OUT, rr = q % CS_OUT, nb = rr % (D / 256), kb = rr / (D / 256), nn = nb * 256 + 4 * lane, k0 = kb * 64;
            c.src = Iwout + (size_t)l * D * D + (size_t)(k0 + 8 * wave) * D + nn; c.ldw = D;
            c.gain = ((k0 < 512) ? Innsa + (size_t)l * 512 : (k0 < 1024) ? Insb + (size_t)l * 512 - 512 : Inssd + (size_t)l * 1024 - 1024) + k0 + 8 * wave;
            c.dst = (unsigned char*)wptr(F, l, WL_OUT) + ((size_t)(nb * 256) * D + k0) * 2; c.K = 2 * D;
        }
    } else {
        const int rr = r - 4 * CS_GU - 4 * CS_DN, l = 1, nb = rr % (NIN / 256), kb = rr / (NIN / 256), nn = nb * 256 + 4 * lane, k0 = kb * 128, col = win_src_col(nn);
        c.valid = col >= 0;
        c.src = Iwin + (size_t)l * D * NIN_SRC + (size_t)(k0 + 16 * wave) * NIN_SRC + (col >= 0 ? col : 0); c.ldw = NIN_SRC; c.gain = Inm + (size_t)l * D + k0 + 16 * wave;
        c.dst = (unsigned char*)wptr(F, l, WL_IN) + (size_t)(nb * 256) * D + k0; c.K = D;
        c.i8 = 1; c.wsc = 127.0f / __uint_as_float(((const unsigned*)F.ctlf)[CW_WMAX + 1 + l]);
    }
    return c;
}
__device__ __forceinline__ void coop_convert(Frame& F, const ProIn PI) {
    constexpr int LSTR = 144;
    const float *Ig1 = PI.g1, *Iu1 = PI.u1, *Id1 = PI.d1, *Ig2 = PI.g2, *Iu2 = PI.u2, *Id2 = PI.d2, *In1 = PI.n1, *In2 = PI.n2, *Inm = PI.nm, *Iwin = PI.win, *Iwout = PI.wout, *Innsa = PI.nnsa, *Insb = PI.nsb, *Inssd = PI.nssd;
    asm volatile("" : "+s"(Ig1), "+s"(Iu1), "+s"(Id1), "+s"(Ig2), "+s"(Iu2), "+s"(Id2), "+s"(In1), "+s"(In2), "+s"(Inm), "+s"(Iwin), "+s"(Iwout), "+s"(Innsa), "+s"(Insb), "+s"(Inssd));
#define CVT_DECODE(rr) cvt_decode(F, Ig1, Iu1, Id1, Ig2, Iu2, Id2, In1, In2, Inm, Iwin, Iwout, Innsa, Insb, Inssd, (rr), wave, lane)
    LAS unsigned char* const l3 = (LAS unsigned char*)F.lds;
    const int lane = F.lane, wave = F.wave, tid = F.tid;
    int r = F.vcu;
    if (r >= CS_ALL) return;
    CvtStep c = CVT_DECODE(r);
    f32x4 v[16];
#pragma unroll
    for (int i = 0; i < 16; ++i) if (i < 8 || !c.b16) v[i] = *(const f32x4*)(c.src + (size_t)i * c.ldw);
    int buf = 0;
#pragma unroll 1
    for (;;) {
        LAS unsigned char* tile = l3 + buf * (256 * LSTR);
#pragma unroll
        for (int i = 0; i < 16; ++i) if (i < 8 || !c.b16) { const float sc = (c.gain ? c.gain[i] : 1.0f) * c.wsc; v[i] = c.valid ? v[i] * sc : (f32x4){0.f, 0.f, 0.f, 0.f}; }
#pragma unroll
        for (int j = 0; j < 4; ++j) { v4u o;
            if (c.b16) { o.x = pk2(v[0][j], v[1][j]); o.y = pk2(v[2][j], v[3][j]); o.z = pk2(v[4][j], v[5][j]); o.w = pk2(v[6][j], v[7][j]); }
            else if (c.i8) { o.x = pk4_i8(v[0][j], v[1][j], v[2][j], v[3][j]); o.y = pk4_i8(v[4][j], v[5][j], v[6][j], v[7][j]); o.z = pk4_i8(v[8][j], v[9][j], v[10][j], v[11][j]); o.w = pk4_i8(v[12][j], v[13][j], v[14][j], v[15][j]); }
            else { o.x = pk4_fp8(v[0][j], v[1][j], v[2][j], v[3][j]); o.y = pk4_fp8(v[4][j], v[5][j], v[6][j], v[7][j]); o.z = pk4_fp8(v[8][j], v[9][j], v[10][j], v[11][j]); o.w = pk4_fp8(v[12][j], v[13][j], v[14][j], v[15][j]); }
            *(LAS v4u*)(tile + (4 * lane + j) * LSTR + 16 * wave) = o; }
        unsigned char* const dst = c.dst; const int K = c.K;
        const int rn = r + F.G; const bool more = rn < CS_ALL;
        if (more) { c = CVT_DECODE(rn);
#pragma unroll
            for (int i = 0; i < 16; ++i) if (i < 8 || !c.b16) v[i] = *(const f32x4*)(c.src + (size_t)i * c.ldw); }
        asm volatile("s_waitcnt lgkmcnt(0)" ::: "memory"); __builtin_amdgcn_s_barrier(); asm volatile("" ::: "memory");
#pragma unroll
        for (int ps = 0; ps < 4; ++ps) { const int row = (tid >> 3) + 64 * ps, q = tid & 7;
            const v4u w = *(const LAS v4u*)(tile + row * LSTR + 16 * q);
            *(v4u*)(dst + (size_t)row * K + 16 * q) = w; }
        if (!more) break;
        r = rn; buf ^= 1;
    }
#undef CVT_DECODE
    __syncthreads();
}
__device__ __forceinline__ void p_prologue_b(Frame& F, const ProIn I) {
    const int gw = F.vcu * NWAVES + F.wave, NGW = F.G * NWAVES;
    if (COOP_OK) coop_convert(F, I);
    else convert_weights<CVM_PRO>(F, I, gw, NGW);
}
__device__ __forceinline__ void p_prologue(Frame& F, const ProIn I) {
    float* scr = (float*)(F.lds + F.wave * 16384);
    const int gw = F.vcu * NWAVES + F.wave, NGW = F.G * NWAVES, lane = F.lane;
    if (GU_I8 || WIN_I8) {
        float wmx = 0.f, wmi0 = 0.f, wmi1 = 0.f;
        if (WIN_I8)
        for (int it = gw; it < DEPTH * D; it += NGW) {
            const int l = it / D, k = it % D;
            if (!((WIN_I8 >> l) & 1)) continue; const f32x4* wr = (const f32x4*)(I.win + ((size_t)l * D + k) * NIN_SRC); float mx = 0.f;
            constexpr int NV = NIN_SRC / 4;
            f32x4 vv[(NV + 63) / 64];
#pragma unroll
            for (int q = 0; q < (NV + 63) / 64; ++q) { const int idx = lane + 64 * q; vv[q] = (idx < NV) ? wr[idx] : (f32x4){0.f, 0.f, 0.f, 0.f}; }
#pragma unroll
            for (int q = 0; q < (NV + 63) / 64; ++q) mx = fmaxf(fmaxf(mx, fmaxf(fabsf(vv[q][0]), fabsf(vv[q][1]))), fmaxf(fabsf(vv[q][2]), fabsf(vv[q][3])));
            mx = wave_max(mx) * fabsf(I.nm[(size_t)l * D + k]);
            if (l == 0) wmi0 = fmaxf(wmi0, mx); else wmi1 = fmaxf(wmi1, mx);
        }
        if (GU_I8)
        for (int rep_m = 0; rep_m < REP_AMAX; ++rep_m)
        for (int it = gw; it < 2 * D; it += NGW) {
            const int mat = it / D, k = it % D; const float* wr = (mat ? I.u1 : I.g1) + (size_t)k * FF; float mx = 0.f;
            f32x4 vv[FF / 256];
#pragma unroll
            for (int q = 0; q < FF / 256; ++q) vv[q] = *((const f32x4*)wr + lane + 64 * q);
#pragma unroll
            for (int q = 0; q < FF / 256; ++q) mx = fmaxf(fmaxf(mx, fmaxf(fabsf(vv[q][0]), fabsf(vv[q][1]))), fmaxf(fabsf(vv[q][2]), fabsf(vv[q][3])));
            wmx = fmaxf(wmx, wave_max(mx) * fabsf(I.n1[k]));
        }
        float* red = (float*)(F.lds + 131072 - 128);
        if (lane == 0) { red[F.wave] = wmx; red[8 + F.wave] = wmi0; red[16 + F.wave] = wmi1; }
        __syncthreads();
        if (F.tid < 3) { float m8 = red[8 * F.tid];
#pragma unroll
            for (int q = 1; q < NWAVES; ++q) m8 = fmaxf(m8, red[8 * F.tid + q]);
            if (F.tid == 0 ? GU_I8 != 0 : WIN_I8 != 0) atomicMax((unsigned*)F.ctlf + CW_WMAX + F.tid, __float_as_uint(m8)); }
        __syncthreads();
    }
    if (blockIdx.x >= 64 && blockIdx.x < 64 + DEPTH * 2 * 16) {
        const int idx = (int)blockIdx.x - 64, mat = idx & 3, sl = idx >> 2, dd = F.tid & 63, sub = F.tid >> 6;
        const float* w = I.cw + (size_t)mat * 2048 * 64; const float* pos = I.cpos + (size_t)mat * 2048;
        float a = 0.f;
#pragma unroll
        for (int k = 0; k < 16; ++k) { const int kk = sl * 128 + sub * 16 + k; a += pos[kk] * w[kk * 64 + dd]; }
        float* red = (float*)F.lds;
        red[F.tid] = a;
        __syncthreads();
        if (F.tid < 64) { float t = 0.f;
#pragma unroll
            for (int q = 0; q < 8; ++q) t += red[q * 64 + F.tid];
            ((float*)(F.ws + WS_TAB + TAB_PB))[(mat * 16 + sl) * 64 + F.tid] = t; }
        __syncthreads();
    }
    if (F.wave == NWAVES - 1)
    for (int it = F.vcu; it < DEPTH * 2 * 64; it += F.G) {
        const int mat = it >> 6, r = it & 63, nb = r & 1, kb = r >> 1;
        transpose_item<true>(I.cw + (size_t)mat * 2048 * 64, 64, nb * 32 + (lane & 31), nullptr, (bf16*)(F.ws + WS_CW) + (size_t)mat * 64 * 2048, 2048, nb * 32, kb * 64, scr, lane);
    }
    {
        const float* x = I.x; bf16* xb = (bf16*)(F.ws + WS_XB); u64* ss0 = ssptr(F, 0);
        for (int m = gw; m < M; m += NGW) {
            const f32x4* xr = (const f32x4*)(x + (size_t)m * D) + lane; float s = 0.f;
            if (gui8(0)) {
                f32x4 v[8]; float mx = 0.f;
#pragma unroll
                for (int j = 0; j < 8; ++j) { v[j] = xr[64 * j]; s += (v[j][0] * v[j][0] + v[j][1] * v[j][1]) + (v[j][2] * v[j][2] + v[j][3] * v[j][3]); mx = fmaxf(fmaxf(mx, fmaxf(fabsf(v[j][0]), fabsf(v[j][1]))), fmaxf(fabsf(v[j][2]), fabsf(v[j][3]))); }
                mx = fmaxf(wave_max(mx), 1e-30f);
                const float inv = 127.0f / mx;
                unsigned* o = (unsigned*)((unsigned char*)xb + (size_t)m * D) + lane;
#pragma unroll
                for (int j = 0; j < 8; ++j) o[64 * j] = pk4_i8(v[j][0] * inv, v[j][1] * inv, v[j][2] * inv, v[j][3] * inv);
                if (lane == 0) ((float*)(F.ws + WS_TAB + TAB_XS))[m] = mx * (1.0f / 127.0f);
            } else if (gu8(0)) {
                unsigned* o = (unsigned*)((unsigned char*)xb + (size_t)m * D) + lane;
#pragma unroll
                for (int j = 0; j < 8; ++j) { const f32x4 v = xr[64 * j]; s += (v[0] * v[0] + v[1] * v[1]) + (v[2] * v[2] + v[3] * v[3]); o[64 * j] = pk4_fp8(v[0] * X8_SCALE, v[1] * X8_SCALE, v[2] * X8_SCALE, v[3] * X8_SCALE); }
            } else {
                v2u* o = (v2u*)(xb + (size_t)m * D) + lane;
#pragma unroll
                for (int j = 0; j < 8; ++j) { const f32x4 v = xr[64 * j]; s += (v[0] * v[0] + v[1] * v[1]) + (v[2] * v[2] + v[3] * v[3]); v2u w; w.x = pk2(v[0], v[1]); w.y = pk2(v[2], v[3]); o[64 * j] = w; }
            }
            s = wave_sum(s);
            if (lane == 0) ss0[m] = (u64)(s * SS_SCALE + 0.5f);
        }
    }
    if (blockIdx.x == 0) {
        float* tab = (float*)(F.ws + WS_TAB);
        for (int i = F.tid; i < 8 * 129; i += NTHR) { const int h = i / 129, dist = i % 129; tab[i] = I.relb[t5_bucket(dist) * 8 + h] * LOG2E; }
    }
}

typedef short bf16x8 __attribute__((ext_vector_type(8)));
typedef float f32x16 __attribute__((ext_vector_type(16)));
__device__ __forceinline__ unsigned cvtpk(float lo, float hi) { unsigned r; asm volatile("v_cvt_pk_bf16_f32 %0, %1, %2" : "=v"(r) : "v"(lo), "v"(hi)); return r; }
__device__ __forceinline__ bf16x8 mk_frag(v2u a, v2u b) { v4u w; w.x = a.x; w.y = a.y; w.z = b.x; w.w = b.y; return __builtin_bit_cast(bf16x8, w); }
__device__ __forceinline__ bf16x8 acc_frag(const f32x16& x, int s) {
    v4u w;
    if (s == 0) { w.x = cvtpk(x[0], x[1]); w.y = cvtpk(x[2], x[3]); w.z = cvtpk(x[4], x[5]); w.w = cvtpk(x[6], x[7]); }
    else        { w.x = cvtpk(x[8], x[9]); w.y = cvtpk(x[10], x[11]); w.z = cvtpk(x[12], x[13]); w.w = cvtpk(x[14], x[15]); }
    return __builtin_bit_cast(bf16x8, w);
}
#define MFMA32(a, b, c) __builtin_amdgcn_mfma_f32_32x32x16_bf16((a), (b), (c), 0, 0, 0)
template <bool DIAG>
__device__ __forceinline__ void sb_block(f32x16& O0, f32x16& O1, float& Rc, const bf16x8 (&Kc)[4], const bf16x8 (&Vc)[4], const bf16x8 (&Qf)[4], int r, int h) {
    f32x16 S;
#pragma unroll
    for (int i = 0; i < 16; ++i) S[i] = 0.f;
#pragma unroll
    for (int s = 0; s < 4; ++s) S = MFMA32(Kc[s], Qf[s], S);
    f32x4 B4[4], W4[4];
#pragma unroll
    for (int k = 0; k < 4; ++k) {
        f32x4 e4;
#pragma unroll
        for (int c = 0; c < 4; ++c) e4[c] = fexp2(__builtin_amdgcn_fmed3f(S[4 * k + c], -100.f, 100.f));
        const f32x4 d4 = e4 + 1.0f;
        f32x4 w4;
#pragma unroll
        for (int c = 0; c < 4; ++c) w4[c] = frcp(d4[c]);
        f32x4 b4 = e4 * w4;
        if (DIAG) {
#pragma unroll
            for (int c = 0; c < 4; ++c) if (c + 8 * k + 4 * h >= r) { w4[c] = 1.f; b4[c] = 0.f; }
        }
        W4[k] = w4; B4[k] = b4;
    }
    float G[4], oth[4];
#pragma unroll
    for (int k = 0; k < 4; ++k) {
        const float s2 = W4[k][3], s1 = s2 * W4[k][2], s0 = s1 * W4[k][1];
        G[k] = s0 * W4[k][0];
        B4[k] = B4[k] * (f32x4){s0, s1, s2, 1.0f};
    }
#pragma unroll
    for (int k = 0; k < 4; ++k) oth[k] = __shfl_xor(G[k], 32);
    const float EO3 = G[3] * oth[3], EO2 = G[2] * oth[2], EO1 = G[1] * oth[1], EO0 = G[0] * oth[0];
    float Tk[4]; Tk[3] = Rc; Tk[2] = EO3 * Rc; Tk[1] = Tk[2] * EO2; Tk[0] = Tk[1] * EO1;
    Rc = Tk[0] * EO0;
#pragma unroll
    for (int k = 0; k < 4; ++k) { const float sk = h == 0 ? Tk[k] * oth[k] : Tk[k]; B4[k] = B4[k] * sk; }
    v4u p0, p1;
    p0.x = cvtpk(B4[0][0], B4[0][1]); p0.y = cvtpk(B4[0][2], B4[0][3]); p0.z = cvtpk(B4[1][0], B4[1][1]); p0.w = cvtpk(B4[1][2], B4[1][3]);
    p1.x = cvtpk(B4[2][0], B4[2][1]); p1.y = cvtpk(B4[2][2], B4[2][3]); p1.z = cvtpk(B4[3][0], B4[3][1]); p1.w = cvtpk(B4[3][2], B4[3][3]);
    const bf16x8 P0 = __builtin_bit_cast(bf16x8, p0), P1 = __builtin_bit_cast(bf16x8, p1);
    O0 = MFMA32(Vc[0], P0, O0); O0 = MFMA32(Vc[1], P1, O0);
    O1 = MFMA32(Vc[2], P0, O1); O1 = MFMA32(Vc[3], P1, O1);
}
__device__ __forceinline__ void m_sb(Frame& F) {
    const bf16* qs = (const bf16*)(F.R + R_QS); const bf16* ks = (const bf16*)(F.R + R_KS); const bf16* vst = (const bf16*)(F.R + R_VST); float* osb = (float*)(F.R + R_OSB);
    const int lane = F.lane, r = lane & 31, h = lane >> 5;
    for (int unit = F.vcu; unit < 256; unit += F.G) {
        const int b = unit >> 6, p = (unit >> 1) & 31, head = (unit & 1) * 4 + (F.wave & 3);
#pragma unroll 1
        for (int pass = 0; pass < 1; ++pass) {
            const int qt = (F.wave >> 2) ? 63 - p : p;
            bf16x8 Qf[4];
            { const bf16* qrow = qs + (size_t)(b * T + 32 * qt + r) * 512 + head * 64 + 8 * h;
#pragma unroll
              for (int s = 0; s < 4; ++s) Qf[s] = *(const bf16x8*)(qrow + 16 * s); }
            const bf16* kbase = ks + (size_t)(b * 8 + head) * (T * 64) + lane * 8;
            const bf16* vbase = vst + (size_t)(b * 8 + head) * (T * 64) + lane * 8;
            f32x16 O0, O1;
#pragma unroll
            for (int i = 0; i < 16; ++i) { O0[i] = 0.f; O1[i] = 0.f; }
            float Rc = 1.f;
#define SB_LOAD(Kx, Vx, kbx) do { _Pragma("unroll") for (int s = 0; s < 4; ++s) { Kx[s] = *(const bf16x8*)(kbase + (size_t)((kbx) * 4 + s) * 512); Vx[s] = *(const bf16x8*)(vbase + (size_t)((kbx) * 4 + s) * 512); } } while (0)
            bf16x8 Kc[4], Vc[4], Kn[4], Vn[4];
            SB_LOAD(Kn, Vn, qt);
            SB_LOAD(Kc, Vc, (qt > 0 ? qt - 1 : 0));
            sb_block<true>(O0, O1, Rc, Kn, Vn, Qf, r, h);
            int kb = qt - 1;
#pragma unroll 1
            for (; kb >= 1; kb -= 2) {
                if (__all(Rc == 0.f)) { kb = -1; break; }
                SB_LOAD(Kn, Vn, kb - 1);
                sb_block<false>(O0, O1, Rc, Kc, Vc, Qf, r, h);
                SB_LOAD(Kc, Vc, (kb >= 2 ? kb - 2 : 0));
                sb_block<false>(O0, O1, Rc, Kn, Vn, Qf, r, h);
            }
            if (kb == 0) sb_block<false>(O0, O1, Rc, Kc, Vc, Qf, r, h);
#undef SB_LOAD
            float* orow = osb + (size_t)(b * T + 32 * qt + r) * 512 + head * 64 + 4 * h;
#pragma unroll
            for (int k = 0; k < 4; ++k) { *(f32x4*)(orow + 8 * k) = (f32x4){O0[4 * k], O0[4 * k + 1], O0[4 * k + 2], O0[4 * k + 3]};
                                          *(f32x4*)(orow + 32 + 8 * k) = (f32x4){O1[4 * k], O1[4 * k + 1], O1[4 * k + 2], O1[4 * k + 3]}; }
        }
    }
}
template <int MODE>
__device__ __forceinline__ void nsa_block(f32x16& O0, f32x16& O1, float& mrun, float& lrun, const bf16x8 (&Kc)[4], const bf16x8 (&Vc)[4], const bf16x8 (&Qf)[4], const LAS float* tabl, float tab128,
                                          int qt, int kb, unsigned msk, int r, int h) {
    f32x16 S;
#pragma unroll
    for (int i = 0; i < 16; ++i) S[i] = 0.f;
#pragma unroll
    for (int s = 0; s < 4; ++s) S = MFMA32(Kc[s], Qf[s], S);
    const int dq = qt - kb;
    const bool bit = MODE == 0 ? ((msk >> (kb >> 1)) & 1u) != 0u : true;
    const bool fast = MODE == 0 ? dq >= 5 : (dq >= 5 && dq <= 15);
    float bm;
    if (fast) {
        const float boff = bit ? tab128 : -3.0e38f;
        S = S + boff;
        bm = fmaxf(fmaxf(fmaxf(S[0], S[1]), fmaxf(S[2], S[3])), fmaxf(fmaxf(S[4], S[5]), fmaxf(S[6], S[7])));
        bm = fmaxf(bm, fmaxf(fmaxf(fmaxf(S[8], S[9]), fmaxf(S[10], S[11])), fmaxf(fmaxf(S[12], S[13]), fmaxf(S[14], S[15]))));
    } else {
        int d0 = 32 * dq + r - 4 * h;
        asm volatile("" : "+v"(d0));
        bm = -3.0e38f;
#pragma unroll
        for (int i = 0; i < 16; ++i) {
            const int dist = d0 - ((i & 3) + 8 * (i >> 2));
            const bool valid = bit && dist >= 0 && (MODE == 0 || dist < 512);
            const float sv = valid ? S[i] + tabl[dist < 0 ? 0 : (dist > 128 ? 128 : dist)] : -3.0e38f;
            S[i] = sv; bm = fmaxf(bm, sv);
        }
    }
    bm = fmaxf(bm, __shfl_xor(bm, 32));
    const float mnew = fmaxf(mrun, bm);
    if (__any(mnew != mrun)) {
        const float alpha = fexp2(mrun - mnew);
        lrun *= alpha; O0 = O0 * alpha; O1 = O1 * alpha; mrun = mnew;
    }
    if (fast) {
        S = S - mrun;
#pragma unroll
        for (int i = 0; i < 16; ++i) S[i] = fexp2(S[i]);
    } else {
#pragma unroll
        for (int i = 0; i < 16; ++i) S[i] = S[i] > -1.0e38f ? fexp2(S[i] - mrun) : 0.f;
    }
    lrun += ((S[0] + S[1]) + (S[2] + S[3])) + ((S[4] + S[5]) + (S[6] + S[7])) + ((S[8] + S[9]) + (S[10] + S[11])) + ((S[12] + S[13]) + (S[14] + S[15]));
    const bf16x8 P0 = acc_frag(S, 0), P1 = acc_frag(S, 1);
    O0 = MFMA32(Vc[0], P0, O0); O0 = MFMA32(Vc[1], P1, O0);
    O1 = MFMA32(Vc[2], P0, O1); O1 = MFMA32(Vc[3], P1, O1);
}
template <int MODE>
__device__ __forceinline__ void nsa_pass(f32x16& Ot0, f32x16& Ot1, const bf16x8 (&Qf)[4], const bf16* kbase, const bf16* vbase, const LAS float* tabl, int qt, int kb_lo, unsigned msk, float gate, int r, int h) {
    f32x16 O0, O1;
#pragma unroll
    for (int i = 0; i < 16; ++i) { O0[i] = 0.f; O1[i] = 0.f; }
    float mrun = -3.0e38f, lrun = 0.f;
    const float tab128 = tabl[128];
#define NSA_LD(X, base, kbx) do { _Pragma("unroll") for (int s = 0; s < 4; ++s) X[s] = *(const bf16x8*)((base) + (size_t)((kbx) * 4 + s) * 512); } while (0)
    bf16x8 Kc[4], Kn[4], Vc[4];
    NSA_LD(Kc, kbase, kb_lo);
    int kb = kb_lo;
#pragma unroll 1
    for (; kb + 1 <= qt; kb += 2) {
        NSA_LD(Vc, vbase, kb); NSA_LD(Kn, kbase, kb + 1);
        nsa_block<MODE>(O0, O1, mrun, lrun, Kc, Vc, Qf, tabl, tab128, qt, kb, msk, r, h);
        NSA_LD(Vc, vbase, kb + 1); NSA_LD(Kc, kbase, (kb + 2 <= qt ? kb + 2 : qt));
        nsa_block<MODE>(O0, O1, mrun, lrun, Kn, Vc, Qf, tabl, tab128, qt, kb + 1, msk, r, h);
    }
    if (kb == qt) { NSA_LD(Vc, vbase, kb); nsa_block<MODE>(O0, O1, mrun, lrun, Kc, Vc, Qf, tabl, tab128, qt, kb, msk, r, h); }
#undef NSA_LD
    lrun += __shfl_xor(lrun, 32);
    const float sc = gate / lrun;
    Ot0 = Ot0 + O0 * sc; Ot1 = Ot1 + O1 * sc;
}
__device__ __forceinline__ void m_nsa(Frame& F) {
    const bf16* qn = (const bf16*)(F.R + R_QN); const bf16* kn = (const bf16*)(F.R + R_KN); const bf16* vnt = (const bf16*)(F.R + R_VNT);
    const bf16* kc = (const bf16*)(F.R + R_KCMP); const bf16* vct = (const bf16*)(F.R + R_VCMPT); const float* dtg = (const float*)(F.R + R_DTG);
    float* onsa = (float*)(F.R + R_ONSA);
    LAS unsigned char* const l3 = (LAS unsigned char*)F.lds;
    LAS float* PS = (LAS float*)l3;
    LAS unsigned* SEL = (LAS unsigned*)(l3 + 32768);
    LAS float* TAB = (LAS float*)(l3 + 33024);
    LAS float* PINV = (LAS float*)(l3 + 37376);
    volatile LAS unsigned* HB = (volatile LAS unsigned*)(l3 + 38400);
    unsigned hb_target = 0u;
#define HALF_BARRIER() do { asm volatile("s_waitcnt vmcnt(0) lgkmcnt(0)" ::: "memory"); hb_target += 4u; if (lane == 0) __hip_atomic_fetch_add((LAS unsigned*)(HB + 16 * half), 1u, __ATOMIC_RELAXED, __HIP_MEMORY_SCOPE_WORKGROUP); \
        while ((unsigned)__builtin_amdgcn_readfirstlane((int)HB[16 * half]) < hb_target) __builtin_amdgcn_s_sleep(1); asm volatile("" ::: "memory"); } while (0)
    const int lane = F.lane, r = lane & 31, h = lane >> 5, g = F.wave & 3, half = F.wave >> 2;
    { const float* tab = (const float*)(F.ws + WS_TAB); for (int i = F.tid; i < 8 * 129; i += NTHR) TAB[i] = tab[i]; }
    __syncthreads();
    if (F.tid < 32) HB[F.tid] = 0u;
    __syncthreads();
    for (int unit = F.vcu; unit < 256; unit += F.G) {
        const int b = unit >> 6, p = (unit >> 1) & 31, hk = unit & 1, head = hk * 4 + g;
        const LAS float* tabl = TAB + head * 129;
#pragma unroll 1
        for (int pass = 0; pass < 1; ++pass) {
            const int qt = half ? 63 - p : p;
            int ln = lane; asm volatile("" : "+v"(ln));
            const int t = 32 * qt + r, row = b * T + 32 * qt + (ln & 31);
            bf16x8 Qf[4];
            { const bf16* qrow = qn + (size_t)row * 512 + head * 64 + 8 * (ln >> 5);
#pragma unroll
              for (int s = 0; s < 4; ++s) Qf[s] = *(const bf16x8*)(qrow + 16 * s); }
            const float* gl = dtg + (size_t)row * 64 + 16 + head * 3;
            const float g0 = sigmoid_f(gl[0]), g1 = sigmoid_f(gl[1]), g2 = sigmoid_f(gl[2]);
            f32x16 Ot0, Ot1;
            {
                const bf16* kcb = kc + (size_t)(b * 2 + hk) * (128 * 64) + ln * 8;
                float mx = -3.0e38f;
                const int ncb = (qt >> 4) + 1 < 4 ? (qt >> 4) + 1 : 4;
#pragma unroll 1
                for (int cb = 0; cb < ncb; ++cb) {
                    f32x16 S;
#pragma unroll
                    for (int i = 0; i < 16; ++i) S[i] = 0.f;
#pragma unroll
                    for (int s = 0; s < 4; ++s) S = MFMA32(*(const bf16x8*)(kcb + (size_t)(cb * 4 + s) * 512), Qf[s], S);
#pragma unroll
                    for (int i = 0; i < 16; ++i) {
                        const int c = 32 * cb + (i & 3) + 8 * (i >> 2) + 4 * h, dist = t - (16 * c + 31);
                        const bool valid = dist >= 0 && c < 127;
                        const float sv = valid ? S[i] + tabl[dist < 0 ? 0 : (dist > 128 ? 128 : dist)] : -3.0e38f;
                        mx = fmaxf(mx, sv);
                    }
                }
                mx = fmaxf(mx, __shfl_xor(mx, 32));
                const bf16* vcb = vct + (size_t)(b * 2 + hk) * (128 * 64) + ln * 8;
                f32x16 O0, O1;
#pragma unroll
                for (int i = 0; i < 16; ++i) { O0[i] = 0.f; O1[i] = 0.f; }
                float sum = 0.f, carry = 0.f;
                LAS float* psw = PS + ((half * 4 + g) * 32) * 32 + r;
#pragma unroll 1
                for (int cb = 0; cb < 4; ++cb) {
                    f32x16 S;
#pragma unroll
                    for (int i = 0; i < 16; ++i) S[i] = 0.f;
#pragma unroll
                    for (int s = 0; s < 4; ++s) S = MFMA32(*(const bf16x8*)(kcb + (size_t)(cb * 4 + s) * 512), Qf[s], S);
#pragma unroll
                    for (int i = 0; i < 16; ++i) {
                        const int c = 32 * cb + (i & 3) + 8 * (i >> 2) + 4 * h, dist = t - (16 * c + 31);
                        const bool valid = dist >= 0 && c < 127;
                        const float pv = valid ? fexp2(S[i] + tabl[dist < 0 ? 0 : (dist > 128 ? 128 : dist)] - mx) : 0.f;
                        S[i] = pv; sum += pv;
                    }
                    float pco[4];
#pragma unroll
                    for (int k = 0; k < 4; ++k) pco[k] = __shfl_xor(0.5f * S[4 * k + 3], 32);
#pragma unroll
                    for (int k = 0; k < 4; ++k) {
                        const float own = S[4 * k] + S[4 * k + 1] + S[4 * k + 2] + 0.5f * S[4 * k + 3];
                        const float cin = h ? pco[k] : (k > 0 ? pco[k > 0 ? k - 1 : 0] : carry);
                        psw[(8 * cb + 2 * k + h) * 32] = own + cin;
                    }
                    carry = pco[3];
#pragma unroll
                    for (int s = 0; s < 2; ++s) {
                        const bf16x8 Pf = acc_frag(S, s);
                        O0 = MFMA32(*(const bf16x8*)(vcb + (size_t)((cb * 2 + 0) * 2 + s) * 512), Pf, O0);
                        O1 = MFMA32(*(const bf16x8*)(vcb + (size_t)((cb * 2 + 1) * 2 + s) * 512), Pf, O1);
                    }
                }
                sum += __shfl_xor(sum, 32);
                const float inv = sum > 0.f ? 1.0f / sum : 0.f;
                if (h == 0) PINV[(half * 4 + g) * 32 + r] = inv;
                const float gi = g0 * inv;
#pragma unroll
                for (int i = 0; i < 16; ++i) { Ot0[i] = gi * O0[i]; Ot1[i] = gi * O1[i]; }
            }
            HALF_BARRIER();
            {
                const int tt = 8 * g + (ln >> 3), s8 = ln & 7, tq = 32 * qt + tt, cur = tq >> 6;
                const float iv0 = PINV[(half * 4 + 0) * 32 + tt], iv1 = PINV[(half * 4 + 1) * 32 + tt], iv2 = PINV[(half * 4 + 2) * 32 + tt], iv3 = PINV[(half * 4 + 3) * 32 + tt];
                float sc[4];
#pragma unroll
                for (int i = 0; i < 4; ++i) {
                    const int j = s8 + 8 * i;
                    const LAS float* pp = PS + ((half * 4) * 32 + j) * 32 + tt;
                    const float v = (pp[0] * iv0 + pp[1024] * iv1) + (pp[2048] * iv2 + pp[3072] * iv3);
                    sc[i] = (64 * j <= tq) ? v + ((j == 0 || j == cur || j == cur - 1) ? 1000.f : 0.f) : -3.0e38f;
                }
                unsigned mk = 0u;
#pragma unroll 1
                for (int it = 0; it < 8; ++it) {
                    float bv = sc[0]; int bj = s8;
#pragma unroll
                    for (int i = 1; i < 4; ++i) if (sc[i] > bv) { bv = sc[i]; bj = s8 + 8 * i; }
#pragma unroll
                    for (int off = 1; off < 8; off <<= 1) { const float ov = __shfl_xor(bv, off); const int oj = __shfl_xor(bj, off); if (ov > bv || (ov == bv && oj < bj)) { bv = ov; bj = oj; } }
                    if (bv > -1.0e38f) mk |= 1u << bj;
                    const bool mine = (bj & 7) == s8;
#pragma unroll
                    for (int i = 0; i < 4; ++i) sc[i] = (mine && (bj >> 3) == i) ? -3.0e38f : sc[i];
                }
                if (s8 == 0) SEL[half * 32 + tt] = mk;
            }
            HALF_BARRIER();
            const unsigned msk = SEL[half * 32 + r];
            nsa_pass<0>(Ot0, Ot1, Qf, kn + (size_t)(b * 4 + hk) * (T * 64) + ln * 8, vnt + (size_t)(b * 4 + hk) * (T * 64) + ln * 8, tabl, qt, 0, msk, g1, r, h);
            nsa_pass<1>(Ot0, Ot1, Qf, kn + (size_t)(b * 4 + 2 + hk) * (T * 64) + ln * 8, vnt + (size_t)(b * 4 + 2 + hk) * (T * 64) + ln * 8, tabl, qt, qt > 16 ? qt - 16 : 0, 0u, g2, r, h);
            float* orow = onsa + (size_t)row * 512 + head * 64 + 4 * (ln >> 5);
#pragma unroll
            for (int k = 0; k < 4; ++k) { *(f32x4*)(orow + 8 * k) = (f32x4){Ot0[4 * k], Ot0[4 * k + 1], Ot0[4 * k + 2], Ot0[4 * k + 3]};
                                          *(f32x4*)(orow + 32 + 8 * k) = (f32x4){Ot1[4 * k], Ot1[4 * k + 1], Ot1[4 * k + 2], Ot1[4 * k + 3]}; }
            HALF_BARRIER();
        }
    }
}
#undef HALF_BARRIER
__device__ __forceinline__ void m_compress(Frame& F, int layer) {
    const bf16* raw = (const bf16*)(F.R + R_CMPRAW); bf16* kc = (bf16*)(F.R + R_KCMP); bf16* vct = (bf16*)(F.R + R_VCMPT);
    LAS float* RED = (LAS float*)(LAS unsigned char*)F.lds;
    const int lane = F.lane, r = lane & 31, h = lane >> 5, w = F.wave;
    for (int item = F.vcu; item < 64; item += F.G) {
        const int ct = item & 3, hk = (item >> 2) & 1, b = (item >> 3) & 3, kind = item >> 5, mat = layer * 2 + kind;
        const bf16* ap = raw + ((size_t)(((kind * 2 + hk) * 4 + b) * 4 + ct) * 128 + 16 * w) * 512 + lane * 8;
        const bf16* bp = (const bf16*)(F.ws + WS_CW) + (size_t)mat * (64 * 2048) + (size_t)(16 * w) * 512 + lane * 8;
        f32x16 a0, a1;
        for (int rep_a = 0; rep_a < REP_CMPA; ++rep_a) {
#pragma unroll
        for (int i = 0; i < 16; ++i) { a0[i] = 0.f; a1[i] = 0.f; }
#pragma unroll 8
        for (int s = 0; s < 16; ++s) {
            const bf16x8 af = *(const bf16x8*)(ap + (size_t)s * 512);
            a0 = MFMA32(af, *(const bf16x8*)(bp + (size_t)s * 512), a0);
            a1 = MFMA32(af, *(const bf16x8*)(bp + (size_t)(128 + s) * 512), a1);
        }
        }
        for (int rep_b = 0; rep_b < REP_CMPB; ++rep_b) {
#pragma unroll
        for (int i = 0; i < 16; ++i) { RED[((w * 2 + 0) * 16 + i) * 64 + lane] = a0[i]; RED[((w * 2 + 1) * 16 + i) * 64 + lane] = a1[i]; }
        __syncthreads();
        const float* pb = (const float*)(F.ws + WS_TAB + TAB_PB) + mat * 16 * 64;
#pragma unroll
        for (int q = 0; q < 4; ++q) {
            const int o = F.tid + NTHR * q, ln = o & 63, i = (o >> 6) & 15, dt = o >> 10;
            float sum = 0.f, pbv = 0.f;
#pragma unroll
            for (int sl = 0; sl < 16; ++sl) pbv += pb[sl * 64 + 32 * dt + (ln & 31)];
#pragma unroll
            for (int ww = 0; ww < 8; ++ww) sum += RED[((ww * 2 + dt) * 16 + i) * 64 + ln];
            const int c = 32 * ct + (i & 3) + 8 * (i >> 2) + 4 * (ln >> 5), dd = 32 * dt + (ln & 31);
            const float val = c < 127 ? sum + pbv : 0.f;
            if (kind == 0) kc[(size_t)(b * 2 + hk) * (128 * 64) + kfrag_off(c, dd & ~7) + (dd & 7)] = (bf16)f2bf(val);
            else vct[(size_t)(b * 2 + hk) * (128 * 64) + vfrag_off(c, dd)] = (bf16)f2bf(val);
        }
        __syncthreads();
        }
    }
}
constexpr int SL = 64, SNC = T / SL;
__device__ __forceinline__ void m_ssd_s1(Frame& F, int layer, const float* conv_w, const float* conv_b, const float* dt_bias, const float* a_log) {
    const bf16* xbc = (const bf16*)(F.R + R_XBC); const float* dtg = (const float*)(F.R + R_DTG);
    bf16* xt = (bf16*)(F.R + R_XT); bf16* bm = (bf16*)(F.R + R_BM); bf16* cm = (bf16*)(F.R + R_CM); float* dtb = (float*)(F.R + R_DT); float* acsb = (float*)(F.R + R_ACS); float* aend = (float*)(F.R + R_AEND);
    bf16* st = (bf16*)(F.R + R_ST);
    const float* cw = conv_w + (size_t)layer * 4 * 1536; const float* cb = conv_b + (size_t)layer * 1536;
    LAS unsigned char* const l3 = (LAS unsigned char*)F.lds;
    LAS bf16* XTL = (LAS bf16*)l3;
    LAS bf16* BMTL = (LAS bf16*)(l3 + 73728);
    LAS float* SCL = (LAS float*)(l3 + 92160);
    const int lane = F.lane, r = lane & 31, h = lane >> 5, e = F.wave;
    for (int item = F.vcu; item < BATCH * SNC * 2; item += F.G) {
        const int g = item & 1, c = (item >> 1) & (SNC - 1), b = item >> 6, t0 = c * SL;
        for (int rep_a = 0; rep_a < REP_S1A; ++rep_a)
#pragma unroll 1
        for (int id = F.tid; id < 96 * 16; id += NTHR) {
            const int c8 = id % 96, q = id / 96;
            const int col = c8 < 64 ? 512 * g + 8 * c8 : (c8 < 80 ? 1024 + 128 * g + 8 * (c8 - 64) : 1280 + 128 * g + 8 * (c8 - 80));
            float u[7][8];
#pragma unroll
            for (int i = 0; i < 7; ++i) {
                const int tt = t0 + 4 * q - 3 + i;
                v4u w = (v4u){0u, 0u, 0u, 0u};
                if (tt >= 0) w = *(const v4u*)(xbc + ((size_t)b * T + tt) * 1536 + col);
                u[i][0] = __uint_as_float(w.x << 16); u[i][1] = __uint_as_float(w.x & 0xffff0000u); u[i][2] = __uint_as_float(w.y << 16); u[i][3] = __uint_as_float(w.y & 0xffff0000u);
                u[i][4] = __uint_as_float(w.z << 16); u[i][5] = __uint_as_float(w.z & 0xffff0000u); u[i][6] = __uint_as_float(w.w << 16); u[i][7] = __uint_as_float(w.w & 0xffff0000u);
            }
            float wk[4][8], bias[8];
#pragma unroll
            for (int k = 0; k < 4; ++k) { const f32x4 a0 = *(const f32x4*)(cw + k * 1536 + col), a1 = *(const f32x4*)(cw + k * 1536 + col + 4);
                wk[k][0] = a0[0]; wk[k][1] = a0[1]; wk[k][2] = a0[2]; wk[k][3] = a0[3]; wk[k][4] = a1[0]; wk[k][5] = a1[1]; wk[k][6] = a1[2]; wk[k][7] = a1[3]; }
            { const f32x4 a0 = *(const f32x4*)(cb + col), a1 = *(const f32x4*)(cb + col + 4);
              bias[0] = a0[0]; bias[1] = a0[1]; bias[2] = a0[2]; bias[3] = a0[3]; bias[4] = a1[0]; bias[5] = a1[1]; bias[6] = a1[2]; bias[7] = a1[3]; }
            float y[4][8];
#pragma unroll
            for (int j = 0; j < 4; ++j)
#pragma unroll
                for (int i = 0; i < 8; ++i) y[j][i] = silu_f(bias[i] + wk[0][i] * u[j][i] + wk[1][i] * u[j + 1][i] + wk[2][i] * u[j + 2][i] + wk[3][i] * u[j + 3][i]);
            if (c8 < 64) {
                const int he = c8 >> 3, p0 = 8 * (c8 & 7);
#pragma unroll
                for (int i = 0; i < 8; ++i) { v2u pk; pk.x = pk2(y[0][i], y[1][i]); pk.y = pk2(y[2][i], y[3][i]);
                    *(LAS v2u*)(XTL + (he * 64 + p0 + i) * 72 + 4 * q) = pk;
                    *(v2u*)(xt + ((size_t)(b * 16 + 8 * g + he) * 64 + p0 + i) * T + t0 + 4 * q) = pk; }
            } else {
                const int n0 = 8 * (c8 < 80 ? c8 - 64 : c8 - 80);
                if (c8 < 80) {
#pragma unroll
                    for (int i = 0; i < 8; ++i) { v2u pk; pk.x = pk2(y[0][i], y[1][i]); pk.y = pk2(y[2][i], y[3][i]); *(LAS v2u*)(BMTL + (n0 + i) * 72 + 4 * q) = pk; }
                }
                bf16* dst = (c8 < 80 ? bm : cm) + ((size_t)((((b * 2 + g) * SNC + c) * 2 + (q >> 3)) * 8 + (n0 >> 4)) * 64 + 32 * ((n0 >> 3) & 1) + 4 * (q & 7)) * 8;
#pragma unroll
                for (int j = 0; j < 4; ++j) { v4u pk; pk.x = pk2(y[j][0], y[j][1]); pk.y = pk2(y[j][2], y[j][3]); pk.z = pk2(y[j][4], y[j][5]); pk.w = pk2(y[j][6], y[j][7]); *(v4u*)(dst + 8 * j) = pk; }
            }
        }
        for (int rep_b = 0; rep_b < REP_S1B; ++rep_b) {
            const int hd = 8 * g + e;
            const float v = dtg[((size_t)b * T + t0 + lane) * 64 + hd] + dt_bias[layer * 16 + hd];
            const float dtv = v > 20.f ? v : log1pf(expf(v));
            const float a = -expf(a_log[layer * 16 + hd]);
            float cs = dtv * a;
#pragma unroll
            for (int off = 1; off < 64; off <<= 1) { const float up = __shfl_up(cs, off); if (lane >= off) cs += up; }
            const float cend = __shfl(cs, 63);
            dtb[(size_t)(b * 16 + hd) * T + t0 + lane] = dtv; acsb[(size_t)(b * 16 + hd) * T + t0 + lane] = cs;
            if (lane == 0) aend[(size_t)(b * 16 + hd) * SNC + c] = cend;
            SCL[e * 64 + lane] = dtv * fexp2((cend - cs) * LOG2E);
        }
        __syncthreads();
        for (int rep_c = 0; rep_c < REP_S1C; ++rep_c)
#pragma unroll 1
        for (int nh = 0; nh < 2; ++nh) {
            f32x16 acc[2][2];
#pragma unroll
            for (int a = 0; a < 2; ++a)
#pragma unroll
                for (int q = 0; q < 2; ++q)
#pragma unroll
                    for (int i = 0; i < 16; ++i) acc[a][q][i] = 0.f;
#pragma unroll
            for (int s = 0; s < 4; ++s) {
                bf16x8 Af[2], Bf[2];
#pragma unroll
                for (int pt = 0; pt < 2; ++pt) Af[pt] = *(const LAS bf16x8*)(XTL + (e * 64 + 32 * pt + r) * 72 + 16 * s + 8 * h);
                const f32x4 sc0 = *(const LAS f32x4*)(SCL + e * 64 + 16 * s + 8 * h), sc1 = *(const LAS f32x4*)(SCL + e * 64 + 16 * s + 8 * h + 4);
#pragma unroll
                for (int nt = 0; nt < 2; ++nt) {
                    const v4u raw = *(const LAS v4u*)(BMTL + (64 * nh + 32 * nt + r) * 72 + 16 * s + 8 * h);
                    v4u w;
                    w.x = cvtpk(__uint_as_float(raw.x << 16) * sc0[0], __uint_as_float(raw.x & 0xffff0000u) * sc0[1]);
                    w.y = cvtpk(__uint_as_float(raw.y << 16) * sc0[2], __uint_as_float(raw.y & 0xffff0000u) * sc0[3]);
                    w.z = cvtpk(__uint_as_float(raw.z << 16) * sc1[0], __uint_as_float(raw.z & 0xffff0000u) * sc1[1]);
                    w.w = cvtpk(__uint_as_float(raw.w << 16) * sc1[2], __uint_as_float(raw.w & 0xffff0000u) * sc1[3]);
                    Bf[nt] = __builtin_bit_cast(bf16x8, w);
                }
#pragma unroll
                for (int pt = 0; pt < 2; ++pt)
#pragma unroll
                    for (int nt = 0; nt < 2; ++nt) acc[pt][nt] = MFMA32(Af[pt], Bf[nt], acc[pt][nt]);
            }
            bf16* sp = st + ((size_t)((b * SNC + c) * 16 + 8 * g + e) * 64) * 128 + 64 * nh + r;
#pragma unroll
            for (int pt = 0; pt < 2; ++pt)
#pragma unroll
                for (int nt = 0; nt < 2; ++nt)
#pragma unroll
                    for (int i = 0; i < 16; ++i) sp[(size_t)(32 * pt + (i & 3) + 8 * (i >> 2) + 4 * h) * 128 + 32 * nt] = (bf16)f2bf(acc[pt][nt][i]);
        }
        __syncthreads();
    }
}
__device__ __forceinline__ void m_ssd_s2(Frame& F) {
    const bf16* st = (const bf16*)(F.R + R_ST); const float* aend = (const float*)(F.R + R_AEND); bf16* hin = (bf16*)(F.R + R_HIN);
    for (int gid = F.vcu * NTHR + F.tid; gid < BATCH * 16 * 64 * 32; gid += F.G * NTHR) {
        const int n4 = gid & 31, p = (gid >> 5) & 63, hd = (gid >> 11) & 15, b = gid >> 15;
        f32x4 hv = (f32x4){0.f, 0.f, 0.f, 0.f};
        const size_t cstride = (size_t)16 * 64 * 128;
        size_t off = ((size_t)(b * SNC * 16 + hd) * 64 + p) * 128 + 4 * n4;
        size_t hoff = (size_t)(b * SNC * 16 + hd) * (64 * 128) + ((size_t)((p >> 5) * 8 + (n4 >> 2)) * 64 + 32 * ((n4 >> 1) & 1) + (p & 31)) * 8 + 4 * (n4 & 1);
#pragma unroll
        for (int c = 0; c < SNC; ++c) {
            v2u w; w.x = pk2(hv[0], hv[1]); w.y = pk2(hv[2], hv[3]);
            *(v2u*)(hin + hoff) = w; hoff += cstride;
            const float dec = fexp2(aend[(size_t)(b * 16 + hd) * SNC + c] * LOG2E);
            const v2u sw = *(const v2u*)(st + off);
            const f32x4 sv = (f32x4){__uint_as_float(sw.x << 16), __uint_as_float(sw.x & 0xffff0000u), __uint_as_float(sw.y << 16), __uint_as_float(sw.y & 0xffff0000u)};
            hv = hv * dec + sv; off += cstride;
        }
    }
}
__device__ __forceinline__ void m_ssd_s3(Frame& F, int layer, const float* d_skip) {
    const bf16* xt = (const bf16*)(F.R + R_XT); const bf16* bm = (const bf16*)(F.R + R_BM); const bf16* cm = (const bf16*)(F.R + R_CM); const float* dtb = (const float*)(F.R + R_DT); const float* acsb = (const float*)(F.R + R_ACS);
    const bf16* hin = (const bf16*)(F.R + R_HIN); const bf16* zb = (const bf16*)(F.R + R_Z); bf16* mixed = (bf16*)(F.R + R_MIXED);
    LAS unsigned char* const l3 = (LAS unsigned char*)F.lds;
    LAS float* DTL = (LAS float*)l3;
    LAS float* ACL = (LAS float*)(l3 + 2048);
    LAS float* SSQ = (LAS float*)(l3 + 4096);
    const int lane = F.lane, r = lane & 31, h = lane >> 5, e = F.wave;
    for (int item = F.vcu; item < BATCH * SNC * 2; item += F.G) {
        const int g = item & 1, c = (item >> 1) & (SNC - 1), b = item >> 6, t0 = c * SL, hd = 8 * g + e;
        DTL[e * 64 + lane] = dtb[(size_t)(b * 16 + hd) * T + t0 + lane];
        ACL[e * 64 + lane] = acsb[(size_t)(b * 16 + hd) * T + t0 + lane];
        f32x16 cbt[3], yo[2][2];
#pragma unroll
        for (int i = 0; i < 16; ++i) { cbt[0][i] = 0.f; cbt[1][i] = 0.f; cbt[2][i] = 0.f; yo[0][0][i] = 0.f; yo[0][1][i] = 0.f; yo[1][0][i] = 0.f; yo[1][1][i] = 0.f; }
        const bf16* bmp = bm + (size_t)((b * 2 + g) * SNC + c) * (64 * 128) + lane * 8;
        const bf16* cmp_ = cm + (size_t)((b * 2 + g) * SNC + c) * (64 * 128) + lane * 8;
        const bf16* hp = hin + (size_t)((b * SNC + c) * 16 + hd) * (64 * 128) + lane * 8;
#pragma unroll 4
        for (int k = 0; k < 8; ++k) {
            const bf16x8 b0 = *(const bf16x8*)(bmp + (size_t)k * 512), b1 = *(const bf16x8*)(bmp + (size_t)(8 + k) * 512);
            const bf16x8 c0 = *(const bf16x8*)(cmp_ + (size_t)k * 512), c1 = *(const bf16x8*)(cmp_ + (size_t)(8 + k) * 512);
            const bf16x8 h0 = *(const bf16x8*)(hp + (size_t)k * 512), h1 = *(const bf16x8*)(hp + (size_t)(8 + k) * 512);
            cbt[0] = MFMA32(b0, c0, cbt[0]); cbt[1] = MFMA32(b0, c1, cbt[1]); cbt[2] = MFMA32(b1, c1, cbt[2]);
            yo[0][0] = MFMA32(h0, c0, yo[0][0]); yo[0][1] = MFMA32(h0, c1, yo[0][1]); yo[1][0] = MFMA32(h1, c0, yo[1][0]); yo[1][1] = MFMA32(h1, c1, yo[1][1]);
        }
        __builtin_amdgcn_wave_barrier(); LDS_WAIT();
        const float Dk = d_skip[layer * 16 + hd];
        const float acl0 = ACL[e * 64 + r], acl1 = ACL[e * 64 + 32 + r];
        { const float e0 = fexp2(acl0 * LOG2E), e1 = fexp2(acl1 * LOG2E);
#pragma unroll
          for (int i = 0; i < 16; ++i) { yo[0][0][i] *= e0; yo[1][0][i] *= e0; yo[0][1][i] *= e1; yo[1][1][i] *= e1; } }
#pragma unroll
        for (int tl = 0; tl < 3; ++tl) {
            const int stl = tl == 2 ? 1 : 0, ltl = tl == 0 ? 0 : 1;
            const float al = ltl ? acl1 : acl0;
#pragma unroll
            for (int i = 0; i < 16; ++i) {
                const int sidx = 32 * stl + (i & 3) + 8 * (i >> 2) + 4 * h, lidx = 32 * ltl + r;
                const float as = ACL[e * 64 + sidx], ds = DTL[e * 64 + sidx];
                float v = sidx <= lidx ? cbt[tl][i] * fexp2((al - as) * LOG2E) * ds : 0.f;
                if (sidx == lidx) v += Dk;
                cbt[tl][i] = v;
            }
        }
        const bf16* xp = xt + ((size_t)(b * 16 + hd) * 64 + r) * T + t0 + 4 * h;
#pragma unroll
        for (int pt = 0; pt < 2; ++pt) {
            const bf16* xq = xp + (size_t)(32 * pt) * T;
#pragma unroll
            for (int k2 = 0; k2 < 2; ++k2) {
                const bf16x8 a0 = mk_frag(*(const v2u*)(xq + 16 * k2), *(const v2u*)(xq + 16 * k2 + 8));
                const bf16x8 a1 = mk_frag(*(const v2u*)(xq + 32 + 16 * k2), *(const v2u*)(xq + 32 + 16 * k2 + 8));
                yo[pt][0] = MFMA32(a0, acc_frag(cbt[0], k2), yo[pt][0]);
                yo[pt][1] = MFMA32(a0, acc_frag(cbt[1], k2), yo[pt][1]);
                yo[pt][1] = MFMA32(a1, acc_frag(cbt[2], k2), yo[pt][1]);
            }
        }
        float ssq[2] = {0.f, 0.f};
#pragma unroll
        for (int lt = 0; lt < 2; ++lt) {
            const bf16* zp = zb + ((size_t)b * T + t0 + 32 * lt + r) * 1024 + hd * 64 + 4 * h;
#pragma unroll
            for (int pt = 0; pt < 2; ++pt)
#pragma unroll
                for (int k = 0; k < 4; ++k) {
                    const v2u zz = *(const v2u*)(zp + 32 * pt + 8 * k);
                    const float z0 = __uint_as_float(zz.x << 16), z1 = __uint_as_float(zz.x & 0xffff0000u), z2 = __uint_as_float(zz.y << 16), z3 = __uint_as_float(zz.y & 0xffff0000u);
                    float v0 = yo[pt][lt][4 * k] * silu_f(z0), v1 = yo[pt][lt][4 * k + 1] * silu_f(z1), v2 = yo[pt][lt][4 * k + 2] * silu_f(z2), v3 = yo[pt][lt][4 * k + 3] * silu_f(z3);
                    yo[pt][lt][4 * k] = v0; yo[pt][lt][4 * k + 1] = v1; yo[pt][lt][4 * k + 2] = v2; yo[pt][lt][4 * k + 3] = v3;
                    ssq[lt] += (v0 * v0 + v1 * v1) + (v2 * v2 + v3 * v3);
                }
            ssq[lt] += __shfl_xor(ssq[lt], 32);
        }
        if (h == 0) { SSQ[e * 64 + r] = ssq[0]; SSQ[e * 64 + 32 + r] = ssq[1]; }
        __syncthreads();
#pragma unroll
        for (int lt = 0; lt < 2; ++lt) {
            float tot = 0.f;
#pragma unroll
            for (int w = 0; w < 8; ++w) tot += SSQ[w * 64 + 32 * lt + r];
            const float rs = rsqrtf(tot * (1.0f / 512.0f) + EPS);
            bf16* mp = mixed + ((size_t)b * T + t0 + 32 * lt + r) * D + 1024 + hd * 64 + 4 * h;
#pragma unroll
            for (int pt = 0; pt < 2; ++pt)
#pragma unroll
                for (int k = 0; k < 4; ++k) { v2u w; w.x = pk2(yo[pt][lt][4 * k] * rs, yo[pt][lt][4 * k + 1] * rs); w.y = pk2(yo[pt][lt][4 * k + 2] * rs, yo[pt][lt][4 * k + 3] * rs); *(v2u*)(mp + 32 * pt + 8 * k) = w; }
        }
        __syncthreads();
    }
}
__device__ __forceinline__ void m_norms2(Frame& F) {
    const float* onsa = (const float*)(F.R + R_ONSA); const float* osb = (const float*)(F.R + R_OSB); bf16* mixed = (bf16*)(F.R + R_MIXED);
    const int gw = F.vcu * NWAVES + F.wave, NGW = F.G * NWAVES, lane = F.lane;
    for (int w0 = gw; w0 < M * 2; w0 += 4 * NGW) {
        f32x4 v0[4], v1[4];
#pragma unroll
        for (int q = 0; q < 4; ++q) { const int w = w0 + q * NGW, ww = w < M * 2 ? w : w0; const int seg = ww & 1, row = ww >> 1;
            const float* src = (seg == 0 ? onsa : osb) + (size_t)row * 512;
            v0[q] = *((const f32x4*)src + lane); v1[q] = *((const f32x4*)src + 64 + lane); }
#pragma unroll
        for (int q = 0; q < 4; ++q) { const int w = w0 + q * NGW; if (w >= M * 2) break; const int seg = w & 1, row = w >> 1;
            float sq = (v0[q][0] * v0[q][0] + v0[q][1] * v0[q][1]) + (v0[q][2] * v0[q][2] + v0[q][3] * v0[q][3]) + (v1[q][0] * v1[q][0] + v1[q][1] * v1[q][1]) + (v1[q][2] * v1[q][2] + v1[q][3] * v1[q][3]);
            sq = wave_sum(sq);
            const float rr = rsqrtf(sq * (1.0f / 512.0f) + EPS);
            bf16* dst = mixed + (size_t)row * D + seg * 512;
            v2u w0_; w0_.x = pk2(v0[q][0] * rr, v0[q][1] * rr); w0_.y = pk2(v0[q][2] * rr, v0[q][3] * rr); *((v2u*)dst + lane) = w0_;
            v2u w1_; w1_.x = pk2(v1[q][0] * rr, v1[q][1] * rr); w1_.y = pk2(v1[q][2] * rr, v1[q][3] * rr); *((v2u*)dst + 64 + lane) = w1_; }
    }
}
__device__ __forceinline__ void p_quant_x(Frame& F) {
    const int gw = F.vcu * NWAVES + F.wave, NGW = F.G * NWAVES, lane = F.lane;
    float* xsc = (float*)(F.ws + WS_TAB + TAB_XS);
    for (int m = gw; m < M; m += 2 * NGW) {
        const int m2 = m + NGW; const bool two = m2 < M;
        const f32x4* xr = (const f32x4*)(F.out + (size_t)m * D) + lane; const f32x4* xr2 = (const f32x4*)(F.out + (size_t)(two ? m2 : m) * D) + lane;
        f32x4 v[8], w[8]; float mx = 0.f, mx2 = 0.f;
#pragma unroll
        for (int j = 0; j < 8; ++j) { v[j] = xr[64 * j]; w[j] = xr2[64 * j]; }
#pragma unroll
        for (int j = 0; j < 8; ++j) { mx = fmaxf(fmaxf(mx, fmaxf(fabsf(v[j][0]), fabsf(v[j][1]))), fmaxf(fabsf(v[j][2]), fabsf(v[j][3])));
                                      mx2 = fmaxf(fmaxf(mx2, fmaxf(fabsf(w[j][0]), fabsf(w[j][1]))), fmaxf(fabsf(w[j][2]), fabsf(w[j][3]))); }
        mx = fmaxf(wave_max(mx), 1e-30f); mx2 = fmaxf(wave_max(mx2), 1e-30f);
        const float inv = 127.0f / mx, inv2 = 127.0f / mx2;
        unsigned* o = (unsigned*)(F.ws + WS_XB + (size_t)m * D) + lane;
#pragma unroll
        for (int j = 0; j < 8; ++j) o[64 * j] = pk4_i8(v[j][0] * inv, v[j][1] * inv, v[j][2] * inv, v[j][3] * inv);
        if (lane == 0) xsc[m] = mx * (1.0f / 127.0f);
        if (two) {
            unsigned* o2 = (unsigned*)(F.ws + WS_XB + (size_t)m2 * D) + lane;
#pragma unroll
            for (int j = 0; j < 8; ++j) o2[64 * j] = pk4_i8(w[j][0] * inv2, w[j][1] * inv2, w[j][2] * inv2, w[j][3] * inv2);
            if (lane == 0) xsc[m2] = mx2 * (1.0f / 127.0f);
        }
    }
}
__device__ __forceinline__ void p_final(Frame& F, const float* gain) {
    const u64* ssf = ssptr(F, 6);
    const int gw = F.vcu * NWAVES + F.wave, NGW = F.G * NWAVES, lane = F.lane;
    for (int m = gw; m < M; m += NGW) {
        const float r = rstd_of(ssf[m]);
        f32x4* xr = (f32x4*)(F.out + (size_t)m * D) + lane;
#pragma unroll
        for (int j = 0; j < 8; ++j) { const f32x4 g = *((const f32x4*)gain + 64 * j + lane); f32x4 v = xr[64 * j]; v = v * r * g; xr[64 * j] = v; }
    }
}

#define SEG_BODY(SEGNO) do { constexpr int seg = (SEGNO); \
        const int layer = seg >> 1, second = seg & 1; \
        if (IN_PH()) { \
            FRAME(); \
            { pg8::Gemm g{(const bf16*)(F.ws + WS_XB), wptr(F, layer, second ? WL_GU2 : WL_GU1), M, NGU, (gu8(seg) || gui8(seg)) ? D / 2 : D}; pg8::StaticOrder S; S.init(M, NGU, F.G, F.vcu); \
            EpiGateUp E{(bf16*)(F.R + R_H), ssptr(F, 3 * layer + (second ? 2 : 0)), gui8(seg) ? __uint_as_float(((const unsigned*)F.ctlf)[CW_WMAX]) * (1.0f / 127.0f) : (gu8(seg) ? GU8_UNSCALE : 1.0f), dn8(seg) ? 1 : 0, \
                        (const float*)(F.ws + WS_TAB + TAB_XS), gui8(seg) ? 1 : 0}; \
            REPEAT(REP_GU, pg8::gemm_phase<EpiGateUp, pg8::StaticOrder, true, GEMM_SP2, gui8(seg) ? 2 : (gu8(seg) ? 1 : 0)>(glds, g, S, E)); } \
            if (CVM_GU[seg] != 0u && F.vcu >= F.G / 2) { \
                KArgs kb = kargs(); Frame F2 = make_frame(kb->ws, kb->out, lds); \
                ProIn I{kb->in[0], kb->in[1], kb->in[2], kb->in[3], kb->in[4], kb->in[5], kb->in[6], kb->in[7], kb->in[8], kb->in[11], kb->in[12], kb->in[18], kb->in[19], kb->in[20], kb->in[21], kb->in[22], kb->in[9], kb->in[10]}; \
                convert_weights<CVM_GU[seg]>(F2, I, (F2.vcu - F2.G / 2) * NWAVES + F2.wave, (F2.G / 2) * NWAVES); \
            } \
        } \
        END_PH(); \
        if (IN_PH()) { \
            FRAME(); \
            pg8::Gemm g{(const bf16*)(F.R + R_H), wptr(F, layer, second ? WL_DN2 : WL_DN1), M, D, dn8(seg) ? FF / 2 : FF}; pg8::StaticOrder S; S.init(M, D, F.G, F.vcu); \
            if (FUSE_X && seg == 3) { \
                EpiResidFin E{(const float*)F.out, F.out, INP(23), dn8(seg) ? 0.5f * DN8_UNSCALE : 0.5f, PanelX{(float*)(F.ws + WS_TAB + TAB_PX) + (size_t)M * 8, (unsigned*)F.ctlf + CW_PX + 2048}}; \
                pg8::gemm_phase<EpiResidFin, pg8::StaticOrder, true, GEMM_SP2, dn8(seg) ? 1 : 0>(glds, g, S, E); \
            } else if (FUSE_X && !second && wini8(layer)) { \
                EpiResidQ8 E{seg == 0 ? INP(0) : (const float*)F.out, F.out, (unsigned char*)(F.ws + WS_XB), (float*)(F.ws + WS_TAB + TAB_XS), ssptr(F, 3 * layer + 1), dn8(seg) ? 0.5f * DN8_UNSCALE : 0.5f, \
                             PanelX{(float*)(F.ws + WS_TAB + TAB_PX), (unsigned*)F.ctlf + CW_PX}}; \
                pg8::gemm_phase<EpiResidQ8, pg8::StaticOrder, true, GEMM_SP2, dn8(seg) ? 1 : 0>(glds, g, S, E); \
            } else { \
            EpiResid E{seg == 0 ? INP(0) : (const float*)F.out, F.out, (bf16*)(F.ws + WS_XB), ssptr(F, second ? 3 * (layer + 1) : 3 * layer + 1), dn8(seg) ? 0.5f * DN8_UNSCALE : 0.5f, (second && gu8(seg + 1)) ? 1 : ((!second && wini8(layer)) ? 2 : 0)}; \
            pg8::gemm_phase<EpiResid, pg8::StaticOrder, true, GEMM_SP2, dn8(seg) ? 1 : 0>(glds, g, S, E); } \
        } \
        END_PH(); \
        if (!second) { \
            if (wini8(layer) && !FUSE_X) { \
                if (IN_PH()) { FRAME(); p_quant_x(F); } \
                END_PH(); \
            } \
            if (IN_PH()) { \
                FRAME(); \
                { pg8::Gemm g{(const bf16*)(F.ws + WS_XB), wptr(F, layer, WL_IN), M, NIN, wini8(layer) ? D / 2 : D}; pg8::StaticOrder S; S.init(M, NIN, F.G, F.vcu); \
                EpiWin E{F.R, ssptr(F, 3 * layer + 1), (const float*)(F.ws + WS_TAB + TAB_XS), wini8(layer) ? __uint_as_float(((const unsigned*)F.ctlf)[CW_WMAX + 1 + layer]) * (1.0f / 127.0f) : 1.0f, wini8(layer) ? 1 : 0}; \
                REPEAT(REP_WIN, pg8::gemm_phase<EpiWin, pg8::StaticOrder, true, GEMM_SP2, wini8(layer) ? 2 : 0>(glds, g, S, E)); } \
                if (CVM_WIN[layer] != 0u && F.vcu >= (F.G * 3) / 4) { \
                    KArgs kb = kargs(); Frame F2 = make_frame(kb->ws, kb->out, lds); \
                    ProIn I{kb->in[0], kb->in[1], kb->in[2], kb->in[3], kb->in[4], kb->in[5], kb->in[6], kb->in[7], kb->in[8], kb->in[11], kb->in[12], kb->in[18], kb->in[19], kb->in[20], kb->in[21], kb->in[22], kb->in[9], kb->in[10]}; \
                    convert_weights<CVM_WIN[layer]>(F2, I, (F2.vcu - (F2.G * 3) / 4) * NWAVES + F2.wave, (F2.G / 4) * NWAVES); \
                } \
            } \
            END_PH(); \
            if (IN_PH()) { FRAME(); REPEAT(REP_M1, REPEAT(REP_CMP, m_compress(F, layer)); REPEAT(REP_S1, m_ssd_s1(F, layer, INP(13), INP(14), INP(15), INP(16))); REPEAT(REP_SB, m_sb(F))); } \
            END_PH(); \
            if (IN_PH()) { FRAME(); REPEAT(REP_M2, REPEAT(REP_S2, m_ssd_s2(F)); REPEAT(REP_NSA, m_nsa(F))); } \
            END_PH(); \
            if (IN_PH()) { FRAME(); REPEAT(REP_M3, REPEAT(REP_S3, m_ssd_s3(F, layer, INP(17))); REPEAT(REP_N2, m_norms2(F))); } \
            END_PH(); \
             \
            if (IN_PH()) { \
                FRAME(); \
                pg8::Gemm g{(const bf16*)(F.R + R_MIXED), wptr(F, layer, WL_OUT), M, D, D}; pg8::StaticOrder S; S.init(M, D, F.G, F.vcu); \
                EpiResid E{F.out, F.out, (bf16*)(F.ws + WS_XB), ssptr(F, 3 * layer + 2), 1.0f, gu8(seg + 1) ? 1 : 0}; \
                pg8::gemm_phase<EpiResid, pg8::StaticOrder, true, GEMM_SP2>(glds, g, S, E); \
            } \
            END_PH(); \
        } \
     \
    } while (0)
__global__ void __launch_bounds__(NTHR, 2) mega_fwd(Args args) {
    extern __shared__ __attribute__((aligned(16))) unsigned char lds[];
    volatile LAS unsigned* MISC = (volatile LAS unsigned*)((LAS unsigned char*)lds + MISC_OFF);
    if (threadIdx.x < 64) MISC[threadIdx.x] = 0u;
    __syncthreads();
    if (MK_ONE_LAUNCH) (void)xcd_barrier_post((unsigned*)(args.ws + WS_CTL) + CW_BAR, MISC + 8);
    int pc = 0;
#define IN_PH() ({ KArgs _k = kargs(); (_k->ph_lo <= pc && pc < _k->ph_hi); })
#define END_PH() do { KArgs _k = kargs(); \
        if (MK_ONE_LAUNCH && pc + 1 < _k->ph_hi && pc >= _k->ph_lo) { XcdBarrier _b; _b.bar = (unsigned*)(_k->ws + WS_CTL) + CW_BAR; _b.x = xb_xcc_id(); _b.st = MISC + 8; xcd_barrier(_b); } \
        ++pc; } while (0)
#define FRAME() KArgs ka = kargs(); Frame F = make_frame(ka->ws, ka->out, lds)
#define INP(k) (ka->in[k])
    LAS unsigned char* glds = (LAS unsigned char*)lds;

    if (IN_PH()) { FRAME();
        ProIn I{INP(0), INP(1), INP(2), INP(3), INP(4), INP(5), INP(6), INP(7), INP(8), INP(11), INP(12), INP(18), INP(19), INP(20), INP(21), INP(22), INP(9), INP(10)};
        REPEAT(REP_PRO, REPEAT(REP_PA, p_prologue(F, I))); }
    END_PH();
    if (IN_PH()) { FRAME();
        ProIn I{INP(0), INP(1), INP(2), INP(3), INP(4), INP(5), INP(6), INP(7), INP(8), INP(11), INP(12), INP(18), INP(19), INP(20), INP(21), INP(22), INP(9), INP(10)};
        REPEAT(REP_PRO, REPEAT(REP_PB, p_prologue_b(F, I))); }
    END_PH();
    SEG_BODY(0); SEG_BODY(1); SEG_BODY(2); SEG_BODY(3);
    if (!FUSE_X) {
    if (IN_PH()) { FRAME(); p_final(F, INP(23)); }
    END_PH();
    }
#undef IN_PH
#undef END_PH
#undef FRAME
#undef INP
#undef SEG_BODY
}
constexpr int N_PHASES = 2 + 4 * 2 + 2 * 5 + (FUSE_X ? 0 : (wini8(0) ? 1 : 0) + (wini8(1) ? 1 : 0) + 1);

extern "C" void kernel_launch(void* const* d_in, const int* in_sizes, int n_in, void* d_out, int out_size, void* d_ws, size_t ws_size, hipStream_t stream) {
    static int grid = 0;
    if (grid == 0) {
        if (n_in != 24 || in_sizes[0] != M * D || out_size != M * D || ws_size < WS_END) {
            fprintf(stderr, "kernel_launch: shape/workspace mismatch: n_in %d in0 %d out %d ws %zu (need %zu); nothing launched\n", n_in, n_in > 0 ? in_sizes[0] : -1, out_size, ws_size, (size_t)WS_END);
            grid = -1; return; }
        int dev = 0, cus = 0, per_cu = 0;
        if (hipGetDevice(&dev) != hipSuccess || hipDeviceGetAttribute(&cus, hipDeviceAttributeMultiprocessorCount, dev) != hipSuccess) { grid = -1; return; }
        if (hipFuncSetAttribute((const void*)mega_fwd, hipFuncAttributeMaxDynamicSharedMemorySize, LDS_BYTES) != hipSuccess) { fprintf(stderr, "kernel_launch: hipFuncSetAttribute failed\n"); grid = -1; return; }
        if (hipOccupancyMaxActiveBlocksPerMultiprocessor(&per_cu, (const void*)mega_fwd, NTHR, LDS_BYTES) != hipSuccess || per_cu < 1) { fprintf(stderr, "kernel_launch: occupancy query reports %d\n", per_cu); }
        (void)hipGetLastError();
        if (FUSE_X && cus != 256) { fprintf(stderr, "kernel_launch: the fused down-GEMM epilogues need exactly 256 workgroups (one output tile each), this device has %d CUs; nothing launched\n", cus); grid = -1; return; }
        grid = cus;
    }
    if (grid < 0) return;
    (void)hipMemsetAsync((char*)d_ws + WS_CTL, 0, CTL_ZERO_BYTES, stream);
    Args a{};
    for (int i = 0; i < 24; ++i) a.in[i] = (const float*)d_in[i];
    a.out = (float*)d_out; a.ws = (unsigned char*)d_ws;
#if MK_ONE_LAUNCH
    a.ph_lo = 0; a.ph_hi = N_PHASES;
    hipLaunchKernelGGL(mega_fwd, dim3(grid), dim3(NTHR), LDS_BYTES, stream, a);
#else
    for (int p = 0; p < N_PHASES; ++p) { a.ph_lo = p; a.ph_hi = p + 1; hipLaunchKernelGGL(mega_fwd, dim3(grid), dim3(NTHR), LDS_BYTES, stream, a); }
#endif
}
```

```cpp
#include <hip/hip_runtime.h>
#include <cstdio>
#include <cstdint>

#ifndef GEMM_SP2
#define GEMM_SP2 true
#endif
#ifndef REP_PRO
#define REP_PRO 1
#endif
#ifndef REP_GU
#define REP_GU 1
#endif
#ifndef REP_WIN
#define REP_WIN 1
#endif
#ifndef REP_M1
#define REP_M1 1
#endif
#ifndef REP_M2
#define REP_M2 1
#endif
#ifndef REP_M3
#define REP_M3 1
#endif
#ifndef REP_CMP
#define REP_CMP 1
#endif
#ifndef REP_S1
#define REP_S1 1
#endif
#ifndef REP_SB
#define REP_SB 1
#endif
#ifndef REP_S2
#define REP_S2 1
#endif
#ifndef REP_NSA
#define REP_NSA 1
#endif
#ifndef REP_S1A
#define REP_S1A 1
#endif
#ifndef REP_S1B
#define REP_S1B 1
#endif
#ifndef REP_S1C
#define REP_S1C 1
#endif
#ifndef REP_CMPA
#define REP_CMPA 1
#endif
#ifndef REP_CMPB
#define REP_CMPB 1
#endif
#ifndef REP_S3
#define REP_S3 1
#endif
#ifndef REP_N2
#define REP_N2 1
#endif
#ifndef REP_PA
#define REP_PA 1
#endif
#ifndef REP_PB
#define REP_PB 1
#endif
#ifndef REP_AMAX
#define REP_AMAX 1
#endif
#define REPEAT(N, ...) do { __VA_ARGS__; if ((N) > 1) { __VA_ARGS__; } } while (0)
#ifndef GU8_MASK
#define GU8_MASK 0xE
#endif
#ifndef GU_I8
#define GU_I8 1
#endif
#ifndef FUSE_X
#define FUSE_X 1
#endif
#ifndef WIN_I8
#define WIN_I8 2
#endif
#ifndef DN8_MASK
#define DN8_MASK 0xF
#endif
#ifndef MK_ONE_LAUNCH
#define MK_ONE_LAUNCH 1
#endif

namespace pg8 {
#define PG8_LAS __attribute__((address_space(3)))
typedef unsigned short bf16_t;
typedef short bf16x8 __attribute__((ext_vector_type(8)));
typedef float f32x4 __attribute__((ext_vector_type(4)));
typedef unsigned u32x4 __attribute__((ext_vector_type(4)));
typedef int i32x4 __attribute__((ext_vector_type(4)));
typedef int i32x8 __attribute__((ext_vector_type(8)));
constexpr int BM = 256, BK = 64, HALF = 128, HTB = HALF * BK * 2  , STAGE_BYTES = 8 * HTB, NXCD = 8, WGM = 8;

__host__ __device__ __forceinline__ int lds_byte(int r, int c) { const int st = (r >> 4) * 2 + (c >> 5), rr = r & 15, cc = c & 31, ob = rr * 64 + cc * 2; return st * 1024 + (ob ^ (((ob >> 9) & 1) << 5)); }
__host__ __device__ __forceinline__ void stage_rc(int b, int& R, int& C) { const int st = b / 1024, sb = b % 1024, swz = sb ^ (((sb >> 9) & 1) << 5); R = (st >> 1) * 16 + swz / 64; C = (st & 1) * 32 + (swz % 64) / 2; }
__host__ __device__ __forceinline__ int perm32(int rho) { const int n = rho >> 4, i = rho & 15; return 8 * (i >> 2) + 4 * n + (i & 3); }

struct Unit { int pm, pn; };
struct Gemm { const bf16_t* A; const bf16_t* Bt; int M, N, K; };

struct StaticOrder {
    int nM, nN, nwg, G, c;
    __host__ __device__ void init(int M, int N, int G_, int c_) { nM = M / BM; nN = N / BM; nwg = nM * nN; G = G_; c = c_; }
    __host__ __device__ bool next(int i, Unit& u) const {
        const long L = (long)i * G + c; if (L >= nwg) return false;
        int wgid = (int)L; { const int q = nwg / NXCD, r = nwg % NXCD, xcd = wgid % NXCD, off = wgid / NXCD; wgid = (xcd < r ? xcd * (q + 1) : r * (q + 1) + (xcd - r) * q) + off; }
        const int nig = WGM * nN, gid = wgid / nig, fm = gid * WGM, gsz = (nM - fm) < WGM ? (nM - fm) : WGM;
        u.pm = fm + ((wgid % nig) % gsz); u.pn = (wgid % nig) / gsz; return true;
    }
    __device__ __forceinline__ void a_ready(const Unit&) const {}
    __device__ __forceinline__ void done(const Unit&) const {}
};

__device__ __forceinline__ unsigned cvt_pk_bf16(float lo, float hi) { unsigned r; asm volatile("v_cvt_pk_bf16_f32 %0, %1, %2" : "=v"(r) : "v"(lo), "v"(hi)); return r; }

template <class Epi, class Sched, bool ALIGN_EPI = false, bool SP2 = false, int QM = 0>
__device__ __forceinline__ void gemm_phase(PG8_LAS unsigned char* lds, const Gemm g, const Sched& S, const Epi& E) {
    constexpr bool FP8 = (QM == 1);
    int tid = threadIdx.x; asm volatile("" : "+v"(tid));
    const int wid = __builtin_amdgcn_readfirstlane(tid >> 6), lane = tid & 63, wr = wid >> 2, wc = wid & 3, fr = lane & 15, fq = lane >> 4;
    const int K = g.K, nt = K / BK;
    unsigned voffA[2], voffB[2];
#pragma unroll
    for (int i = 0; i < 2; ++i) { int R, C; stage_rc(tid * 16 + i * 8192, R, C); const int Rb = Epi::PERM ? ((R & ~31) + perm32(R & 31)) : R;
        voffA[i] = (unsigned)(R * K + C) * 2u; voffB[i] = (unsigned)(Rb * K + C) * 2u; }
    const size_t kstep = (size_t)(BK * 2);
    const size_t hstep = (size_t)HALF * K * 2;
    const size_t tstep = 2 * hstep;
    const unsigned ldsw = (unsigned)wid * 1024u;
    const int aoff = lds_byte(wr * 64 + fr, fq * 8), boff = lds_byte(wc * 32 + fr, fq * 8);
#define PG8_SA(b, h) (((b) * 2 + (h)) * HTB)
#define PG8_SB(b, h) ((4 + (b) * 2 + (h)) * HTB)
#define PG8_STAGE(bufoff, gbase, voff) do { _Pragma("unroll") for (int _i = 0; _i < 2; ++_i) \
        __builtin_amdgcn_global_load_lds((const unsigned*)((const char*)(gbase) + (voff)[_i]), (PG8_LAS unsigned*)(lds + (bufoff) + ldsw + _i * 8192), 16, 0, 0); } while (0)
#define PG8_LDA(dst, b, h) do { _Pragma("unroll") for (int m = 0; m < 4; ++m) { if constexpr (FP8) { dst##8[m] = __builtin_shufflevector(*(const PG8_LAS i32x4*)(lds + PG8_SA(b, h) + aoff + m * 2048), *(const PG8_LAS i32x4*)(lds + PG8_SA(b, h) + aoff + m * 2048 + 1024), 0, 1, 2, 3, 4, 5, 6, 7); } \
        else { _Pragma("unroll") for (int k = 0; k < 2; ++k) dst[m][k] = *(const PG8_LAS bf16x8*)(lds + PG8_SA(b, h) + aoff + m * 2048 + k * 1024); } } } while (0)
#define PG8_LDB(dst, b, h) do { _Pragma("unroll") for (int n = 0; n < 2; ++n) { if constexpr (FP8) { dst##8[n] = __builtin_shufflevector(*(const PG8_LAS i32x4*)(lds + PG8_SB(b, h) + boff + n * 2048), *(const PG8_LAS i32x4*)(lds + PG8_SB(b, h) + boff + n * 2048 + 1024), 0, 1, 2, 3, 4, 5, 6, 7); } \
        else { _Pragma("unroll") for (int k = 0; k < 2; ++k) dst[n][k] = *(const PG8_LAS bf16x8*)(lds + PG8_SB(b, h) + boff + n * 2048 + k * 1024); } } } while (0)
#define PG8_MMA(ai, bj, At, Bt) do { __builtin_amdgcn_s_setprio(1); _Pragma("unroll") for (int m = 0; m < 4; ++m) _Pragma("unroll") for (int n = 0; n < 2; ++n) { \
        if constexpr (FP8) { asm("v_mfma_f32_16x16x128_f8f6f4 %0, %1, %2, %0" : "+v"(acc[ai][bj][m][n]) : "v"(Bt##8[n]), "v"(At##8[m])); }   \
        else if constexpr (QM == 2) { _Pragma("unroll") for (int k = 0; k < 2; ++k) acc[ai][bj][m][n] = __builtin_bit_cast(f32x4, __builtin_amdgcn_mfma_i32_16x16x64_i8(__builtin_bit_cast(i32x4, Bt[n][k]), __builtin_bit_cast(i32x4, At[m][k]), __builtin_bit_cast(i32x4, acc[ai][bj][m][n]), 0, 0, 0)); }   \
        else { _Pragma("unroll") for (int k = 0; k < 2; ++k) acc[ai][bj][m][n] = __builtin_amdgcn_mfma_f32_16x16x32_bf16(Bt[n][k], At[m][k], acc[ai][bj][m][n], 0, 0, 0); } } \
        __builtin_amdgcn_s_setprio(0); } while (0)
#define PG8_WAIT_V(n) asm volatile("s_waitcnt vmcnt(" #n ")" ::: "memory")
#define PG8_WAIT_L(n) asm volatile("s_waitcnt lgkmcnt(" #n ")" ::: "memory")
#define PG8_BAR __builtin_amdgcn_s_barrier()
#define PG8_SCHED __builtin_amdgcn_sched_barrier(0)
    Unit cur, nxt; int ui = 0;
    if (!S.next(0, cur)) return;
    f32x4 acc[2][2][4][2];
#pragma unroll
    for (int a = 0; a < 2; ++a)
#pragma unroll
        for (int b = 0; b < 2; ++b)
#pragma unroll
            for (int m = 0; m < 4; ++m)
#pragma unroll
                for (int n = 0; n < 2; ++n) acc[a][b][m][n] = (f32x4){0.f, 0.f, 0.f, 0.f};
    bf16x8 At[4][2], B0[2][2], B1[2][2]; i32x8 At8[4], B08[2], B18[2];
    const char* cA = (const char*)g.A + (size_t)cur.pm * tstep; const char* cB = (const char*)g.Bt + (size_t)cur.pn * tstep;
    S.a_ready(cur);
    if constexpr (SP2) {
        PG8_STAGE(PG8_SB(0, 0), cB, voffB); PG8_STAGE(PG8_SB(0, 1), cB + hstep, voffB); PG8_STAGE(PG8_SA(0, 0), cA, voffA); PG8_STAGE(PG8_SA(0, 1), cA + hstep, voffA);
        if (wr == 1) PG8_BAR;
        PG8_WAIT_V(2); PG8_BAR;
        PG8_STAGE(PG8_SB(1, 0), cB + kstep, voffB); PG8_STAGE(PG8_SA(1, 0), cA + kstep, voffA); PG8_STAGE(PG8_SB(1, 1), cB + hstep + kstep, voffB);
        PG8_WAIT_V(6); PG8_BAR;
    } else {
        PG8_STAGE(PG8_SB(0, 0), cB, voffB); PG8_STAGE(PG8_SA(0, 0), cA, voffA); PG8_STAGE(PG8_SB(0, 1), cB + hstep, voffB); PG8_STAGE(PG8_SA(0, 1), cA + hstep, voffA);
        if (wr == 1) PG8_BAR;
        PG8_WAIT_V(4); PG8_BAR;
        PG8_STAGE(PG8_SB(1, 0), cB + kstep, voffB); PG8_STAGE(PG8_SA(1, 0), cA + kstep, voffA); PG8_STAGE(PG8_SB(1, 1), cB + hstep + kstep, voffB);
        PG8_WAIT_V(6); PG8_BAR;
    }
    for (;;) {
        const bool has_next = S.next(ui + 1, nxt);
        const char* nA = has_next ? (const char*)g.A + (size_t)nxt.pm * tstep : cA; const char* nB = has_next ? (const char*)g.Bt + (size_t)nxt.pn * tstep : cB;
        for (int t = 0; t < nt; t += 2) {
            const bool last = (t == nt - 2);
            const char* a1 = cA + (size_t)(t + 1) * kstep;
            const char* a2 = last ? nA : cA + (size_t)(t + 2) * kstep; const char* b2 = last ? nB : cB + (size_t)(t + 2) * kstep;
            const char* a3 = a2 + kstep; const char* b3 = b2 + kstep;
            if (last && has_next) S.a_ready(nxt);
            if constexpr (SP2) {
            PG8_LDB(B0, 0, 0); PG8_LDB(B1, 0, 1); PG8_SCHED; PG8_LDA(At, 0, 0); PG8_STAGE(PG8_SA(1, 1), a1 + hstep, voffA);
            PG8_WAIT_V(8); PG8_WAIT_L(0); PG8_BAR; PG8_MMA(0, 0, At, B0); PG8_MMA(0, 1, At, B1); PG8_BAR; PG8_SCHED;
            PG8_LDA(At, 0, 1); PG8_STAGE(PG8_SB(0, 0), b2, voffB); PG8_STAGE(PG8_SB(0, 1), b2 + hstep, voffB); PG8_STAGE(PG8_SA(0, 0), a2, voffA);
            PG8_WAIT_V(8); PG8_WAIT_L(0); PG8_BAR; PG8_MMA(1, 0, At, B0); PG8_MMA(1, 1, At, B1); PG8_BAR; PG8_SCHED;
            PG8_LDB(B0, 1, 0); PG8_LDB(B1, 1, 1); PG8_SCHED; PG8_LDA(At, 1, 0); PG8_STAGE(PG8_SA(0, 1), a2 + hstep, voffA);
            PG8_WAIT_V(8); PG8_WAIT_L(0); PG8_BAR; PG8_MMA(0, 0, At, B0); PG8_MMA(0, 1, At, B1); PG8_BAR; PG8_SCHED;
            PG8_LDA(At, 1, 1); PG8_STAGE(PG8_SB(1, 0), b3, voffB); PG8_STAGE(PG8_SB(1, 1), b3 + hstep, voffB); PG8_STAGE(PG8_SA(1, 0), a3, voffA);
            PG8_WAIT_V(8); PG8_WAIT_L(0); PG8_BAR; PG8_MMA(1, 0, At, B0); PG8_MMA(1, 1, At, B1); PG8_BAR; PG8_SCHED;
            } else {
            PG8_LDB(B0, 0, 0); PG8_SCHED; PG8_LDA(At, 0, 0); PG8_STAGE(PG8_SA(1, 1), a1 + hstep, voffA);
            PG8_WAIT_L(8); PG8_BAR; PG8_WAIT_L(0); PG8_MMA(0, 0, At, B0); PG8_BAR; PG8_SCHED;
            PG8_LDB(B1, 0, 1); PG8_STAGE(PG8_SB(0, 0), b2, voffB);
            PG8_BAR; PG8_WAIT_L(0); PG8_MMA(0, 1, At, B1); PG8_BAR;
            PG8_LDA(At, 0, 1); PG8_STAGE(PG8_SA(0, 0), a2, voffA);
            PG8_BAR; PG8_WAIT_L(0); PG8_MMA(1, 0, At, B0); PG8_BAR; PG8_SCHED;
            PG8_STAGE(PG8_SB(0, 1), b2 + hstep, voffB);
            PG8_WAIT_V(6); PG8_BAR; PG8_MMA(1, 1, At, B1); PG8_BAR;
            PG8_LDB(B0, 1, 0); PG8_SCHED; PG8_LDA(At, 1, 0); PG8_STAGE(PG8_SA(0, 1), a2 + hstep, voffA);
            PG8_WAIT_L(8); PG8_BAR; PG8_WAIT_L(0); PG8_MMA(0, 0, At, B0); PG8_BAR; PG8_SCHED;
            PG8_LDB(B1, 1, 1); PG8_STAGE(PG8_SB(1, 0), b3, voffB);
            PG8_BAR; PG8_WAIT_L(0); PG8_MMA(0, 1, At, B1); PG8_BAR;
            PG8_LDA(At, 1, 1); PG8_STAGE(PG8_SA(1, 0), a3, voffA);
            PG8_BAR; PG8_WAIT_L(0); PG8_MMA(1, 0, At, B0); PG8_BAR; PG8_SCHED;
            PG8_STAGE(PG8_SB(1, 1), b3 + hstep, voffB);
            PG8_WAIT_V(6); PG8_BAR; PG8_MMA(1, 1, At, B1); PG8_BAR;
            }
        }
        if constexpr (ALIGN_EPI) { if (wr == 0) PG8_BAR; }
        if constexpr (!Epi::AFTER_DRAIN) E(acc, cur, wr, wc, fr, fq);
        S.done(cur);
        if (!has_next) break;
#pragma unroll
        for (int a = 0; a < 2; ++a)
#pragma unroll
            for (int b = 0; b < 2; ++b)
#pragma unroll
                for (int m = 0; m < 4; ++m)
#pragma unroll
                    for (int n = 0; n < 2; ++n) acc[a][b][m][n] = (f32x4){0.f, 0.f, 0.f, 0.f};
        cur = nxt; cA = nA; cB = nB; ++ui;
        if constexpr (ALIGN_EPI) { if (wr == 1) PG8_BAR; }
    }
    PG8_WAIT_V(0);
    if constexpr (!ALIGN_EPI) { if (wr == 0) PG8_BAR; }
    PG8_BAR;
    if constexpr (Epi::AFTER_DRAIN) E.fused(acc, cur, wr, wc, fr, fq, lds);
#undef PG8_SA
#undef PG8_SB
#undef PG8_STAGE
#undef PG8_LDA
#undef PG8_LDB
#undef PG8_MMA
#undef PG8_WAIT_V
#undef PG8_WAIT_L
#undef PG8_BAR
#undef PG8_SCHED
}
}

constexpr int NWAVES = 8, NTHR = 512;
constexpr int BATCH = 4, T = 2048, M = BATCH * T, D = 2048, FF = 5632, DEPTH = 2;
constexpr int NIN_SRC = 5416, NIN = 5632;
constexpr int NGU = 2 * FF;
constexpr float EPS = 1e-6f;
constexpr float LOG2E = 1.4426950408889634f;
constexpr float QSCALE = 0.125f * LOG2E;
constexpr int NSS = 7;

constexpr size_t MiB = 1u << 20;
constexpr size_t WS_CTL = 0, CTL_ZERO_BYTES = 1 * MiB;
constexpr int CW_TMO = 0, CW_BAR = 4096, CW_PX = 8192  , CW_SS = 16384;
static_assert((CW_SS + 2 * NSS * M) * 4 <= (int)CTL_ZERO_BYTES, "ctl");
typedef unsigned long long u64;
constexpr float SS_SCALE = 1048576.0f, SS_INV = 1.0f / 1048576.0f;
constexpr size_t WS_TAB = 1 * MiB;
constexpr size_t WS_W = 2 * MiB;
constexpr size_t W_GU = (size_t)NGU * D * 2, W_DN = (size_t)D * FF * 2, W_IN = (size_t)NIN * D * 2, W_OUT = (size_t)D * D * 2;
constexpr size_t WL_GU1 = 0, WL_DN1 = WL_GU1 + W_GU, WL_IN = WL_DN1 + W_DN, WL_OUT = WL_IN + W_IN, WL_GU2 = WL_OUT + W_OUT, WL_DN2 = WL_GU2 + W_GU, WL_SIZE = WL_DN2 + W_DN;
static_assert(WL_SIZE == 162 * MiB, "weights per layer");
constexpr size_t WS_XB = WS_W + DEPTH * WL_SIZE;
constexpr size_t WS_CW = WS_XB + (size_t)M * D * 2;
constexpr size_t WS_R = WS_CW + 1 * MiB;
constexpr size_t TAB_PB = 8192;
constexpr size_t R_H = 0;
constexpr size_t R_QN = 0, R_QS = R_QN + 8 * MiB, R_KS = R_QS + 8 * MiB, R_KN = R_KS + 8 * MiB, R_CMPRAW = R_KN + 4 * MiB, R_VNT = R_CMPRAW + 8 * MiB,
                 R_VST = R_VNT + 4 * MiB, R_Z = R_VST + 8 * MiB, R_XBC = R_Z + 16 * MiB, R_DTG = R_XBC + 24 * MiB, R_XT = R_DTG + 2 * MiB, R_BM = R_XT + 16 * MiB,
                 R_CM = R_BM + 4 * MiB, R_DT = R_CM + 4 * MiB, R_KCMP = R_DT + 1 * MiB, R_VCMPT = R_KCMP + 1 * MiB, R_SELM = R_VCMPT + 1 * MiB, R_MIXED = R_SELM + 1 * MiB,
                 R_OC = R_MIXED + 32 * MiB, R_ONSA = R_OC + 16 * MiB, R_OSB = R_ONSA + 16 * MiB, R_YS = R_OSB + 16 * MiB, R_ST = R_YS + 32 * MiB, R_HIN = R_ST + 64 * MiB,
                 R_ACS = R_HIN + 32 * MiB, R_AEND = R_ACS + 1 * MiB, R_END = R_AEND + 1 * MiB;
constexpr size_t WS_END = WS_R + R_END;
static_assert((size_t)M * FF * 2 <= R_MIXED, "H must not overlay MIXED");

typedef unsigned short bf16;
typedef unsigned v4u __attribute__((ext_vector_type(4)));
typedef unsigned v2u __attribute__((ext_vector_type(2)));
typedef float f32x4 __attribute__((ext_vector_type(4)));
#define LAS __attribute__((address_space(3)))
#define LDS_WAIT() asm volatile("s_waitcnt lgkmcnt(0)" ::: "memory")

__device__ __forceinline__ float bf2f(bf16 v) { return __uint_as_float(((unsigned)v) << 16); }
__device__ __forceinline__ unsigned f2bf(float f) { unsigned u = __float_as_uint(f); return (u + 0x7fffu + ((u >> 16) & 1u)) >> 16; }
__device__ __forceinline__ unsigned pk2(float lo, float hi) { unsigned r; asm("v_cvt_pk_bf16_f32 %0, %1, %2" : "=v"(r) : "v"(lo), "v"(hi)); return r; }
__device__ __forceinline__ float wave_sum(float v) {
#pragma unroll
    for (int o = 1; o < 64; o <<= 1) v += __shfl_xor(v, o);
    return v;
}
__device__ __forceinline__ float wave_max(float v) {
#pragma unroll
    for (int o = 1; o < 64; o <<= 1) v = fmaxf(v, __shfl_xor(v, o));
    return v;
}
__device__ __forceinline__ float fexp2(float x) { return __builtin_amdgcn_exp2f(x); }
__device__ __forceinline__ float frcp(float x) { return __builtin_amdgcn_rcpf(x); }
__device__ __forceinline__ float silu_f(float v) { return v * frcp(1.0f + fexp2(-v * LOG2E)); }
__device__ __forceinline__ float sigmoid_f(float v) { return frcp(1.0f + fexp2(-v * LOG2E)); }

#define XB_TMO      128
#define XB_XCNT(j)  (256  + 64 * (j))
#define XB_XSUB(j)  (1280 + 64 * (j))
#define XB_XGEN(j)  (2304 + 64 * (j))
#define XB_TOP      3328
#define XB_TOPGEN   3392
#define XCD_BAR_WORDS 3456
#define XB_SPIN_CAP (1u << 18)
__device__ __forceinline__ unsigned xb_ld(unsigned* p)              { return __hip_atomic_load(p, __ATOMIC_RELAXED, __HIP_MEMORY_SCOPE_AGENT); }
__device__ __forceinline__ unsigned xb_add(unsigned* p, unsigned v) { return __hip_atomic_fetch_add(p, v, __ATOMIC_RELAXED, __HIP_MEMORY_SCOPE_AGENT); }
__device__ __forceinline__ unsigned xb_xcc_id() { return (unsigned)__builtin_amdgcn_s_getreg((3 << 11) | 20) & 0xFu; }
#define XB_SPIN(cond, bar) do { unsigned _sp = 0; while (cond) { __builtin_amdgcn_s_sleep(1); \
    if ((++_sp & 255u) == 0u) { if (xb_ld(&(bar)[XB_TMO])) break; if (_sp > XB_SPIN_CAP) { atomicAdd(&(bar)[XB_TMO], 1u); break; } } } } while (0)
struct XcdBarrier { unsigned* bar; unsigned x; volatile LAS unsigned* st; };
__device__ __forceinline__ XcdBarrier xcd_barrier_post(unsigned* bar, volatile LAS unsigned* st) {
    XcdBarrier b; b.bar = bar; b.x = xb_xcc_id(); b.st = st;
    if (threadIdx.x == 0) (void)xb_add(&bar[XB_XCNT(b.x)], 1u);
    return b;
}
__device__ __forceinline__ void xcd_barrier_complete(unsigned* bar, unsigned x, unsigned& nloc, unsigned& nx) {
    const unsigned G = gridDim.x * gridDim.y * gridDim.z;
    unsigned sum, cnt, mine, sp = 0u;
    for (;;) {
        sum = 0u; cnt = 0u; mine = 0u;
#pragma unroll
        for (unsigned j = 0; j < 16; ++j) { const unsigned c = xb_ld(&bar[XB_XCNT(j)]); sum += c; cnt += (c > 0u) ? 1u : 0u; mine = (j == x) ? c : mine; }
        if (sum == G) break;
        __builtin_amdgcn_s_sleep(1);
        if ((++sp & 255u) == 0u) { if (xb_ld(&bar[XB_TMO])) break; if (sp > XB_SPIN_CAP) { atomicAdd(&bar[XB_TMO], 1u); break; } }
    }
    nloc = mine > 0u ? mine : 1u; nx = cnt > 0u ? cnt : 1u;
}
__device__ __forceinline__ void xcd_barrier(const XcdBarrier& b) {
    asm volatile("s_waitcnt vmcnt(0)" ::: "memory");
    __syncthreads();
    if (threadIdx.x == 0) {
        unsigned* bar = b.bar;
        __builtin_amdgcn_s_waitcnt(0);
        unsigned nloc = b.st[0], nx = b.st[1];
        if (nloc == 0u) { xcd_barrier_complete(bar, b.x, nloc, nx); b.st[0] = nloc; b.st[1] = nx; }
        const unsigned old = xb_add(&bar[XB_XSUB(b.x)], 1u);
        const unsigned gen = old / nloc;
        if (old + 1u == (gen + 1u) * nloc) {
            __builtin_amdgcn_fence(__ATOMIC_RELEASE, "agent");
            asm volatile("s_waitcnt vmcnt(0)" ::: "memory");
            const unsigned og = xb_add(&bar[XB_TOP], 1u);
            const unsigned tg = og / nx;
            if (og + 1u == (tg + 1u) * nx) xb_add(&bar[XB_TOPGEN], 1u);
            else XB_SPIN(xb_ld(&bar[XB_TOPGEN]) == tg, bar);
            __builtin_amdgcn_fence(__ATOMIC_ACQUIRE, "agent");
            xb_add(&bar[XB_XGEN(b.x)], 1u);
            asm volatile("s_waitcnt vmcnt(0)" ::: "memory");
        } else {
            XB_SPIN(xb_ld(&bar[XB_XGEN(b.x)]) == gen, bar);
            __builtin_amdgcn_fence(__ATOMIC_ACQUIRE, "agent");
            asm volatile("s_waitcnt vmcnt(0)" ::: "memory");
        }
    }
    __syncthreads();
}


constexpr int RING_BYTES = 131072;
constexpr int MISC_OFF = RING_BYTES;
constexpr int LDS_BYTES = 147456;

__device__ __forceinline__ float rstd_of(u64 ssq) { return rsqrtf((float)ssq * (SS_INV / D) + EPS); }
constexpr bool gu8(int seg) { return seg >= 0 && seg < 4 && ((GU8_MASK >> seg) & 1); }
constexpr bool gui8(int seg) { return GU_I8 != 0 && seg == 0; }
constexpr int CW_WMAX = 8;
constexpr size_t TAB_PX = 131072;
constexpr size_t TAB_XS = 32768;
constexpr bool wini8(int l) { return l >= 0 && l < 2 && ((WIN_I8 >> l) & 1); }
constexpr bool dn8(int seg) { return seg >= 0 && seg < 4 && ((DN8_MASK >> seg) & 1); }
constexpr float H8_SCALE = 16.0f, DN8_UNSCALE = 1.0f / (16.0f * 256.0f);
constexpr float X8_SCALE = 16.0f, W8_SCALE = 256.0f, GU8_UNSCALE = 1.0f / (16.0f * 256.0f);
__device__ __forceinline__ float sat8(float v) { return __builtin_amdgcn_fmed3f(v, -448.0f, 448.0f); }
__device__ __forceinline__ unsigned pk4_fp8(float a, float b, float c, float d) { int w = 0; w = __builtin_amdgcn_cvt_pk_fp8_f32(sat8(a), sat8(b), w, false); w = __builtin_amdgcn_cvt_pk_fp8_f32(sat8(c), sat8(d), w, true); return (unsigned)w; }
__device__ __forceinline__ size_t kfrag_off(int t, int d0) { return ((size_t)((t >> 5) * 4 + (d0 >> 4)) * 64 + 32 * ((d0 >> 3) & 1) + (t & 31)) * 8; }
__device__ __forceinline__ size_t vfrag_off(int t, int d) { const int q = t & 15; return ((size_t)(((t >> 5) * 2 + (d >> 5)) * 2 + ((t >> 4) & 1)) * 64 + 32 * ((q >> 2) & 1) + (d & 31)) * 8 + 4 * (q >> 3) + (q & 3); }
struct EpiGateUp {
    static constexpr bool PERM = true, AFTER_DRAIN = false;
    bf16* H; const u64* ss; float unscale; int h8; const float* xs; int i8;
    __device__ __forceinline__ void operator()(const f32x4 (&acc)[2][2][4][2], const pg8::Unit& u, int wr, int wc, int fr, int fq) const {
        const int row0 = u.pm * 256 + wr * 64 + fr, hcol = u.pn * 128 + wc * 32 + 8 * fq;
#pragma unroll
        for (int ai = 0; ai < 2; ++ai)
#pragma unroll
            for (int m = 0; m < 4; ++m) {
                const int row = row0 + ai * 128 + m * 16;
                float r = rstd_of(ss[row]) * unscale;
                if (i8) r *= xs[row];
                float h[8];
#pragma unroll
                for (int n = 0; n < 2; ++n)
#pragma unroll
                    for (int j = 0; j < 4; ++j) {
                        const float gf = acc[ai][0][m][n][j], uf = acc[ai][1][m][n][j];
                        const float ga = i8 ? (float)__float_as_int(gf) : gf, ua = i8 ? (float)__float_as_int(uf) : uf;
                        const float g = ga * r, uu = ua * r; h[n * 4 + j] = silu_f(g) * uu; }
                if (h8) { v2u w8; w8.x = pk4_fp8(h[0] * H8_SCALE, h[1] * H8_SCALE, h[2] * H8_SCALE, h[3] * H8_SCALE); w8.y = pk4_fp8(h[4] * H8_SCALE, h[5] * H8_SCALE, h[6] * H8_SCALE, h[7] * H8_SCALE);
                    *(v2u*)((unsigned char*)H + (size_t)row * FF + hcol) = w8; }
                else { v4u w; w.x = pk2(h[0], h[1]); w.y = pk2(h[2], h[3]); w.z = pk2(h[4], h[5]); w.w = pk2(h[6], h[7]);
                    *(v4u*)(H + (size_t)row * FF + hcol) = w; }
            }
    }
};
struct EpiResid {
    static constexpr bool PERM = true, AFTER_DRAIN = false;
    const float* xin; float* xout; bf16* xb; u64* ss_out; float alpha; int out8;
    __device__ __forceinline__ void operator()(const f32x4 (&acc)[2][2][4][2], const pg8::Unit& u, int wr, int wc, int fr, int fq) const {
        const int row0 = u.pm * 256 + wr * 64 + fr, col0 = u.pn * 256 + wc * 32 + 8 * fq;
#pragma unroll
        for (int ai = 0; ai < 2; ++ai)
#pragma unroll
            for (int m = 0; m < 4; ++m) {
                const int row = row0 + ai * 128 + m * 16;
                float s = 0.f;
#pragma unroll
                for (int bj = 0; bj < 2; ++bj) {
                    const size_t off = (size_t)row * D + col0 + bj * 128;
                    const f32x4 x0 = *(const f32x4*)(xin + off), x1 = *(const f32x4*)(xin + off + 4);
                    const f32x4 y0 = x0 + acc[ai][bj][m][0] * alpha, y1 = x1 + acc[ai][bj][m][1] * alpha;
                    *(f32x4*)(xout + off) = y0; *(f32x4*)(xout + off + 4) = y1;
                    if (out8 == 2) { }
                    else if (out8) { v2u w8; w8.x = pk4_fp8(y0[0] * X8_SCALE, y0[1] * X8_SCALE, y0[2] * X8_SCALE, y0[3] * X8_SCALE); w8.y = pk4_fp8(y1[0] * X8_SCALE, y1[1] * X8_SCALE, y1[2] * X8_SCALE, y1[3] * X8_SCALE);
                        *(v2u*)((unsigned char*)xb + off) = w8; }
                    else { v4u w; w.x = pk2(y0[0], y0[1]); w.y = pk2(y0[2], y0[3]); w.z = pk2(y1[0], y1[1]); w.w = pk2(y1[2], y1[3]);
                        *(v4u*)(xb + off) = w; }
                    s += (y0[0] * y0[0] + y0[1] * y0[1]) + (y0[2] * y0[2] + y0[3] * y0[3]) + (y1[0] * y1[0] + y1[1] * y1[1]) + (y1[2] * y1[2] + y1[3] * y1[3]);
                }
                s += __shfl_xor(s, 16); s += __shfl_xor(s, 32);
                if (fq == 0) atomicAdd(ss_out + row, (u64)(s * SS_SCALE + 0.5f));
                asm volatile("" ::: "memory");
            }
    }
};
struct PanelX {
    float* slots;
    unsigned* cnt;
    template <int OP  >
    __device__ __forceinline__ void run(const float (&part)[2][4], const pg8::Unit& u, int wr, int wc, int fr, int fq, PG8_LAS unsigned char* lds) const {
        PG8_LAS float* P = (PG8_LAS float*)lds;
        PG8_LAS float* S = (PG8_LAS float*)(lds + 8192);
        int tid = threadIdx.x; asm volatile("" : "+v"(tid));
        const int wid = __builtin_amdgcn_readfirstlane(tid >> 6), lane = tid & 63;
        if (fq == 0) {
#pragma unroll
            for (int ai = 0; ai < 2; ++ai)
#pragma unroll
                for (int m = 0; m < 4; ++m) P[(ai * 128 + wr * 64 + m * 16 + fr) * 4 + wc] = part[ai][m];
        }
        asm volatile("s_waitcnt lgkmcnt(0)" ::: "memory"); __builtin_amdgcn_s_barrier(); asm volatile("" ::: "memory");
        const int row = wid * 32 + (lane & 31);
        if (lane < 32) {
            const float a = P[row * 4 + 0], b = P[row * 4 + 1], c = P[row * 4 + 2], d = P[row * 4 + 3];
            const float v = OP == 0 ? (a + b) + (c + d) : fmaxf(fmaxf(a, b), fmaxf(c, d));
            __hip_atomic_store((unsigned*)slots + (size_t)(u.pm * 256 + row) * 8 + u.pn, __float_as_uint(v), __ATOMIC_RELAXED, __HIP_MEMORY_SCOPE_AGENT);
        }
        asm volatile("s_waitcnt vmcnt(0)" ::: "memory");
        if (lane == 0) __hip_atomic_fetch_add(cnt + 64 * u.pm, 1u, __ATOMIC_RELAXED, __HIP_MEMORY_SCOPE_AGENT);
        if (wid == 0) {
            unsigned sp = 0u;
            while ((unsigned)__builtin_amdgcn_readfirstlane((int)__hip_atomic_load(cnt + 64 * u.pm, __ATOMIC_RELAXED, __HIP_MEMORY_SCOPE_AGENT)) < 64u) { __builtin_amdgcn_s_sleep(2); if (++sp > (1u << 22)) break; }
            __builtin_amdgcn_fence(__ATOMIC_ACQUIRE, "agent");
        }
        asm volatile("s_waitcnt vmcnt(0) lgkmcnt(0)" ::: "memory"); __builtin_amdgcn_s_barrier(); asm volatile("" ::: "memory");
        if (lane < 32) {
            const unsigned* sl = (const unsigned*)slots + (size_t)(u.pm * 256 + row) * 8;
            float t[8];
#pragma unroll
            for (int q = 0; q < 8; ++q) t[q] = __uint_as_float(__hip_atomic_load(sl + q, __ATOMIC_RELAXED, __HIP_MEMORY_SCOPE_AGENT));
            S[row] = OP == 0 ? ((t[0] + t[1]) + (t[2] + t[3])) + ((t[4] + t[5]) + (t[6] + t[7])) : fmaxf(fmaxf(fmaxf(t[0], t[1]), fmaxf(t[2], t[3])), fmaxf(fmaxf(t[4], t[5]), fmaxf(t[6], t[7])));
        }
        asm volatile("s_waitcnt lgkmcnt(0)" ::: "memory"); __builtin_amdgcn_s_barrier(); asm volatile("" ::: "memory");
    }
};
__device__ __forceinline__ unsigned pk4_i8(float a, float b, float c, float d);
struct EpiResidFin {
    static constexpr bool PERM = true, AFTER_DRAIN = true;
    const float* xin; float* out; const float* gain; float alpha; PanelX px;
    __device__ __forceinline__ void fused(f32x4 (&acc)[2][2][4][2], const pg8::Unit& u, int wr, int wc, int fr, int fq, PG8_LAS unsigned char* lds) const {
        const int row0 = u.pm * 256 + wr * 64 + fr, col0 = u.pn * 256 + wc * 32 + 8 * fq;
        float part[2][4];
#pragma unroll
        for (int ai = 0; ai < 2; ++ai)
#pragma unroll
            for (int m = 0; m < 4; ++m) {
                const int row = row0 + ai * 128 + m * 16;
                float s = 0.f;
#pragma unroll
                for (int bj = 0; bj < 2; ++bj) {
                    const size_t off = (size_t)row * D + col0 + bj * 128;
                    const f32x4 x0 = *(const f32x4*)(xin + off), x1 = *(const f32x4*)(xin + off + 4);
                    const f32x4 y0 = x0 + acc[ai][bj][m][0] * alpha, y1 = x1 + acc[ai][bj][m][1] * alpha;
                    acc[ai][bj][m][0] = y0; acc[ai][bj][m][1] = y1;
                    s += (y0[0] * y0[0] + y0[1] * y0[1]) + (y0[2] * y0[2] + y0[3] * y0[3]) + (y1[0] * y1[0] + y1[1] * y1[1]) + (y1[2] * y1[2] + y1[3] * y1[3]);
                }
                s += __shfl_xor(s, 16); s += __shfl_xor(s, 32);
                part[ai][m] = s;
                asm volatile("" : "+v"(acc[ai][0][m][0]), "+v"(acc[ai][0][m][1]), "+v"(acc[ai][1][m][0]), "+v"(acc[ai][1][m][1]));
            }
        px.run<0>(part, u, wr, wc, fr, fq, lds);
        const PG8_LAS float* S = (const PG8_LAS float*)(lds + 8192);
        f32x4 g[2][2];
#pragma unroll
        for (int bj = 0; bj < 2; ++bj) { g[bj][0] = *(const f32x4*)(gain + col0 + bj * 128); g[bj][1] = *(const f32x4*)(gain + col0 + bj * 128 + 4); }
#pragma unroll
        for (int ai = 0; ai < 2; ++ai)
#pragma unroll
            for (int m = 0; m < 4; ++m) {
                const int rl = ai * 128 + wr * 64 + m * 16 + fr, row = u.pm * 256 + rl;
                const float r = rsqrtf(S[rl] * (1.0f / D) + EPS);
#pragma unroll
                for (int bj = 0; bj < 2; ++bj) {
                    const size_t off = (size_t)row * D + col0 + bj * 128;
                    *(f32x4*)(out + off) = acc[ai][bj][m][0] * r * g[bj][0]; *(f32x4*)(out + off + 4) = acc[ai][bj][m][1] * r * g[bj][1];
                }
            }
    }
};
struct EpiResidQ8 {
    static constexpr bool PERM = true, AFTER_DRAIN = true;
    const float* xin; float* xout; unsigned char* xb8; float* xs; u64* ss_out; float alpha; PanelX px;
    __device__ __forceinline__ void fused(f32x4 (&acc)[2][2][4][2], const pg8::Unit& u, int wr, int wc, int fr, int fq, PG8_LAS unsigned char* lds) const {
        const int row0 = u.pm * 256 + wr * 64 + fr, col0 = u.pn * 256 + wc * 32 + 8 * fq;
        float part[2][4];
#pragma unroll
        for (int ai = 0; ai < 2; ++ai)
#pragma unroll
            for (int m = 0; m < 4; ++m) {
                const int row = row0 + ai * 128 + m * 16;
                float s = 0.f, mx = 0.f;
#pragma unroll
                for (int bj = 0; bj < 2; ++bj) {
                    const size_t off = (size_t)row * D + col0 + bj * 128;
                    const f32x4 x0 = *(const f32x4*)(xin + off), x1 = *(const f32x4*)(xin + off + 4);
                    const f32x4 y0 = x0 + acc[ai][bj][m][0] * alpha, y1 = x1 + acc[ai][bj][m][1] * alpha;
                    acc[ai][bj][m][0] = y0; acc[ai][bj][m][1] = y1;
                    *(f32x4*)(xout + off) = y0; *(f32x4*)(xout + off + 4) = y1;
                    s += (y0[0] * y0[0] + y0[1] * y0[1]) + (y0[2] * y0[2] + y0[3] * y0[3]) + (y1[0] * y1[0] + y1[1] * y1[1]) + (y1[2] * y1[2] + y1[3] * y1[3]);
                    mx = fmaxf(fmaxf(fmaxf(mx, fmaxf(fabsf(y0[0]), fabsf(y0[1]))), fmaxf(fabsf(y0[2]), fabsf(y0[3]))), fmaxf(fmaxf(fabsf(y1[0]), fabsf(y1[1])), fmaxf(fabsf(y1[2]), fabsf(y1[3]))));
                }
                s += __shfl_xor(s, 16); s += __shfl_xor(s, 32);
                mx = fmaxf(mx, __shfl_xor(mx, 16)); mx = fmaxf(mx, __shfl_xor(mx, 32));
                if (fq == 0) atomicAdd(ss_out + row, (u64)(s * SS_SCALE + 0.5f));
                part[ai][m] = mx;
                asm volatile("" : "+v"(acc[ai][0][m][0]), "+v"(acc[ai][0][m][1]), "+v"(acc[ai][1][m][0]), "+v"(acc[ai][1][m][1]) :: "memory");
            }
        px.run<1>(part, u, wr, wc, fr, fq, lds);
        const PG8_LAS float* S = (const PG8_LAS float*)(lds + 8192);
        if (u.pn == 0) { int tid = threadIdx.x; asm volatile("" : "+v"(tid)); if (tid < 256) xs[u.pm * 256 + tid] = fmaxf(S[tid], 1e-30f) * (1.0f / 127.0f); }
#pragma unroll
        for (int ai = 0; ai < 2; ++ai)
#pragma unroll
            for (int m = 0; m < 4; ++m) {
                const int rl = ai * 128 + wr * 64 + m * 16 + fr, row = u.pm * 256 + rl;
                const float inv = 127.0f / fmaxf(S[rl], 1e-30f);
#pragma unroll
                for (int bj = 0; bj < 2; ++bj) {
                    const f32x4 y0 = acc[ai][bj][m][0] * inv, y1 = acc[ai][bj][m][1] * inv;
                    v2u w8; w8.x = pk4_i8(y0[0], y0[1], y0[2], y0[3]); w8.y = pk4_i8(y1[0], y1[1], y1[2], y1[3]);
                    *(v2u*)(xb8 + (size_t)row * D + col0 + bj * 128) = w8;
                }
            }
    }
};
struct EpiWin {
    static constexpr bool PERM = true, AFTER_DRAIN = false;
    unsigned char* R; const u64* ss; const float* xs; float wsc; int i8;
    __device__ __forceinline__ void operator()(const f32x4 (&acc)[2][2][4][2], const pg8::Unit& u, int wr, int wc, int fr, int fq) const {
        const int row0 = u.pm * 256 + wr * 64 + fr;
        const int pn = u.pn;
        unsigned off = 0u; int ld = 0, cbase = 0, cls = 0, hbase = 0, nh = 0; float sc = 1.f;
        if (pn < 2)       { off = (unsigned)R_QN; ld = 512; cbase = pn * 256; sc = QSCALE; }
        else if (pn < 4)  { off = (unsigned)R_QS; ld = 512; cbase = (pn - 2) * 256; sc = QSCALE; }
        else if (pn < 6)  { cls = 4; off = (unsigned)R_KS; hbase = (pn - 4) * 4; nh = 8; }
        else if (pn == 6) { cls = 4; off = (unsigned)R_KN; hbase = 0; nh = 4; }
        else if (pn == 7) { cls = 1; off = (unsigned)R_CMPRAW; }
        else if (pn == 8) { cls = 2; off = (unsigned)R_VNT; hbase = 0; nh = 4; }
        else if (pn < 11) { cls = 2; off = (unsigned)R_VST; hbase = (pn - 9) * 4; nh = 8; }
        else if (pn < 15) { off = (unsigned)R_Z; ld = 1024; cbase = (pn - 11) * 256; }
        else if (pn < 21) { off = (unsigned)R_XBC; ld = 1536; cbase = (pn - 15) * 256; }
        else              { cls = 3; off = (unsigned)R_DTG; }
        unsigned char* const dst = R + off;
#pragma unroll
        for (int ai = 0; ai < 2; ++ai)
#pragma unroll
            for (int m = 0; m < 4; ++m) {
                const int row = row0 + ai * 128 + m * 16;
                float r = rstd_of(ss[row]) * sc;
                if (i8) r *= xs[row] * wsc;
#pragma unroll
                for (int bj = 0; bj < 2; ++bj) {
                    const int col = bj * 128 + wc * 32 + 8 * fq;
                    float v[8];
#pragma unroll
                    for (int n = 0; n < 2; ++n)
#pragma unroll
                        for (int j = 0; j < 4; ++j) { const float af = acc[ai][bj][m][n][j]; v[n * 4 + j] = (i8 ? (float)__float_as_int(af) : af) * r; }
                    if (cls == 0) {
                        v4u w; w.x = pk2(v[0], v[1]); w.y = pk2(v[2], v[3]); w.z = pk2(v[4], v[5]); w.w = pk2(v[6], v[7]);
                        *(v4u*)((bf16*)dst + (size_t)row * ld + cbase + col) = w;
                    } else if (cls == 1) {
                        v4u w; w.x = pk2(v[0], v[1]); w.y = pk2(v[2], v[3]); w.z = pk2(v[4], v[5]); w.w = pk2(v[6], v[7]);
                        const int seg = col >> 6, d0 = col & 63, b = row / T, t = row % T, c1 = t >> 4, l1 = t & 15;
                        bf16* base = (bf16*)dst + (size_t)(seg * 4 + b) * (4 * 128 * 512);
                        *(v4u*)(base + ((size_t)((c1 >> 5) * 128 + 4 * l1 + (d0 >> 4)) * 64 + 32 * ((d0 >> 3) & 1) + (c1 & 31)) * 8) = w;
                        if (c1 > 0) { const int c0 = c1 - 1, l0 = l1 + 16;
                            *(v4u*)(base + ((size_t)((c0 >> 5) * 128 + 4 * l0 + (d0 >> 4)) * 64 + 32 * ((d0 >> 3) & 1) + (c0 & 31)) * 8) = w; }
                    } else if (cls == 4) {
                        v4u w; w.x = pk2(v[0], v[1]); w.y = pk2(v[2], v[3]); w.z = pk2(v[4], v[5]); w.w = pk2(v[6], v[7]);
                        const int b = row / T, t = row % T, hs = hbase + (col >> 6), d0 = col & 63;
                        *(v4u*)((bf16*)dst + (size_t)(b * nh + hs) * (T * 64) + kfrag_off(t, d0)) = w;
                    } else if (cls == 2) {
                        const int b = row / T, t = row % T, hs = hbase + (col >> 6), d0 = col & 63;
                        bf16* tp = (bf16*)dst + (size_t)(b * nh + hs) * (T * 64) + vfrag_off(t, d0);
#pragma unroll
                        for (int j = 0; j < 8; ++j) tp[8 * j] = (bf16)f2bf(v[j]);
                    } else {
                        if (col < 64) { float* o = (float*)dst + (size_t)row * 64 + col; *(f32x4*)o = (f32x4){v[0], v[1], v[2], v[3]}; *(f32x4*)(o + 4) = (f32x4){v[4], v[5], v[6], v[7]}; }
                    }
                }
            }
    }
};

struct Args { const float* in[24]; float* out; unsigned char* ws; int ph_lo, ph_hi; };
struct Frame {
    unsigned char* lds; int tid, lane, wave, vcu, G;
    float* out; unsigned char* ws; unsigned char* R; float* ctlf;
};
__device__ __forceinline__ bf16* wptr(const Frame& F, int layer, size_t off) { return (bf16*)(F.ws + WS_W + (size_t)layer * WL_SIZE + off); }
__device__ __forceinline__ u64* ssptr(const Frame& F, int i) { return (u64*)(F.ctlf + CW_SS) + (size_t)i * M; }
typedef const __attribute__((address_space(4))) Args* KArgs;
__device__ __forceinline__ KArgs kargs() { KArgs p = (KArgs)__builtin_amdgcn_kernarg_segment_ptr(); asm volatile("" : "+s"(p)); return p; }
__device__ __forceinline__ Frame make_frame(unsigned char* ws, float* out, unsigned char* lds) {
    int tid = threadIdx.x, vcu = blockIdx.x, G = gridDim.x; asm volatile("" : "+v"(tid), "+s"(vcu), "+s"(G));
    Frame F; F.lds = lds; F.tid = tid; F.lane = F.tid & 63; F.wave = __builtin_amdgcn_readfirstlane(F.tid >> 6); F.G = G; F.vcu = vcu;
    F.out = out; F.ws = ws; F.R = ws + WS_R; F.ctlf = (float*)(ws + WS_CTL); return F;
}

__device__ __forceinline__ int win_src_col(int n) {
    if (n < 512) return n;
    if (n < 1024) return 1304 + (n - 512);
    if (n < 1536) return 1304 + 512 + (n - 1024);
    if (n < 2304) {
        const int tile = (n - 1536) >> 8, i = (n - 1536) & 255, seg = i >> 6, d = i & 63;
        int branch, kv, hk;
        if (tile == 0) { branch = 1 + (seg >> 1); kv = 0; hk = seg & 1; }
        else if (tile == 1) { branch = 0; kv = seg >> 1; hk = seg & 1; }
        else { branch = 1 + (seg >> 1); kv = 1; hk = seg & 1; }
        return 512 + ((branch * 2 + kv) * 2 + hk) * 64 + d;
    }
    if (n < 2816) return 1304 + 1024 + (n - 2304);
    if (n < 3840) return 2840 + (n - 2816);
    if (n < 5376) return 3864 + (n - 3840);
    const int i = n - 5376;
    if (i < 16) return 5400 + i;
    if (i < 40) return 1280 + (i - 16);
    return -1;
}
template <bool FRAG>
__device__ __forceinline__ void transpose_item(const float* W, int ldw, int srccol, const float* gain, bf16* WT, int K, int n0, int k0, float* scr, int lane) {
#pragma unroll 8
    for (int i = 0; i < 32; ++i) { const int kk = 2 * i + (lane >> 5);
        float v = 0.f; if (srccol >= 0) v = W[(size_t)(k0 + kk) * ldw + srccol]; if (gain) v *= gain[k0 + kk];
        scr[kk * 33 + (lane & 31)] = v; }
    __builtin_amdgcn_wave_barrier(); LDS_WAIT();
    const int c = lane & 7;
#pragma unroll
    for (int j = 0; j < 4; ++j) { const int n = (lane >> 3) + 8 * j; const float* s = scr + (8 * c) * 33 + n;
        v4u o; o.x = pk2(s[0 * 33], s[1 * 33]); o.y = pk2(s[2 * 33], s[3 * 33]); o.z = pk2(s[4 * 33], s[5 * 33]); o.w = pk2(s[6 * 33], s[7 * 33]);
        if (FRAG) { const int nn = n0 + n, k8 = k0 + 8 * c; *(v4u*)(WT + ((size_t)((nn >> 5) * (K / 16) + (k8 >> 4)) * 64 + 32 * ((k8 >> 3) & 1) + (nn & 31)) * 8) = o; }
        else *(v4u*)(WT + (size_t)(n0 + n) * K + k0 + 8 * c) = o; }
    __builtin_amdgcn_wave_barrier(); LDS_WAIT();
}
template <int MODE>
__device__ __forceinline__ void transpose_item4(const float* W0, const float* W1, int ldw, const float* gain, bf16* WT, int K, int n0, int k0, int lane) {
    const int kc = lane & 3, ng = lane >> 2;
#pragma unroll 1
    for (int sub = 0; sub < 4; ++sub) {
        const int nn = n0 + 64 * sub + 4 * ng;
        const float* W = W0; int col = nn;
        if (MODE == 1) { W = ((nn & 255) >= 128) ? W1 : W0; col = (nn >> 8) * 128 + (nn & 127); }
        if (MODE == 2) col = win_src_col(nn);
#pragma unroll
        for (int ks = 0; ks < 2; ++ks) {
            const int kk = k0 + 32 * ks + 8 * kc;
            const float* src = W + (size_t)kk * ldw + (col >= 0 ? col : 0);
            f32x4 v[8];
#pragma unroll
            for (int i = 0; i < 8; ++i) v[i] = *(const f32x4*)(src + (size_t)i * ldw) * (gain ? gain[kk + i] : 1.0f);
            if (MODE == 2 && col < 0) {
#pragma unroll
                for (int i = 0; i < 8; ++i) v[i] = (f32x4){0.f, 0.f, 0.f, 0.f};
            }
            bf16* drow = WT + (size_t)nn * K + kk;
#pragma unroll
            for (int j = 0; j < 4; ++j) { v4u o; o.x = pk2(v[0][j], v[1][j]); o.y = pk2(v[2][j], v[3][j]); o.z = pk2(v[4][j], v[5][j]); o.w = pk2(v[6][j], v[7][j]);
                *(v4u*)(drow + (size_t)j * K) = o; }
        }
    }
}
__device__ __forceinline__ unsigned pk4_i8(float a, float b, float c, float d) {
    const int ia = __float2int_rn(__builtin_amdgcn_fmed3f(a, -127.f, 127.f)), ib = __float2int_rn(__builtin_amdgcn_fmed3f(b, -127.f, 127.f)), ic = __float2int_rn(__builtin_amdgcn_fmed3f(c, -127.f, 127.f)), id = __float2int_rn(__builtin_amdgcn_fmed3f(d, -127.f, 127.f));
    return (unsigned)(ia & 0xff) | ((unsigned)(ib & 0xff) << 8) | ((unsigned)(ic & 0xff) << 16) | ((unsigned)id << 24);
}
template <int MODE, bool I8 = false>
__device__ __forceinline__ void transpose_item_8(const float* W0, const float* W1, int ldw, const float* gain, unsigned char* WT, int K, int n0, int k0, int lane, float wsc = W8_SCALE) {
    const int kc = lane & 3, ng = lane >> 2;
#pragma unroll 1
    for (int sub = 0; sub < 4; ++sub) {
        const int nn = n0 + 64 * sub + 4 * ng;
        const float* W = W0; int col = nn;
        if (MODE == 1) { W = ((nn & 255) >= 128) ? W1 : W0; col = (nn >> 8) * 128 + (nn & 127); }
        if (MODE == 2) col = win_src_col(nn);
#pragma unroll 1
        for (int ks = 0; ks < 2; ++ks) {
            const int kk = k0 + 64 * ks + 16 * kc;
            const float* src = W + (size_t)kk * ldw + (col >= 0 ? col : 0);
            f32x4 v[16];
#pragma unroll
            for (int i = 0; i < 16; ++i) v[i] = *(const f32x4*)(src + (size_t)i * ldw) * ((gain ? gain[kk + i] : 1.0f) * wsc);
            if (MODE == 2 && col < 0) {
#pragma unroll
                for (int i = 0; i < 16; ++i) v[i] = (f32x4){0.f, 0.f, 0.f, 0.f};
            }
            unsigned char* drow = WT + (size_t)nn * K + kk;
#pragma unroll
            for (int j = 0; j < 4; ++j) { v4u o;
                if (I8) { o.x = pk4_i8(v[0][j], v[1][j], v[2][j], v[3][j]); o.y = pk4_i8(v[4][j], v[5][j], v[6][j], v[7][j]); o.z = pk4_i8(v[8][j], v[9][j], v[10][j], v[11][j]); o.w = pk4_i8(v[12][j], v[13][j], v[14][j], v[15][j]); }
                else { o.x = pk4_fp8(v[0][j], v[1][j], v[2][j], v[3][j]); o.y = pk4_fp8(v[4][j], v[5][j], v[6][j], v[7][j]); o.z = pk4_fp8(v[8][j], v[9][j], v[10][j], v[11][j]); o.w = pk4_fp8(v[12][j], v[13][j], v[14][j], v[15][j]); }
                *(v4u*)(drow + (size_t)j * K) = o; }
        }
    }
}
__device__ __forceinline__ int t5_bucket(int dist) {
    if (dist < 16) return dist;
    return 16 + (dist >= 19) + (dist >= 21) + (dist >= 24) + (dist >= 27) + (dist >= 31) + (dist >= 35) + (dist >= 40) + (dist >= 46) + (dist >= 52) + (dist >= 59)
              + (dist >= 67) + (dist >= 77) + (dist >= 87) + (dist >= 99) + (dist >= 113);
}
struct ProIn { const float *x, *relb, *n1, *g1, *u1, *d1, *nm, *win, *wout, *nnsa, *nsb, *nssd, *n2, *g2, *u2, *d2, *cpos, *cw; };
constexpr unsigned CV_GU(int sg) { return 1u << sg; }
constexpr unsigned CV_DN(int sg) { return 16u << sg; }
constexpr unsigned CV_IN(int l) { return 256u << l; }
constexpr unsigned CV_OUT(int l) { return 1024u << l; }
template <unsigned MASK>
__device__ __forceinline__ void convert_weights(Frame& F, const ProIn I, int gw, int NGW) {
    const int lane = F.lane;
    constexpr int I_GU8 = (D / 128) * (NGU / 256), I_GU16 = (D / 64) * (NGU / 256), I_DN16 = (FF / 64) * (D / 256), I_DN8 = (FF / 128) * (D / 256), I_IN16 = (D / 64) * (NIN / 256), I_IN8 = (D / 128) * (NIN / 256), I_OUT = (D / 64) * (D / 256);
    constexpr int C_GU[4] = {(MASK & 1u) ? ((gu8(0) || gui8(0)) ? I_GU8 : I_GU16) : 0, (MASK & 2u) ? (gu8(1) ? I_GU8 : I_GU16) : 0, (MASK & 4u) ? (gu8(2) ? I_GU8 : I_GU16) : 0, (MASK & 8u) ? (gu8(3) ? I_GU8 : I_GU16) : 0};
    constexpr int C_DN[4] = {(MASK & 16u) ? (dn8(0) ? I_DN8 : I_DN16) : 0, (MASK & 32u) ? (dn8(1) ? I_DN8 : I_DN16) : 0, (MASK & 64u) ? (dn8(2) ? I_DN8 : I_DN16) : 0, (MASK & 128u) ? (dn8(3) ? I_DN8 : I_DN16) : 0};
    constexpr int C_IN[2] = {(MASK & 256u) ? (wini8(0) ? I_IN8 : I_IN16) : 0, (MASK & 512u) ? (wini8(1) ? I_IN8 : I_IN16) : 0};
    constexpr int C_OUT[2] = {(MASK & 1024u) ? I_OUT : 0, (MASK & 2048u) ? I_OUT : 0};
    constexpr int I_ALL = C_GU[0] + C_GU[1] + C_GU[2] + C_GU[3] + C_DN[0] + C_DN[1] + C_DN[2] + C_DN[3] + C_IN[0] + C_IN[1] + C_OUT[0] + C_OUT[1];
    for (int it = gw; it < I_ALL; it += NGW) {
        int r = it; bool done = false;
#pragma unroll
        for (int sg = 0; sg < 4; ++sg) {
            if (C_GU[sg] > 0 && !done && r < C_GU[sg]) {
                const int l = sg >> 1, f = sg & 1;
                const int nb = r % (NGU / 256), kb = r / (NGU / 256), n0 = nb * 256;
                const float* gain = (f == 0 ? I.n1 : I.n2) + (size_t)l * D;
                const float* Wg = (f == 0 ? I.g1 : I.g2) + (size_t)l * D * FF; const float* Wu = (f == 0 ? I.u1 : I.u2) + (size_t)l * D * FF;
                if (gui8(sg)) { const float wmax = __uint_as_float(((const unsigned*)F.ctlf)[CW_WMAX]);
                    transpose_item_8<1, true>(Wg, Wu, FF, gain, (unsigned char*)wptr(F, l, f == 0 ? WL_GU1 : WL_GU2), D, n0, kb * 128, lane, 127.0f / wmax); }
                else if (gu8(sg)) transpose_item_8<1>(Wg, Wu, FF, gain, (unsigned char*)wptr(F, l, f == 0 ? WL_GU1 : WL_GU2), D, n0, kb * 128, lane);
                else transpose_item4<1>(Wg, Wu, FF, gain, wptr(F, l, f == 0 ? WL_GU1 : WL_GU2), D, n0, kb * 64, lane);
                done = true;
            }
            if (!done) r -= C_GU[sg];
        }
        if (done) continue;
#pragma unroll
        for (int sg = 0; sg < 4; ++sg) {
            if (C_DN[sg] > 0 && !done && r < C_DN[sg]) {
                const int l = sg >> 1, f = sg & 1;
                const int nb = r % (D / 256), kb = r / (D / 256), n0 = nb * 256;
                const float* W = (f == 0 ? I.d1 : I.d2) + (size_t)l * FF * D;
                if (dn8(sg)) transpose_item_8<0>(W, W, D, nullptr, (unsigned char*)wptr(F, l, f == 0 ? WL_DN1 : WL_DN2), FF, n0, kb * 128, lane);
                else transpose_item4<0>(W, W, D, nullptr, wptr(F, l, f == 0 ? WL_DN1 : WL_DN2), FF, n0, kb * 64, lane);
                done = true;
            }
            if (!done) r -= C_DN[sg];
        }
        if (done) continue;
#pragma unroll
        for (int l = 0; l < 2; ++l) {
            if (C_IN[l] > 0 && !done && r < C_IN[l]) {
                const int nb = r % (NIN / 256), kb = r / (NIN / 256), n0 = nb * 256, k0 = kb * 64;
                const float* W = I.win + (size_t)l * D * NIN_SRC;
                if (wini8(l)) { const float wmax = __uint_as_float(((const unsigned*)F.ctlf)[CW_WMAX + 1 + l]);
                    transpose_item_8<2, true>(W, W, NIN_SRC, I.nm + (size_t)l * D, (unsigned char*)wptr(F, l, WL_IN), D, n0, kb * 128, lane, 127.0f / wmax); }
                else transpose_item4<2>(W, W, NIN_SRC, I.nm + (size_t)l * D, wptr(F, l, WL_IN), D, n0, k0, lane);
                done = true;
            }
            if (!done) r -= C_IN[l];
        }
        if (done) continue;
#pragma unroll
        for (int l = 0; l < 2; ++l) {
            if (C_OUT[l] > 0 && !done && r < C_OUT[l]) {
                const int nb = r % (D / 256), kb = r / (D / 256), n0 = nb * 256, k0 = kb * 64;
                const float* W = I.wout + (size_t)l * D * D;
                const float* gbase = (k0 < 512) ? I.nnsa + (size_t)l * 512 : (k0 < 1024) ? I.nsb + (size_t)l * 512 - 512 : I.nssd + (size_t)l * 1024 - 1024;
                transpose_item4<0>(W, W, D, gbase, wptr(F, l, WL_OUT), D, n0, k0, lane);
                done = true;
            }
            if (!done) r -= C_OUT[l];
        }
    }
}
constexpr unsigned CVM_PRO = 0xFFFu;
constexpr unsigned CVM_GU[4] = {0u, 0u, 0u, 0u};
constexpr unsigned CVM_WIN[2] = {0u, 0u};
static_assert((CVM_PRO | CVM_GU[0] | CVM_GU[1] | CVM_GU[2] | CVM_GU[3] | CVM_WIN[0] | CVM_WIN[1]) == 0xFFFu, "every matrix converted exactly once");
#ifndef COOP_CVT
#define COOP_CVT 1
#endif
constexpr bool COOP_OK = COOP_CVT && GU_I8 && GU8_MASK == 0xE && DN8_MASK == 0xF && (WIN_I8 & ~2) == 0;
struct CvtStep { const float* src; const float* gain; unsigned char* dst; float wsc; int ldw, K, i8, valid, b16; };
constexpr int CS_INB = (D / 64) * (NIN / 256), CS_OUT = (D / 64) * (D / 256);
constexpr int CS_GU = (D / 128) * (NGU / 256), CS_DN = (FF / 128) * (D / 256), CS_IN = (D / 128) * (NIN / 256);
constexpr int CS_ONE = 4 * CS_GU + 4 * CS_DN + (wini8(1) ? CS_IN : 0);
constexpr int CS_ALL = CS_ONE + (wini8(0) ? 0 : CS_INB) + (wini8(1) ? 0 : CS_INB) + 2 * CS_OUT;
__device__ __forceinline__ CvtStep cvt_decode(const Frame& F, const float* Ig1, const float* Iu1, const float* Id1, const float* Ig2, const float* Iu2, const float* Id2, const float* In1, const float* In2, const float* Inm, const float* Iwin,
                                              const float* Iwout, const float* Innsa, const float* Insb, const float* Inssd, int r, int wave, int lane) {
    CvtStep c; c.valid = 1; c.i8 = 0; c.b16 = 0; c.wsc = W8_SCALE; c.gain = nullptr;
    if (r < 4 * CS_GU) {
        const int sg = r / CS_GU, rr = r % CS_GU, l = sg >> 1, f = sg & 1, nb = rr % (NGU / 256), kb = rr / (NGU / 256), nn = nb * 256 + 4 * lane, k0 = kb * 128;
        const float* W = ((nn & 255) >= 128 ? (f == 0 ? Iu1 : Iu2) : (f == 0 ? Ig1 : Ig2)) + (size_t)l * D * FF;
        c.src = W + (size_t)(k0 + 16 * wave) * FF + (nn >> 8) * 128 + (nn & 127); c.ldw = FF; c.gain = (f == 0 ? In1 : In2) + (size_t)l * D + k0 + 16 * wave;
        c.dst = (unsigned char*)wptr(F, l, f == 0 ? WL_GU1 : WL_GU2) + (size_t)(nb * 256) * D + k0; c.K = D;
        if (sg == 0) { c.i8 = 1; c.wsc = 127.0f / __uint_as_float(((const unsigned*)F.ctlf)[CW_WMAX]); }
    } else if (r < 4 * CS_GU + 4 * CS_DN) {
        const int q = r - 4 * CS_GU, sg = q / CS_DN, rr = q % CS_DN, l = sg >> 1, f = sg & 1, nb = rr % (D / 256), kb = rr / (D / 256), nn = nb * 256 + 4 * lane, k0 = kb * 128;
        c.src = (f == 0 ? Id1 : Id2) + (size_t)l * FF * D + (size_t)(k0 + 16 * wave) * D + nn; c.ldw = D;
        c.dst = (unsigned char*)wptr(F, l, f == 0 ? WL_DN1 : WL_DN2) + (size_t)(nb * 256) * FF + k0; c.K = FF;
    } else if (r >= CS_ONE) {
        int q = r - CS_ONE; c.b16 = 1; c.wsc = 1.0f;
        constexpr int NB16 = (wini8(0) ? 0 : 1) + (wini8(1) ? 0 : 1);
        if (q < NB16 * CS_INB) {
            const int l = (NB16 == 2) ? q / CS_INB : (wini8(0) ? 1 : 0), rr = q % CS_INB, nb = rr % (NIN / 256), kb = rr / (NIN / 256), nn = nb * 256 + 4 * lane, k0 = kb * 64, col = win_src_col(nn);
            c.valid = col >= 0;
            c.src = Iwin + (size_t)l * D * NIN_SRC + (size_t)(k0 + 8 * wave) * NIN_SRC + (col >= 0 ? col : 0); c.ldw = NIN_SRC; c.gain = Inm + (size_t)l * D + k0 + 8 * wave;
            c.dst = (unsigned char*)wptr(F, l, WL_IN) + ((size_t)(nb * 256) * D + k0) * 2; c.K = 2 * D;
        } else {
            q -= NB16 * CS_INB;
            const int l = q / CS_OUT, rr = q % CS_OUT, nb = rr % (D / 256), kb = rr / (D / 256), nn = nb * 256 + 4 * lane, k0 = kb * 64;
            c.src = Iwout + (size_t)l * D * D + (size_t)(k0 + 8 * wave) * D + nn; c.ldw = D;
            c.gain = ((k0 < 512) ? Innsa + (size_t)l * 512 : (k0 < 1024) ? Insb + (size_t)l * 512 - 512 : Inssd + (size_t)l * 1024 - 1024) + k0 + 8 * wave;
            c.dst = (unsigned char*)wptr(F, l, WL_OUT) + ((size_t)(nb * 256) * D + k0) * 2; c.K = 2 * D;
        }
    } else {
        const int rr = r - 4 * CS_GU - 4 * CS_DN, l = 1, nb = rr % (NIN / 256), kb = rr / (NIN / 256), nn = nb * 256 + 4 * lane, k0 = kb * 128, col = win_src_col(nn);
        c.valid = col >= 0;
        c.src = Iwin + (size_t)l * D * NIN_SRC + (size_t)(k0 + 16 * wave) * NIN_SRC + (col >= 0 ? col : 0); c.ldw = NIN_SRC; c.gain = Inm + (size_t)l * D + k0 + 16 * wave;
        c.dst = (unsigned char*)wptr(F, l, WL_IN) + (size_t)(nb * 256) * D + k0; c.K = D;
        c.i8 = 1; c.wsc = 127.0f / __uint_as_float(((const unsigned*)F.ctlf)[CW_WMAX + 1 + l]);
    }
    return c;
}
__device__ __forceinline__ void coop_convert(Frame& F, const ProIn PI) {
    constexpr int LSTR = 144;
    const float *Ig1 = PI.g1, *Iu1 = PI.u1, *Id1 = PI.d1, *Ig2 = PI.g2, *Iu2 = PI.u2, *Id2 = PI.d2, *In1 = PI.n1, *In2 = PI.n2, *Inm = PI.nm, *Iwin = PI.win, *Iwout = PI.wout, *Innsa = PI.nnsa, *Insb = PI.nsb, *Inssd = PI.nssd;
    asm volatile("" : "+s"(Ig1), "+s"(Iu1), "+s"(Id1), "+s"(Ig2), "+s"(Iu2), "+s"(Id2), "+s"(In1), "+s"(In2), "+s"(Inm), "+s"(Iwin), "+s"(Iwout), "+s"(Innsa), "+s"(Insb), "+s"(Inssd));
#define CVT_DECODE(rr) cvt_decode(F, Ig1, Iu1, Id1, Ig2, Iu2, Id2, In1, In2, Inm, Iwin, Iwout, Innsa, Insb, Inssd, (rr), wave, lane)
    LAS unsigned char* const l3 = (LAS unsigned char*)F.lds;
    const int lane = F.lane, wave = F.wave, tid = F.tid;
    int r = F.vcu;
    if (r >= CS_ALL) return;
    CvtStep c = CVT_DECODE(r);
    f32x4 v[16];
#pragma unroll
    for (int i = 0; i < 16; ++i) if (i < 8 || !c.b16) v[i] = *(const f32x4*)(c.src + (size_t)i * c.ldw);
    int buf = 0;
#pragma unroll 1
    for (;;) {
        LAS unsigned char* tile = l3 + buf * (256 * LSTR);
#pragma unroll
        for (int i = 0; i < 16; ++i) if (i < 8 || !c.b16) { const float sc = (c.gain ? c.gain[i] : 1.0f) * c.wsc; v[i] = c.valid ? v[i] * sc : (f32x4){0.f, 0.f, 0.f, 0.f}; }
#pragma unroll
        for (int j = 0; j < 4; ++j) { v4u o;
            if (c.b16) { o.x = pk2(v[0][j], v[1][j]); o.y = pk2(v[2][j], v[3][j]); o.z = pk2(v[4][j], v[5][j]); o.w = pk2(v[6][j], v[7][j]); }
            else if (c.i8) { o.x = pk4_i8(v[0][j], v[1][j], v[2][j], v[3][j]); o.y = pk4_i8(v[4][j], v[5][j], v[6][j], v[7][j]); o.z = pk4_i8(v[8][j], v[9][j], v[10][j], v[11][j]); o.w = pk4_i8(v[12][j], v[13][j], v[14][j], v[15][j]); }
            else { o.x = pk4_fp8(v[0][j], v[1][j], v[2][j], v[3][j]); o.y = pk4_fp8(v[4][j], v[5][j], v[6][j], v[7][j]); o.z = pk4_fp8(v[8][j], v[9][j], v[10][j], v[11][j]); o.w = pk4_fp8(v[12][j], v[13][j], v[14][j], v[15][j]); }
            *(LAS v4u*)(tile + (4 * lane + j) * LSTR + 16 * wave) = o; }
        unsigned char* const dst = c.dst; const int K = c.K;
        const int rn = r + F.G; const bool more = rn < CS_ALL;
        if (more) { c = CVT_DECODE(rn);
#pragma unroll
            for (int i = 0; i < 16; ++i) if (i < 8 || !c.b16) v[i] = *(const f32x4*)(c.src + (size_t)i * c.ldw); }
        asm volatile("s_waitcnt lgkmcnt(0)" ::: "memory"); __builtin_amdgcn_s_barrier(); asm volatile("" ::: "memory");
#pragma unroll
        for (int ps = 0; ps < 4; ++ps) { const int row = (tid >> 3) + 64 * ps, q = tid & 7;
            const v4u w = *(const LAS v4u*)(tile + row * LSTR + 16 * q);
            *(v4u*)(dst + (size_t)row * K + 16 * q) = w; }
        if (!more) break;
        r = rn; buf ^= 1;
    }
#undef CVT_DECODE
    __syncthreads();
}
__device__ __forceinline__ void p_prologue_b(Frame& F, const ProIn I) {
    const int gw = F.vcu * NWAVES + F.wave, NGW = F.G * NWAVES;
    if (COOP_OK) coop_convert(F, I);
    else convert_weights<CVM_PRO>(F, I, gw, NGW);
}
__device__ __forceinline__ void p_prologue(Frame& F, const ProIn I) {
    float* scr = (float*)(F.lds + F.wave * 16384);
    const int gw = F.vcu * NWAVES + F.wave, NGW = F.G * NWAVES, lane = F.lane;
    if (GU_I8 || WIN_I8) {
        float wmx = 0.f, wmi0 = 0.f, wmi1 = 0.f;
        if (WIN_I8)
        for (int it = gw; it < DEPTH * D; it += NGW) {
            const int l = it / D, k = it % D;
            if (!((WIN_I8 >> l) & 1)) continue; const f32x4* wr = (const f32x4*)(I.win + ((size_t)l * D + k) * NIN_SRC); float mx = 0.f;
            constexpr int NV = NIN_SRC / 4;
            f32x4 vv[(NV + 63) / 64];
#pragma unroll
            for (int q = 0; q < (NV + 63) / 64; ++q) { const int idx = lane + 64 * q; vv[q] = (idx < NV) ? wr[idx] : (f32x4){0.f, 0.f, 0.f, 0.f}; }
#pragma unroll
            for (int q = 0; q < (NV + 63) / 64; ++q) mx = fmaxf(fmaxf(mx, fmaxf(fabsf(vv[q][0]), fabsf(vv[q][1]))), fmaxf(fabsf(vv[q][2]), fabsf(vv[q][3])));
            mx = wave_max(mx) * fabsf(I.nm[(size_t)l * D + k]);
            if (l == 0) wmi0 = fmaxf(wmi0, mx); else wmi1 = fmaxf(wmi1, mx);
        }
        if (GU_I8)
        for (int rep_m = 0; rep_m < REP_AMAX; ++rep_m)
        for (int it = gw; it < 2 * D; it += NGW) {
            const int mat = it / D, k = it % D; const float* wr = (mat ? I.u1 : I.g1) + (size_t)k * FF; float mx = 0.f;
            f32x4 vv[FF / 256];
#pragma unroll
            for (int q = 0; q < FF / 256; ++q) vv[q] = *((const f32x4*)wr + lane + 64 * q);
#pragma unroll
            for (int q = 0; q < FF / 256; ++q) mx = fmaxf(fmaxf(mx, fmaxf(fabsf(vv[q][0]), fabsf(vv[q][1]))), fmaxf(fabsf(vv[q][2]), fabsf(vv[q][3])));
            wmx = fmaxf(wmx, wave_max(mx) * fabsf(I.n1[k]));
        }
        float* red = (float*)(F.lds + 131072 - 128);
        if (lane == 0) { red[F.wave] = wmx; red[8 + F.wave] = wmi0; red[16 + F.wave] = wmi1; }
        __syncthreads();
        if (F.tid < 3) { float m8 = red[8 * F.tid];
#pragma unroll
            for (int q = 1; q < NWAVES; ++q) m8 = fmaxf(m8, red[8 * F.tid + q]);
            if (F.tid == 0 ? GU_I8 != 0 : WIN_I8 != 0) atomicMax((unsigned*)F.ctlf + CW_WMAX + F.tid, __float_as_uint(m8)); }
        __syncthreads();
    }
    if (blockIdx.x >= 64 && blockIdx.x < 64 + DEPTH * 2 * 16) {
        const int idx = (int)blockIdx.x - 64, mat = idx & 3, sl = idx >> 2, dd = F.tid & 63, sub = F.tid >> 6;
        const float* w = I.cw + (size_t)mat * 2048 * 64; const float* pos = I.cpos + (size_t)mat * 2048;
        float a = 0.f;
#pragma unroll
        for (int k = 0; k < 16; ++k) { const int kk = sl * 128 + sub * 16 + k; a += pos[kk] * w[kk * 64 + dd]; }
        float* red = (float*)F.lds;
        red[F.tid] = a;
        __syncthreads();
        if (F.tid < 64) { float t = 0.f;
#pragma unroll
            for (int q = 0; q < 8; ++q) t += red[q * 64 + F.tid];
            ((float*)(F.ws + WS_TAB + TAB_PB))[(mat * 16 + sl) * 64 + F.tid] = t; }
        __syncthreads();
    }
    if (F.wave == NWAVES - 1)
    for (int it = F.vcu; it < DEPTH * 2 * 64; it += F.G) {
        const int mat = it >> 6, r = it & 63, nb = r & 1, kb = r >> 1;
        transpose_item<true>(I.cw + (size_t)mat * 2048 * 64, 64, nb * 32 + (lane & 31), nullptr, (bf16*)(F.ws + WS_CW) + (size_t)mat * 64 * 2048, 2048, nb * 32, kb * 64, scr, lane);
    }
    {
        const float* x = I.x; bf16* xb = (bf16*)(F.ws + WS_XB); u64* ss0 = ssptr(F, 0);
        for (int m = gw; m < M; m += NGW) {
            const f32x4* xr = (const f32x4*)(x + (size_t)m * D) + lane; float s = 0.f;
            if (gui8(0)) {
                f32x4 v[8]; float mx = 0.f;
#pragma unroll
                for (int j = 0; j < 8; ++j) { v[j] = xr[64 * j]; s += (v[j][0] * v[j][0] + v[j][1] * v[j][1]) + (v[j][2] * v[j][2] + v[j][3] * v[j][3]); mx = fmaxf(fmaxf(mx, fmaxf(fabsf(v[j][0]), fabsf(v[j][1]))), fmaxf(fabsf(v[j][2]), fabsf(v[j][3]))); }
                mx = fmaxf(wave_max(mx), 1e-30f);
                const float inv = 127.0f / mx;
                unsigned* o = (unsigned*)((unsigned char*)xb + (size_t)m * D) + lane;
#pragma unroll
                for (int j = 0; j < 8; ++j) o[64 * j] = pk4_i8(v[j][0] * inv, v[j][1] * inv, v[j][2] * inv, v[j][3] * inv);
                if (lane == 0) ((float*)(F.ws + WS_TAB + TAB_XS))[m] = mx * (1.0f / 127.0f);
            } else if (gu8(0)) {
                unsigned* o = (unsigned*)((unsigned char*)xb + (size_t)m * D) + lane;
#pragma unroll
                for (int j = 0; j < 8; ++j) { const f32x4 v = xr[64 * j]; s += (v[0] * v[0] + v[1] * v[1]) + (v[2] * v[2] + v[3] * v[3]); o[64 * j] = pk4_fp8(v[0] * X8_SCALE, v[1] * X8_SCALE, v[2] * X8_SCALE, v[3] * X8_SCALE); }
            } else {
                v2u* o = (v2u*)(xb + (size_t)m * D) + lane;
#pragma unroll
                for (int j = 0; j < 8; ++j) { const f32x4 v = xr[64 * j]; s += (v[0] * v[0] + v[1] * v[1]) + (v[2] * v[2] + v[3] * v[3]); v2u w; w.x = pk2(v[0], v[1]); w.y = pk2(v[2], v[3]); o[64 * j] = w; }
            }
            s = wave_sum(s);
            if (lane == 0) ss0[m] = (u64)(s * SS_SCALE + 0.5f);
        }
    }
    if (blockIdx.x == 0) {
        float* tab = (float*)(F.ws + WS_TAB);
        for (int i = F.tid; i < 8 * 129; i += NTHR) { const int h = i / 129, dist = i % 129; tab[i] = I.relb[t5_bucket(dist) * 8 + h] * LOG2E; }
    }
}

typedef short bf16x8 __attribute__((ext_vector_type(8)));
typedef float f32x16 __attribute__((ext_vector_type(16)));
__device__ __forceinline__ unsigned cvtpk(float lo, float hi) { unsigned r; asm volatile("v_cvt_pk_bf16_f32 %0, %1, %2" : "=v"(r) : "v"(lo), "v"(hi)); return r; }
__device__ __forceinline__ bf16x8 mk_frag(v2u a, v2u b) { v4u w; w.x = a.x; w.y = a.y; w.z = b.x; w.w = b.y; return __builtin_bit_cast(bf16x8, w); }
__device__ __forceinline__ bf16x8 acc_frag(const f32x16& x, int s) {
    v4u w;
    if (s == 0) { w.x = cvtpk(x[0], x[1]); w.y = cvtpk(x[2], x[3]); w.z = cvtpk(x[4], x[5]); w.w = cvtpk(x[6], x[7]); }
    else        { w.x = cvtpk(x[8], x[9]); w.y = cvtpk(x[10], x[11]); w.z = cvtpk(x[12], x[13]); w.w = cvtpk(x[14], x[15]); }
    return __builtin_bit_cast(bf16x8, w);
}
#define MFMA32(a, b, c) __builtin_amdgcn_mfma_f32_32x32x16_bf16((a), (b), (c), 0, 0, 0)
template <bool DIAG>
__device__ __forceinline__ void sb_block(f32x16& O0, f32x16& O1, float& Rc, const bf16x8 (&Kc)[4], const bf16x8 (&Vc)[4], const bf16x8 (&Qf)[4], int r, int h) {
    f32x16 S;
#pragma unroll
    for (int i = 0; i < 16; ++i) S[i] = 0.f;
#pragma unroll
    for (int s = 0; s < 4; ++s) S = MFMA32(Kc[s], Qf[s], S);
    f32x4 B4[4], W4[4];
#pragma unroll
    for (int k = 0; k < 4; ++k) {
        f32x4 e4;
#pragma unroll
        for (int c = 0; c < 4; ++c) e4[c] = fexp2(__builtin_amdgcn_fmed3f(S[4 * k + c], -100.f, 100.f));
        const f32x4 d4 = e4 + 1.0f;
        f32x4 w4;
#pragma unroll
        for (int c = 0; c < 4; ++c) w4[c] = frcp(d4[c]);
        f32x4 b4 = e4 * w4;
        if (DIAG) {
#pragma unroll
            for (int c = 0; c < 4; ++c) if (c + 8 * k + 4 * h >= r) { w4[c] = 1.f; b4[c] = 0.f; }
        }
        W4[k] = w4; B4[k] = b4;
    }
    float G[4], oth[4];
#pragma unroll
    for (int k = 0; k < 4; ++k) {
        const float s2 = W4[k][3], s1 = s2 * W4[k][2], s0 = s1 * W4[k][1];
        G[k] = s0 * W4[k][0];
        B4[k] = B4[k] * (f32x4){s0, s1, s2, 1.0f};
    }
#pragma unroll
    for (int k = 0; k < 4; ++k) oth[k] = __shfl_xor(G[k], 32);
    const float EO3 = G[3] * oth[3], EO2 = G[2] * oth[2], EO1 = G[1] * oth[1], EO0 = G[0] * oth[0];
    float Tk[4]; Tk[3] = Rc; Tk[2] = EO3 * Rc; Tk[1] = Tk[2] * EO2; Tk[0] = Tk[1] * EO1;
    Rc = Tk[0] * EO0;
#pragma unroll
    for (int k = 0; k < 4; ++k) { const float sk = h == 0 ? Tk[k] * oth[k] : Tk[k]; B4[k] = B4[k] * sk; }
    v4u p0, p1;
    p0.x = cvtpk(B4[0][0], B4[0][1]); p0.y = cvtpk(B4[0][2], B4[0][3]); p0.z = cvtpk(B4[1][0], B4[1][1]); p0.w = cvtpk(B4[1][2], B4[1][3]);
    p1.x = cvtpk(B4[2][0], B4[2][1]); p1.y = cvtpk(B4[2][2], B4[2][3]); p1.z = cvtpk(B4[3][0], B4[3][1]); p1.w = cvtpk(B4[3][2], B4[3][3]);
    const bf16x8 P0 = __builtin_bit_cast(bf16x8, p0), P1 = __builtin_bit_cast(bf16x8, p1);
    O0 = MFMA32(Vc[0], P0, O0); O0 = MFMA32(Vc[1], P1, O0);
    O1 = MFMA32(Vc[2], P0, O1); O1 = MFMA32(Vc[3], P1, O1);
}
__device__ __forceinline__ void m_sb(Frame& F) {
    const bf16* qs = (const bf16*)(F.R + R_QS); const bf16* ks = (const bf16*)(F.R + R_KS); const bf16* vst = (const bf16*)(F.R + R_VST); float* osb = (float*)(F.R + R_OSB);
    const int lane = F.lane, r = lane & 31, h = lane >> 5;
    for (int unit = F.vcu; unit < 256; unit += F.G) {
        const int b = unit >> 6, p = (unit >> 1) & 31, head = (unit & 1) * 4 + (F.wave & 3);
#pragma unroll 1
        for (int pass = 0; pass < 1; ++pass) {
            const int qt = (F.wave >> 2) ? 63 - p : p;
            bf16x8 Qf[4];
            { const bf16* qrow = qs + (size_t)(b * T + 32 * qt + r) * 512 + head * 64 + 8 * h;
#pragma unroll
              for (int s = 0; s < 4; ++s) Qf[s] = *(const bf16x8*)(qrow + 16 * s); }
            const bf16* kbase = ks + (size_t)(b * 8 + head) * (T * 64) + lane * 8;
            const bf16* vbase = vst + (size_t)(b * 8 + head) * (T * 64) + lane * 8;
            f32x16 O0, O1;
#pragma unroll
            for (int i = 0; i < 16; ++i) { O0[i] = 0.f; O1[i] = 0.f; }
            float Rc = 1.f;
#define SB_LOAD(Kx, Vx, kbx) do { _Pragma("unroll") for (int s = 0; s < 4; ++s) { Kx[s] = *(const bf16x8*)(kbase + (size_t)((kbx) * 4 + s) * 512); Vx[s] = *(const bf16x8*)(vbase + (size_t)((kbx) * 4 + s) * 512); } } while (0)
            bf16x8 Kc[4], Vc[4], Kn[4], Vn[4];
            SB_LOAD(Kn, Vn, qt);
            SB_LOAD(Kc, Vc, (qt > 0 ? qt - 1 : 0));
            sb_block<true>(O0, O1, Rc, Kn, Vn, Qf, r, h);
            int kb = qt - 1;
#pragma unroll 1
            for (; kb >= 1; kb -= 2) {
                if (__all(Rc == 0.f)) { kb = -1; break; }
                SB_LOAD(Kn, Vn, kb - 1);
                sb_block<false>(O0, O1, Rc, Kc, Vc, Qf, r, h);
                SB_LOAD(Kc, Vc, (kb >= 2 ? kb - 2 : 0));
                sb_block<false>(O0, O1, Rc, Kn, Vn, Qf, r, h);
            }
            if (kb == 0) sb_block<false>(O0, O1, Rc, Kc, Vc, Qf, r, h);
#undef SB_LOAD
            float* orow = osb + (size_t)(b * T + 32 * qt + r) * 512 + head * 64 + 4 * h;
#pragma unroll
            for (int k = 0; k < 4; ++k) { *(f32x4*)(orow + 8 * k) = (f32x4){O0[4 * k], O0[4 * k + 1], O0[4 * k + 2], O0[4 * k + 3]};
                                          *(f32x4*)(orow + 32 + 8 * k) = (f32x4){O1[4 * k], O1[4 * k + 1], O1[4 * k + 2], O1[4 * k + 3]}; }
        }
    }
}
template <int MODE>
__device__ __forceinline__ void nsa_block(f32x16& O0, f32x16& O1, float& mrun, float& lrun, const bf16x8 (&Kc)[4], const bf16x8 (&Vc)[4], const bf16x8 (&Qf)[4], const LAS float* tabl, float tab128,
                                          int qt, int kb, unsigned msk, int r, int h) {
    f32x16 S;
#pragma unroll
    for (int i = 0; i < 16; ++i) S[i] = 0.f;
#pragma unroll
    for (int s = 0; s < 4; ++s) S = MFMA32(Kc[s], Qf[s], S);
    const int dq = qt - kb;
    const bool bit = MODE == 0 ? ((msk >> (kb >> 1)) & 1u) != 0u : true;
    const bool fast = MODE == 0 ? dq >= 5 : (dq >= 5 && dq <= 15);
    float bm;
    if (fast) {
        const float boff = bit ? tab128 : -3.0e38f;
        S = S + boff;
        bm = fmaxf(fmaxf(fmaxf(S[0], S[1]), fmaxf(S[2], S[3])), fmaxf(fmaxf(S[4], S[5]), fmaxf(S[6], S[7])));
        bm = fmaxf(bm, fmaxf(fmaxf(fmaxf(S[8], S[9]), fmaxf(S[10], S[11])), fmaxf(fmaxf(S[12], S[13]), fmaxf(S[14], S[15]))));
    } else {
        int d0 = 32 * dq + r - 4 * h;
        asm volatile("" : "+v"(d0));
        bm = -3.0e38f;
#pragma unroll
        for (int i = 0; i < 16; ++i) {
            const int dist = d0 - ((i & 3) + 8 * (i >> 2));
            const bool valid = bit && dist >= 0 && (MODE == 0 || dist < 512);
            const float sv = valid ? S[i] + tabl[dist < 0 ? 0 : (dist > 128 ? 128 : dist)] : -3.0e38f;
            S[i] = sv; bm = fmaxf(bm, sv);
        }
    }
    bm = fmaxf(bm, __shfl_xor(bm, 32));
    const float mnew = fmaxf(mrun, bm);
    if (__any(mnew != mrun)) {
        const float alpha = fexp2(mrun - mnew);
        lrun *= alpha; O0 = O0 * alpha; O1 = O1 * alpha; mrun = mnew;
    }
    if (fast) {
        S = S - mrun;
#pragma unroll
        for (int i = 0; i < 16; ++i) S[i] = fexp2(S[i]);
    } else {
#pragma unroll
        for (int i = 0; i < 16; ++i) S[i] = S[i] > -1.0e38f ? fexp2(S[i] - mrun) : 0.f;
    }
    lrun += ((S[0] + S[1]) + (S[2] + S[3])) + ((S[4] + S[5]) + (S[6] + S[7])) + ((S[8] + S[9]) + (S[10] + S[11])) + ((S[12] + S[13]) + (S[14] + S[15]));
    const bf16x8 P0 = acc_frag(S, 0), P1 = acc_frag(S, 1);
    O0 = MFMA32(Vc[0], P0, O0); O0 = MFMA32(Vc[1], P1, O0);
    O1 = MFMA32(Vc[2], P0, O1); O1 = MFMA32(Vc[3], P1, O1);
}
template <int MODE>
__device__ __forceinline__ void nsa_pass(f32x16& Ot0, f32x16& Ot1, const bf16x8 (&Qf)[4], const bf16* kbase, const bf16* vbase, const LAS float* tabl, int qt, int kb_lo, unsigned msk, float gate, int r, int h) {
    f32x16 O0, O1;
#pragma unroll
    for (int i = 0; i < 16; ++i) { O0[i] = 0.f; O1[i] = 0.f; }
    float mrun = -3.0e38f, lrun = 0.f;
    const float tab128 = tabl[128];
#define NSA_LD(X, base, kbx) do { _Pragma("unroll") for (int s = 0; s < 4; ++s) X[s] = *(const bf16x8*)((base) + (size_t)((kbx) * 4 + s) * 512); } while (0)
    bf16x8 Kc[4], Kn[4], Vc[4];
    NSA_LD(Kc, kbase, kb_lo);
    int kb = kb_lo;
#pragma unroll 1
    for (; kb + 1 <= qt; kb += 2) {
        NSA_LD(Vc, vbase, kb); NSA_LD(Kn, kbase, kb + 1);
        nsa_block<MODE>(O0, O1, mrun, lrun, Kc, Vc, Qf, tabl, tab128, qt, kb, msk, r, h);
        NSA_LD(Vc, vbase, kb + 1); NSA_LD(Kc, kbase, (kb + 2 <= qt ? kb + 2 : qt));
        nsa_block<MODE>(O0, O1, mrun, lrun, Kn, Vc, Qf, tabl, tab128, qt, kb + 1, msk, r, h);
    }
    if (kb == qt) { NSA_LD(Vc, vbase, kb); nsa_block<MODE>(O0, O1, mrun, lrun, Kc, Vc, Qf, tabl, tab128, qt, kb, msk, r, h); }
#undef NSA_LD
    lrun += __shfl_xor(lrun, 32);
    const float sc = gate / lrun;
    Ot0 = Ot0 + O0 * sc; Ot1 = Ot1 + O1 * sc;
}
__device__ __forceinline__ void m_nsa(Frame& F) {
    const bf16* qn = (const bf16*)(F.R + R_QN); const bf16* kn = (const bf16*)(F.R + R_KN); const bf16* vnt = (const bf16*)(F.R + R_VNT);
    const bf16* kc = (const bf16*)(F.R + R_KCMP); const bf16* vct = (const bf16*)(F.R + R_VCMPT); const float* dtg = (const float*)(F.R + R_DTG);
    float* onsa = (float*)(F.R + R_ONSA);
    LAS unsigned char* const l3 = (LAS unsigned char*)F.lds;
    LAS float* PS = (LAS float*)l3;
    LAS unsigned* SEL = (LAS unsigned*)(l3 + 32768);
    LAS float* TAB = (LAS float*)(l3 + 33024);
    LAS float* PINV = (LAS float*)(l3 + 37376);
    volatile LAS unsigned* HB = (volatile LAS unsigned*)(l3 + 38400);
    unsigned hb_target = 0u;
#define HALF_BARRIER() do { asm volatile("s_waitcnt vmcnt(0) lgkmcnt(0)" ::: "memory"); hb_target += 4u; if (lane == 0) __hip_atomic_fetch_add((LAS unsigned*)(HB + 16 * half), 1u, __ATOMIC_RELAXED, __HIP_MEMORY_SCOPE_WORKGROUP); \
        while ((unsigned)__builtin_amdgcn_readfirstlane((int)HB[16 * half]) < hb_target) __builtin_amdgcn_s_sleep(1); asm volatile("" ::: "memory"); } while (0)
    const int lane = F.lane, r = lane & 31, h = lane >> 5, g = F.wave & 3, half = F.wave >> 2;
    { const float* tab = (const float*)(F.ws + WS_TAB); for (int i = F.tid; i < 8 * 129; i += NTHR) TAB[i] = tab[i]; }
    __syncthreads();
    if (F.tid < 32) HB[F.tid] = 0u;
    __syncthreads();
    for (int unit = F.vcu; unit < 256; unit += F.G) {
        const int b = unit >> 6, p = (unit >> 1) & 31, hk = unit & 1, head = hk * 4 + g;
        const LAS float* tabl = TAB + head * 129;
#pragma unroll 1
        for (int pass = 0; pass < 1; ++pass) {
            const int qt = half ? 63 - p : p;
            int ln = lane; asm volatile("" : "+v"(ln));
            const int t = 32 * qt + r, row = b * T + 32 * qt + (ln & 31);
            bf16x8 Qf[4];
            { const bf16* qrow = qn + (size_t)row * 512 + head * 64 + 8 * (ln >> 5);
#pragma unroll
              for (int s = 0; s < 4; ++s) Qf[s] = *(const bf16x8*)(qrow + 16 * s); }
            const float* gl = dtg + (size_t)row * 64 + 16 + head * 3;
            const float g0 = sigmoid_f(gl[0]), g1 = sigmoid_f(gl[1]), g2 = sigmoid_f(gl[2]);
            f32x16 Ot0, Ot1;
            {
                const bf16* kcb = kc + (size_t)(b * 2 + hk) * (128 * 64) + ln * 8;
                float mx = -3.0e38f;
                const int ncb = (qt >> 4) + 1 < 4 ? (qt >> 4) + 1 : 4;
#pragma unroll 1
                for (int cb = 0; cb < ncb; ++cb) {
                    f32x16 S;
#pragma unroll
                    for (int i = 0; i < 16; ++i) S[i] = 0.f;
#pragma unroll
                    for (int s = 0; s < 4; ++s) S = MFMA32(*(const bf16x8*)(kcb + (size_t)(cb * 4 + s) * 512), Qf[s], S);
#pragma unroll
                    for (int i = 0; i < 16; ++i) {
                        const int c = 32 * cb + (i & 3) + 8 * (i >> 2) + 4 * h, dist = t - (16 * c + 31);
                        const bool valid = dist >= 0 && c < 127;
                        const float sv = valid ? S[i] + tabl[dist < 0 ? 0 : (dist > 128 ? 128 : dist)] : -3.0e38f;
                        mx = fmaxf(mx, sv);
                    }
                }
                mx = fmaxf(mx, __shfl_xor(mx, 32));
                const bf16* vcb = vct + (size_t)(b * 2 + hk) * (128 * 64) + ln * 8;
                f32x16 O0, O1;
#pragma unroll
                for (int i = 0; i < 16; ++i) { O0[i] = 0.f; O1[i] = 0.f; }
                float sum = 0.f, carry = 0.f;
                LAS float* psw = PS + ((half * 4 + g) * 32) * 32 + r;
#pragma unroll 1
                for (int cb = 0; cb < 4; ++cb) {
                    f32x16 S;
#pragma unroll
                    for (int i = 0; i < 16; ++i) S[i] = 0.f;
#pragma unroll
                    for (int s = 0; s < 4; ++s) S = MFMA32(*(const bf16x8*)(kcb + (size_t)(cb * 4 + s) * 512), Qf[s], S);
#pragma unroll
                    for (int i = 0; i < 16; ++i) {
                        const int c = 32 * cb + (i & 3) + 8 * (i >> 2) + 4 * h, dist = t - (16 * c + 31);
                        const bool valid = dist >= 0 && c < 127;
                        const float pv = valid ? fexp2(S[i] + tabl[dist < 0 ? 0 : (dist > 128 ? 128 : dist)] - mx) : 0.f;
                        S[i] = pv; sum += pv;
                    }
                    float pco[4];
#pragma unroll
                    for (int k = 0; k < 4; ++k) pco[k] = __shfl_xor(0.5f * S[4 * k + 3], 32);
#pragma unroll
                    for (int k = 0; k < 4; ++k) {
                        const float own = S[4 * k] + S[4 * k + 1] + S[4 * k + 2] + 0.5f * S[4 * k + 3];
                        const float cin = h ? pco[k] : (k > 0 ? pco[k > 0 ? k - 1 : 0] : carry);
                        psw[(8 * cb + 2 * k + h) * 32] = own + cin;
                    }
                    carry = pco[3];
#pragma unroll
                    for (int s = 0; s < 2; ++s) {
                        const bf16x8 Pf = acc_frag(S, s);
                        O0 = MFMA32(*(const bf16x8*)(vcb + (size_t)((cb * 2 + 0) * 2 + s) * 512), Pf, O0);
                        O1 = MFMA32(*(const bf16x8*)(vcb + (size_t)((cb * 2 + 1) * 2 + s) * 512), Pf, O1);
                    }
                }
                sum += __shfl_xor(sum, 32);
                const float inv = sum > 0.f ? 1.0f / sum : 0.f;
                if (h == 0) PINV[(half * 4 + g) * 32 + r] = inv;
                const float gi = g0 * inv;
#pragma unroll
                for (int i = 0; i < 16; ++i) { Ot0[i] = gi * O0[i]; Ot1[i] = gi * O1[i]; }
            }
            HALF_BARRIER();
            {
                const int tt = 8 * g + (ln >> 3), s8 = ln & 7, tq = 32 * qt + tt, cur = tq >> 6;
                const float iv0 = PINV[(half * 4 + 0) * 32 + tt], iv1 = PINV[(half * 4 + 1) * 32 + tt], iv2 = PINV[(half * 4 + 2) * 32 + tt], iv3 = PINV[(half * 4 + 3) * 32 + tt];
                float sc[4];
#pragma unroll
                for (int i = 0; i < 4; ++i) {
                    const int j = s8 + 8 * i;
                    const LAS float* pp = PS + ((half * 4) * 32 + j) * 32 + tt;
                    const float v = (pp[0] * iv0 + pp[1024] * iv1) + (pp[2048] * iv2 + pp[3072] * iv3);
                    sc[i] = (64 * j <= tq) ? v + ((j == 0 || j == cur || j == cur - 1) ? 1000.f : 0.f) : -3.0e38f;
                }
                unsigned mk = 0u;
#pragma unroll 1
                for (int it = 0; it < 8; ++it) {
                    float bv = sc[0]; int bj = s8;
#pragma unroll
                    for (int i = 1; i < 4; ++i) if (sc[i] > bv) { bv = sc[i]; bj = s8 + 8 * i; }
#pragma unroll
                    for (int off = 1; off < 8; off <<= 1) { const float ov = __shfl_xor(bv, off); const int oj = __shfl_xor(bj, off); if (ov > bv || (ov == bv && oj < bj)) { bv = ov; bj = oj; } }
                    if (bv > -1.0e38f) mk |= 1u << bj;
                    const bool mine = (bj & 7) == s8;
#pragma unroll
                    for (int i = 0; i < 4; ++i) sc[i] = (mine && (bj >> 3) == i) ? -3.0e38f : sc[i];
                }
                if (s8 == 0) SEL[half * 32 + tt] = mk;
            }
            HALF_BARRIER();
            const unsigned msk = SEL[half * 32 + r];
            nsa_pass<0>(Ot0, Ot1, Qf, kn + (size_t)(b * 4 + hk) * (T * 64) + ln * 8, vnt + (size_t)(b * 4 + hk) * (T * 64) + ln * 8, tabl, qt, 0, msk, g1, r, h);
            nsa_pass<1>(Ot0, Ot1, Qf, kn + (size_t)(b * 4 + 2 + hk) * (T * 64) + ln * 8, vnt + (size_t)(b * 4 + 2 + hk) * (T * 64) + ln * 8, tabl, qt, qt > 16 ? qt - 16 : 0, 0u, g2, r, h);
            float* orow = onsa + (size_t)row * 512 + head * 64 + 4 * (ln >> 5);
#pragma unroll
            for (int k = 0; k < 4; ++k) { *(f32x4*)(orow + 8 * k) = (f32x4){Ot0[4 * k], Ot0[4 * k + 1], Ot0[4 * k + 2], Ot0[4 * k + 3]};
                                          *(f32x4*)(orow + 32 + 8 * k) = (f32x4){Ot1[4 * k], Ot1[4 * k + 1], Ot1[4 * k + 2], Ot1[4 * k + 3]}; }
            HALF_BARRIER();
        }
    }
}
#undef HALF_BARRIER
__device__ __forceinline__ void m_compress(Frame& F, int layer) {
    const bf16* raw = (const bf16*)(F.R + R_CMPRAW); bf16* kc = (bf16*)(F.R + R_KCMP); bf16* vct = (bf16*)(F.R + R_VCMPT);
    LAS float* RED = (LAS float*)(LAS unsigned char*)F.lds;
    const int lane = F.lane, w = F.wave;
    for (int item = F.vcu; item < 128; item += F.G) {
        const int dt = item & 1, rest = item >> 1, ct = rest & 3, hk = (rest >> 2) & 1, b = (rest >> 3) & 3, kind = rest >> 5, mat = layer * 2 + kind;
        const bf16* ap = raw + ((size_t)(((kind * 2 + hk) * 4 + b) * 4 + ct) * 128 + 16 * w) * 512 + lane * 8;
        const bf16* bp = (const bf16*)(F.ws + WS_CW) + (size_t)mat * (64 * 2048) + (size_t)(128 * dt + 16 * w) * 512 + lane * 8;
        const float* pb = (const float*)(F.ws + WS_TAB + TAB_PB) + mat * 16 * 64 + 32 * dt + (lane & 31);
        float pbv = 0.f;
#pragma unroll
        for (int sl = 0; sl < 16; ++sl) pbv += pb[sl * 64];
        f32x16 a0;
        for (int rep_a = 0; rep_a < REP_CMPA; ++rep_a) {
#pragma unroll
        for (int i = 0; i < 16; ++i) a0[i] = 0.f;
#pragma unroll
        for (int s = 0; s < 16; ++s) a0 = MFMA32(*(const bf16x8*)(ap + (size_t)s * 512), *(const bf16x8*)(bp + (size_t)s * 512), a0);
        }
        for (int rep_b = 0; rep_b < REP_CMPB; ++rep_b) {
#pragma unroll
        for (int i = 0; i < 16; ++i) RED[(w * 16 + i) * 64 + lane] = a0[i];
        __syncthreads();
#pragma unroll
        for (int q = 0; q < 2; ++q) {
            const int o = F.tid + NTHR * q, ln = o & 63, i = (o >> 6) & 15;
            float sum = 0.f;
#pragma unroll
            for (int ww = 0; ww < 8; ++ww) sum += RED[(ww * 16 + i) * 64 + ln];
            const int c = 32 * ct + (i & 3) + 8 * (i >> 2) + 4 * (ln >> 5), dd = 32 * dt + (ln & 31);
            const float val = c < 127 ? sum + pbv : 0.f;
            if (kind == 0) kc[(size_t)(b * 2 + hk) * (128 * 64) + kfrag_off(c, dd & ~7) + (dd & 7)] = (bf16)f2bf(val);
            else vct[(size_t)(b * 2 + hk) * (128 * 64) + vfrag_off(c, dd)] = (bf16)f2bf(val);
        }
        __syncthreads();
        }
    }
}
constexpr int SL = 64, SNC = T / SL;
__device__ __forceinline__ void m_ssd_s1(Frame& F, int layer, const float* conv_w, const float* conv_b, const float* dt_bias, const float* a_log) {
    const bf16* xbc = (const bf16*)(F.R + R_XBC); const float* dtg = (const float*)(F.R + R_DTG);
    bf16* xt = (bf16*)(F.R + R_XT); bf16* bm = (bf16*)(F.R + R_BM); bf16* cm = (bf16*)(F.R + R_CM); float* dtb = (float*)(F.R + R_DT); float* acsb = (float*)(F.R + R_ACS); float* aend = (float*)(F.R + R_AEND);
    bf16* st = (bf16*)(F.R + R_ST);
    const float* cw = conv_w + (size_t)layer * 4 * 1536; const float* cb = conv_b + (size_t)layer * 1536;
    LAS unsigned char* const l3 = (LAS unsigned char*)F.lds;
    LAS bf16* XTL = (LAS bf16*)l3;
    LAS bf16* BMTL = (LAS bf16*)(l3 + 73728);
    LAS float* SCL = (LAS float*)(l3 + 92160);
    const int lane = F.lane, r = lane & 31, h = lane >> 5, e = F.wave;
    for (int item = F.vcu; item < BATCH * SNC * 2; item += F.G) {
        const int g = item & 1, c = (item >> 1) & (SNC - 1), b = item >> 6, t0 = c * SL;
        for (int rep_a = 0; rep_a < REP_S1A; ++rep_a)
#pragma unroll 1
        for (int id = F.tid; id < 96 * 16; id += NTHR) {
            const int c8 = id % 96, q = id / 96;
            const int col = c8 < 64 ? 512 * g + 8 * c8 : (c8 < 80 ? 1024 + 128 * g + 8 * (c8 - 64) : 1280 + 128 * g + 8 * (c8 - 80));
            float u[7][8];
#pragma unroll
            for (int i = 0; i < 7; ++i) {
                const int tt = t0 + 4 * q - 3 + i;
                v4u w = (v4u){0u, 0u, 0u, 0u};
                if (tt >= 0) w = *(const v4u*)(xbc + ((size_t)b * T + tt) * 1536 + col);
                u[i][0] = __uint_as_float(w.x << 16); u[i][1] = __uint_as_float(w.x & 0xffff0000u); u[i][2] = __uint_as_float(w.y << 16); u[i][3] = __uint_as_float(w.y & 0xffff0000u);
                u[i][4] = __uint_as_float(w.z << 16); u[i][5] = __uint_as_float(w.z & 0xffff0000u); u[i][6] = __uint_as_float(w.w << 16); u[i][7] = __uint_as_float(w.w & 0xffff0000u);
            }
            float wk[4][8], bias[8];
#pragma unroll
            for (int k = 0; k < 4; ++k) { const f32x4 a0 = *(const f32x4*)(cw + k * 1536 + col), a1 = *(const f32x4*)(cw + k * 1536 + col + 4);
                wk[k][0] = a0[0]; wk[k][1] = a0[1]; wk[k][2] = a0[2]; wk[k][3] = a0[3]; wk[k][4] = a1[0]; wk[k][5] = a1[1]; wk[k][6] = a1[2]; wk[k][7] = a1[3]; }
            { const f32x4 a0 = *(const f32x4*)(cb + col), a1 = *(const f32x4*)(cb + col + 4);
              bias[0] = a0[0]; bias[1] = a0[1]; bias[2] = a0[2]; bias[3] = a0[3]; bias[4] = a1[0]; bias[5] = a1[1]; bias[6] = a1[2]; bias[7] = a1[3]; }
            float y[4][8];
#pragma unroll
            for (int j = 0; j < 4; ++j)
#pragma unroll
                for (int i = 0; i < 8; ++i) y[j][i] = silu_f(bias[i] + wk[0][i] * u[j][i] + wk[1][i] * u[j + 1][i] + wk[2][i] * u[j + 2][i] + wk[3][i] * u[j + 3][i]);
            if (c8 < 64) {
                const int he = c8 >> 3, p0 = 8 * (c8 & 7);
#pragma unroll
                for (int i = 0; i < 8; ++i) { v2u pk; pk.x = pk2(y[0][i], y[1][i]); pk.y = pk2(y[2][i], y[3][i]);
                    *(LAS v2u*)(XTL + (he * 64 + p0 + i) * 72 + 4 * q) = pk;
                    *(v2u*)(xt + ((size_t)(b * 16 + 8 * g + he) * 64 + p0 + i) * T + t0 + 4 * q) = pk; }
            } else {
                const int n0 = 8 * (c8 < 80 ? c8 - 64 : c8 - 80);
                if (c8 < 80) {
#pragma unroll
                    for (int i = 0; i < 8; ++i) { v2u pk; pk.x = pk2(y[0][i], y[1][i]); pk.y = pk2(y[2][i], y[3][i]); *(LAS v2u*)(BMTL + (n0 + i) * 72 + 4 * q) = pk; }
                }
                bf16* dst = (c8 < 80 ? bm : cm) + ((size_t)((((b * 2 + g) * SNC + c) * 2 + (q >> 3)) * 8 + (n0 >> 4)) * 64 + 32 * ((n0 >> 3) & 1) + 4 * (q & 7)) * 8;
#pragma unroll
                for (int j = 0; j < 4; ++j) { v4u pk; pk.x = pk2(y[j][0], y[j][1]); pk.y = pk2(y[j][2], y[j][3]); pk.z = pk2(y[j][4], y[j][5]); pk.w = pk2(y[j][6], y[j][7]); *(v4u*)(dst + 8 * j) = pk; }
            }
        }
        for (int rep_b = 0; rep_b < REP_S1B; ++rep_b) {
            const int hd = 8 * g + e;
            const float v = dtg[((size_t)b * T + t0 + lane) * 64 + hd] + dt_bias[layer * 16 + hd];
            const float dtv = v > 20.f ? v : log1pf(expf(v));
            const float a = -expf(a_log[layer * 16 + hd]);
            float cs = dtv * a;
#pragma unroll
            for (int off = 1; off < 64; off <<= 1) { const float up = __shfl_up(cs, off); if (lane >= off) cs += up; }
            const float cend = __shfl(cs, 63);
            dtb[(size_t)(b * 16 + hd) * T + t0 + lane] = dtv; acsb[(size_t)(b * 16 + hd) * T + t0 + lane] = cs;
            if (lane == 0) aend[(size_t)(b * 16 + hd) * SNC + c] = cend;
            SCL[e * 64 + lane] = dtv * fexp2((cend - cs) * LOG2E);
        }
        __syncthreads();
        for (int rep_c = 0; rep_c < REP_S1C; ++rep_c)
#pragma unroll 1
        for (int nh = 0; nh < 2; ++nh) {
            f32x16 acc[2][2];
#pragma unroll
            for (int a = 0; a < 2; ++a)
#pragma unroll
                for (int q = 0; q < 2; ++q)
#pragma unroll
                    for (int i = 0; i < 16; ++i) acc[a][q][i] = 0.f;
#pragma unroll
            for (int s = 0; s < 4; ++s) {
                bf16x8 Af[2], Bf[2];
#pragma unroll
                for (int pt = 0; pt < 2; ++pt) Af[pt] = *(const LAS bf16x8*)(XTL + (e * 64 + 32 * pt + r) * 72 + 16 * s + 8 * h);
                const f32x4 sc0 = *(const LAS f32x4*)(SCL + e * 64 + 16 * s + 8 * h), sc1 = *(const LAS f32x4*)(SCL + e * 64 + 16 * s + 8 * h + 4);
#pragma unroll
                for (int nt = 0; nt < 2; ++nt) {
                    const v4u raw = *(const LAS v4u*)(BMTL + (64 * nh + 32 * nt + r) * 72 + 16 * s + 8 * h);
                    v4u w;
                    w.x = cvtpk(__uint_as_float(raw.x << 16) * sc0[0], __uint_as_float(raw.x & 0xffff0000u) * sc0[1]);
                    w.y = cvtpk(__uint_as_float(raw.y << 16) * sc0[2], __uint_as_float(raw.y & 0xffff0000u) * sc0[3]);
                    w.z = cvtpk(__uint_as_float(raw.z << 16) * sc1[0], __uint_as_float(raw.z & 0xffff0000u) * sc1[1]);
                    w.w = cvtpk(__uint_as_float(raw.w << 16) * sc1[2], __uint_as_float(raw.w & 0xffff0000u) * sc1[3]);
                    Bf[nt] = __builtin_bit_cast(bf16x8, w);
                }
#pragma unroll
                for (int pt = 0; pt < 2; ++pt)
#pragma unroll
                    for (int nt = 0; nt < 2; ++nt) acc[pt][nt] = MFMA32(Af[pt], Bf[nt], acc[pt][nt]);
            }
            bf16* sp = st + ((size_t)((b * SNC + c) * 16 + 8 * g + e) * 64) * 128 + 64 * nh + r;
#pragma unroll
            for (int pt = 0; pt < 2; ++pt)
#pragma unroll
                for (int nt = 0; nt < 2; ++nt)
#pragma unroll
                    for (int i = 0; i < 16; ++i) sp[(size_t)(32 * pt + (i & 3) + 8 * (i >> 2) + 4 * h) * 128 + 32 * nt] = (bf16)f2bf(acc[pt][nt][i]);
        }
        __syncthreads();
    }
}
__device__ __forceinline__ void m_ssd_s2(Frame& F) {
    const bf16* st = (const bf16*)(F.R + R_ST); const float* aend = (const float*)(F.R + R_AEND); bf16* hin = (bf16*)(F.R + R_HIN);
    for (int gid = F.vcu * NTHR + F.tid; gid < BATCH * 16 * 64 * 32; gid += F.G * NTHR) {
        const int n4 = gid & 31, p = (gid >> 5) & 63, hd = (gid >> 11) & 15, b = gid >> 15;
        f32x4 hv = (f32x4){0.f, 0.f, 0.f, 0.f};
        const size_t cstride = (size_t)16 * 64 * 128;
        size_t off = ((size_t)(b * SNC * 16 + hd) * 64 + p) * 128 + 4 * n4;
        size_t hoff = (size_t)(b * SNC * 16 + hd) * (64 * 128) + ((size_t)((p >> 5) * 8 + (n4 >> 2)) * 64 + 32 * ((n4 >> 1) & 1) + (p & 31)) * 8 + 4 * (n4 & 1);
#pragma unroll
        for (int c = 0; c < SNC; ++c) {
            v2u w; w.x = pk2(hv[0], hv[1]); w.y = pk2(hv[2], hv[3]);
            *(v2u*)(hin + hoff) = w; hoff += cstride;
            const float dec = fexp2(aend[(size_t)(b * 16 + hd) * SNC + c] * LOG2E);
            const v2u sw = *(const v2u*)(st + off);
            const f32x4 sv = (f32x4){__uint_as_float(sw.x << 16), __uint_as_float(sw.x & 0xffff0000u), __uint_as_float(sw.y << 16), __uint_as_float(sw.y & 0xffff0000u)};
            hv = hv * dec + sv; off += cstride;
        }
    }
}
__device__ __forceinline__ void m_ssd_s3(Frame& F, int layer, const float* d_skip) {
    const bf16* xt = (const bf16*)(F.R + R_XT); const bf16* bm = (const bf16*)(F.R + R_BM); const bf16* cm = (const bf16*)(F.R + R_CM); const float* dtb = (const float*)(F.R + R_DT); const float* acsb = (const float*)(F.R + R_ACS);
    const bf16* hin = (const bf16*)(F.R + R_HIN); const bf16* zb = (const bf16*)(F.R + R_Z); bf16* mixed = (bf16*)(F.R + R_MIXED);
    LAS unsigned char* const l3 = (LAS unsigned char*)F.lds;
    LAS float* DTL = (LAS float*)l3;
    LAS float* ACL = (LAS float*)(l3 + 2048);
    LAS float* SSQ = (LAS float*)(l3 + 4096);
    const int lane = F.lane, r = lane & 31, h = lane >> 5, e = F.wave;
    for (int item = F.vcu; item < BATCH * SNC * 2; item += F.G) {
        const int g = item & 1, c = (item >> 1) & (SNC - 1), b = item >> 6, t0 = c * SL, hd = 8 * g + e;
        DTL[e * 64 + lane] = dtb[(size_t)(b * 16 + hd) * T + t0 + lane];
        ACL[e * 64 + lane] = acsb[(size_t)(b * 16 + hd) * T + t0 + lane];
        f32x16 cbt[3], yo[2][2];
#pragma unroll
        for (int i = 0; i < 16; ++i) { cbt[0][i] = 0.f; cbt[1][i] = 0.f; cbt[2][i] = 0.f; yo[0][0][i] = 0.f; yo[0][1][i] = 0.f; yo[1][0][i] = 0.f; yo[1][1][i] = 0.f; }
        const bf16* bmp = bm + (size_t)((b * 2 + g) * SNC + c) * (64 * 128) + lane * 8;
        const bf16* cmp_ = cm + (size_t)((b * 2 + g) * SNC + c) * (64 * 128) + lane * 8;
        const bf16* hp = hin + (size_t)((b * SNC + c) * 16 + hd) * (64 * 128) + lane * 8;
#pragma unroll 2
        for (int k = 0; k < 8; ++k) {
            const bf16x8 b0 = *(const bf16x8*)(bmp + (size_t)k * 512), b1 = *(const bf16x8*)(bmp + (size_t)(8 + k) * 512);
            const bf16x8 c0 = *(const bf16x8*)(cmp_ + (size_t)k * 512), c1 = *(const bf16x8*)(cmp_ + (size_t)(8 + k) * 512);
            const bf16x8 h0 = *(const bf16x8*)(hp + (size_t)k * 512), h1 = *(const bf16x8*)(hp + (size_t)(8 + k) * 512);
            cbt[0] = MFMA32(b0, c0, cbt[0]); cbt[1] = MFMA32(b0, c1, cbt[1]); cbt[2] = MFMA32(b1, c1, cbt[2]);
            yo[0][0] = MFMA32(h0, c0, yo[0][0]); yo[0][1] = MFMA32(h0, c1, yo[0][1]); yo[1][0] = MFMA32(h1, c0, yo[1][0]); yo[1][1] = MFMA32(h1, c1, yo[1][1]);
        }
        __builtin_amdgcn_wave_barrier(); LDS_WAIT();
        const float Dk = d_skip[layer * 16 + hd];
        const float acl0 = ACL[e * 64 + r], acl1 = ACL[e * 64 + 32 + r];
        { const float e0 = fexp2(acl0 * LOG2E), e1 = fexp2(acl1 * LOG2E);
#pragma unroll
          for (int i = 0; i < 16; ++i) { yo[0][0][i] *= e0; yo[1][0][i] *= e0; yo[0][1][i] *= e1; yo[1][1][i] *= e1; } }
#pragma unroll
        for (int tl = 0; tl < 3; ++tl) {
            const int stl = tl == 2 ? 1 : 0, ltl = tl == 0 ? 0 : 1;
            const float al = ltl ? acl1 : acl0;
#pragma unroll
            for (int i = 0; i < 16; ++i) {
                const int sidx = 32 * stl + (i & 3) + 8 * (i >> 2) + 4 * h, lidx = 32 * ltl + r;
                const float as = ACL[e * 64 + sidx], ds = DTL[e * 64 + sidx];
                float v = sidx <= lidx ? cbt[tl][i] * fexp2((al - as) * LOG2E) * ds : 0.f;
                if (sidx == lidx) v += Dk;
                cbt[tl][i] = v;
            }
        }
        const bf16* xp = xt + ((size_t)(b * 16 + hd) * 64 + r) * T + t0 + 4 * h;
#pragma unroll
        for (int pt = 0; pt < 2; ++pt) {
            const bf16* xq = xp + (size_t)(32 * pt) * T;
#pragma unroll
            for (int k2 = 0; k2 < 2; ++k2) {
                const bf16x8 a0 = mk_frag(*(const v2u*)(xq + 16 * k2), *(const v2u*)(xq + 16 * k2 + 8));
                const bf16x8 a1 = mk_frag(*(const v2u*)(xq + 32 + 16 * k2), *(const v2u*)(xq + 32 + 16 * k2 + 8));
                yo[pt][0] = MFMA32(a0, acc_frag(cbt[0], k2), yo[pt][0]);
                yo[pt][1] = MFMA32(a0, acc_frag(cbt[1], k2), yo[pt][1]);
                yo[pt][1] = MFMA32(a1, acc_frag(cbt[2], k2), yo[pt][1]);
            }
        }
        float ssq[2] = {0.f, 0.f};
#pragma unroll
        for (int lt = 0; lt < 2; ++lt) {
            const bf16* zp = zb + ((size_t)b * T + t0 + 32 * lt + r) * 1024 + hd * 64 + 4 * h;
#pragma unroll
            for (int pt = 0; pt < 2; ++pt)
#pragma unroll
                for (int k = 0; k < 4; ++k) {
                    const v2u zz = *(const v2u*)(zp + 32 * pt + 8 * k);
                    const float z0 = __uint_as_float(zz.x << 16), z1 = __uint_as_float(zz.x & 0xffff0000u), z2 = __uint_as_float(zz.y << 16), z3 = __uint_as_float(zz.y & 0xffff0000u);
                    float v0 = yo[pt][lt][4 * k] * silu_f(z0), v1 = yo[pt][lt][4 * k + 1] * silu_f(z1), v2 = yo[pt][lt][4 * k + 2] * silu_f(z2), v3 = yo[pt][lt][4 * k + 3] * silu_f(z3);
                    yo[pt][lt][4 * k] = v0; yo[pt][lt][4 * k + 1] = v1; yo[pt][lt][4 * k + 2] = v2; yo[pt][lt][4 * k + 3] = v3;
                    ssq[lt] += (v0 * v0 + v1 * v1) + (v2 * v2 + v3 * v3);
                }
            ssq[lt] += __shfl_xor(ssq[lt], 32);
        }
        if (h == 0) { SSQ[e * 64 + r] = ssq[0]; SSQ[e * 64 + 32 + r] = ssq[1]; }
        __syncthreads();
#pragma unroll
        for (int lt = 0; lt < 2; ++lt) {
            float tot = 0.f;
#pragma unroll
            for (int w = 0; w < 8; ++w) tot += SSQ[w * 64 + 32 * lt + r];
            const float rs = rsqrtf(tot * (1.0f / 512.0f) + EPS);
            bf16* mp = mixed + ((size_t)b * T + t0 + 32 * lt + r) * D + 1024 + hd * 64 + 4 * h;
#pragma unroll
            for (int pt = 0; pt < 2; ++pt)
#pragma unroll
                for (int k = 0; k < 4; ++k) { v2u w; w.x = pk2(yo[pt][lt][4 * k] * rs, yo[pt][lt][4 * k + 1] * rs); w.y = pk2(yo[pt][lt][4 * k + 2] * rs, yo[pt][lt][4 * k + 3] * rs); *(v2u*)(mp + 32 * pt + 8 * k) = w; }
        }
        __syncthreads();
    }
}
__device__ __forceinline__ void m_norms2(Frame& F) {
    const float* onsa = (const float*)(F.R + R_ONSA); const float* osb = (const float*)(F.R + R_OSB); bf16* mixed = (bf16*)(F.R + R_MIXED);
    const int gw = F.vcu * NWAVES + F.wave, NGW = F.G * NWAVES, lane = F.lane;
    for (int w = gw; w < M * 2; w += NGW) {
        const int seg = w & 1, row = w >> 1;
        const float* src = (seg == 0 ? onsa : osb) + (size_t)row * 512;
        const f32x4 v0 = *((const f32x4*)src + lane), v1 = *((const f32x4*)src + 64 + lane);
        float sq = (v0[0] * v0[0] + v0[1] * v0[1]) + (v0[2] * v0[2] + v0[3] * v0[3]) + (v1[0] * v1[0] + v1[1] * v1[1]) + (v1[2] * v1[2] + v1[3] * v1[3]);
        sq = wave_sum(sq);
        const float rr = rsqrtf(sq * (1.0f / 512.0f) + EPS);
        bf16* dst = mixed + (size_t)row * D + seg * 512;
        v2u w0; w0.x = pk2(v0[0] * rr, v0[1] * rr); w0.y = pk2(v0[2] * rr, v0[3] * rr); *((v2u*)dst + lane) = w0;
        v2u w1; w1.x = pk2(v1[0] * rr, v1[1] * rr); w1.y = pk2(v1[2] * rr, v1[3] * rr); *((v2u*)dst + 64 + lane) = w1;
    }
}
__device__ __forceinline__ void p_quant_x(Frame& F) {
    const int gw = F.vcu * NWAVES + F.wave, NGW = F.G * NWAVES, lane = F.lane;
    float* xsc = (float*)(F.ws + WS_TAB + TAB_XS);
    for (int m = gw; m < M; m += 2 * NGW) {
        const int m2 = m + NGW; const bool two = m2 < M;
        const f32x4* xr = (const f32x4*)(F.out + (size_t)m * D) + lane; const f32x4* xr2 = (const f32x4*)(F.out + (size_t)(two ? m2 : m) * D) + lane;
        f32x4 v[8], w[8]; float mx = 0.f, mx2 = 0.f;
#pragma unroll
        for (int j = 0; j < 8; ++j) { v[j] = xr[64 * j]; w[j] = xr2[64 * j]; }
#pragma unroll
        for (int j = 0; j < 8; ++j) { mx = fmaxf(fmaxf(mx, fmaxf(fabsf(v[j][0]), fabsf(v[j][1]))), fmaxf(fabsf(v[j][2]), fabsf(v[j][3])));
                                      mx2 = fmaxf(fmaxf(mx2, fmaxf(fabsf(w[j][0]), fabsf(w[j][1]))), fmaxf(fabsf(w[j][2]), fabsf(w[j][3]))); }
        mx = fmaxf(wave_max(mx), 1e-30f); mx2 = fmaxf(wave_max(mx2), 1e-30f);
        const float inv = 127.0f / mx, inv2 = 127.0f / mx2;
        unsigned* o = (unsigned*)(F.ws + WS_XB + (size_t)m * D) + lane;
#pragma unroll
        for (int j = 0; j < 8; ++j) o[64 * j] = pk4_i8(v[j][0] * inv, v[j][1] * inv, v[j][2] * inv, v[j][3] * inv);
        if (lane == 0) xsc[m] = mx * (1.0f / 127.0f);
        if (two) {
            unsigned* o2 = (unsigned*)(F.ws + WS_XB + (size_t)m2 * D) + lane;
#pragma unroll
            for (int j = 0; j < 8; ++j) o2[64 * j] = pk4_i8(w[j][0] * inv2, w[j][1] * inv2, w[j][2] * inv2, w[j][3] * inv2);
            if (lane == 0) xsc[m2] = mx2 * (1.0f / 127.0f);
        }
    }
}
__device__ __forceinline__ void p_final(Frame& F, const float* gain) {
    const u64* ssf = ssptr(F, 6);
    const int gw = F.vcu * NWAVES + F.wave, NGW = F.G * NWAVES, lane = F.lane;
    for (int m = gw; m < M; m += NGW) {
        const float r = rstd_of(ssf[m]);
        f32x4* xr = (f32x4*)(F.out + (size_t)m * D) + lane;
#pragma unroll
        for (int j = 0; j < 8; ++j) { const f32x4 g = *((const f32x4*)gain + 64 * j + lane); f32x4 v = xr[64 * j]; v = v * r * g; xr[64 * j] = v; }
    }
}

#define SEG_BODY(SEGNO) do { constexpr int seg = (SEGNO); \
        const int layer = seg >> 1, second = seg & 1; \
        if (IN_PH()) { \
            FRAME(); \
            { pg8::Gemm g{(const bf16*)(F.ws + WS_XB), wptr(F, layer, second ? WL_GU2 : WL_GU1), M, NGU, (gu8(seg) || gui8(seg)) ? D / 2 : D}; pg8::StaticOrder S; S.init(M, NGU, F.G, F.vcu); \
            EpiGateUp E{(bf16*)(F.R + R_H), ssptr(F, 3 * layer + (second ? 2 : 0)), gui8(seg) ? __uint_as_float(((const unsigned*)F.ctlf)[CW_WMAX]) * (1.0f / 127.0f) : (gu8(seg) ? GU8_UNSCALE : 1.0f), dn8(seg) ? 1 : 0, \
                        (const float*)(F.ws + WS_TAB + TAB_XS), gui8(seg) ? 1 : 0}; \
            REPEAT(REP_GU, pg8::gemm_phase<EpiGateUp, pg8::StaticOrder, true, GEMM_SP2, gui8(seg) ? 2 : (gu8(seg) ? 1 : 0)>(glds, g, S, E)); } \
            if (CVM_GU[seg] != 0u && F.vcu >= F.G / 2) { \
                KArgs kb = kargs(); Frame F2 = make_frame(kb->ws, kb->out, lds); \
                ProIn I{kb->in[0], kb->in[1], kb->in[2], kb->in[3], kb->in[4], kb->in[5], kb->in[6], kb->in[7], kb->in[8], kb->in[11], kb->in[12], kb->in[18], kb->in[19], kb->in[20], kb->in[21], kb->in[22], kb->in[9], kb->in[10]}; \
                convert_weights<CVM_GU[seg]>(F2, I, (F2.vcu - F2.G / 2) * NWAVES + F2.wave, (F2.G / 2) * NWAVES); \
            } \
        } \
        END_PH(); \
        if (IN_PH()) { \
            FRAME(); \
            pg8::Gemm g{(const bf16*)(F.R + R_H), wptr(F, layer, second ? WL_DN2 : WL_DN1), M, D, dn8(seg) ? FF / 2 : FF}; pg8::StaticOrder S; S.init(M, D, F.G, F.vcu); \
            if (FUSE_X && seg == 3) { \
                EpiResidFin E{(const float*)F.out, F.out, INP(23), dn8(seg) ? 0.5f * DN8_UNSCALE : 0.5f, PanelX{(float*)(F.ws + WS_TAB + TAB_PX) + (size_t)M * 8, (unsigned*)F.ctlf + CW_PX + 2048}}; \
                pg8::gemm_phase<EpiResidFin, pg8::StaticOrder, true, GEMM_SP2, dn8(seg) ? 1 : 0>(glds, g, S, E); \
            } else if (FUSE_X && !second && wini8(layer)) { \
                EpiResidQ8 E{seg == 0 ? INP(0) : (const float*)F.out, F.out, (unsigned char*)(F.ws + WS_XB), (float*)(F.ws + WS_TAB + TAB_XS), ssptr(F, 3 * layer + 1), dn8(seg) ? 0.5f * DN8_UNSCALE : 0.5f, \
                             PanelX{(float*)(F.ws + WS_TAB + TAB_PX), (unsigned*)F.ctlf + CW_PX}}; \
                pg8::gemm_phase<EpiResidQ8, pg8::StaticOrder, true, GEMM_SP2, dn8(seg) ? 1 : 0>(glds, g, S, E); \
            } else { \
            EpiResid E{seg == 0 ? INP(0) : (const float*)F.out, F.out, (bf16*)(F.ws + WS_XB), ssptr(F, second ? 3 * (layer + 1) : 3 * layer + 1), dn8(seg) ? 0.5f * DN8_UNSCALE : 0.5f, (second && gu8(seg + 1)) ? 1 : ((!second && wini8(layer)) ? 2 : 0)}; \
            pg8::gemm_phase<EpiResid, pg8::StaticOrder, true, GEMM_SP2, dn8(seg) ? 1 : 0>(glds, g, S, E); } \
        } \
        END_PH(); \
        if (!second) { \
            if (wini8(layer) && !FUSE_X) { \
                if (IN_PH()) { FRAME(); p_quant_x(F); } \
                END_PH(); \
            } \
            if (IN_PH()) { \
                FRAME(); \
                { pg8::Gemm g{(const bf16*)(F.ws + WS_XB), wptr(F, layer, WL_IN), M, NIN, wini8(layer) ? D / 2 : D}; pg8::StaticOrder S; S.init(M, NIN, F.G, F.vcu); \
                EpiWin E{F.R, ssptr(F, 3 * layer + 1), (const float*)(F.ws + WS_TAB + TAB_XS), wini8(layer) ? __uint_as_float(((const unsigned*)F.ctlf)[CW_WMAX + 1 + layer]) * (1.0f / 127.0f) : 1.0f, wini8(layer) ? 1 : 0}; \
                REPEAT(REP_WIN, pg8::gemm_phase<EpiWin, pg8::StaticOrder, true, GEMM_SP2, wini8(layer) ? 2 : 0>(glds, g, S, E)); } \
                if (CVM_WIN[layer] != 0u && F.vcu >= (F.G * 3) / 4) { \
                    KArgs kb = kargs(); Frame F2 = make_frame(kb->ws, kb->out, lds); \
                    ProIn I{kb->in[0], kb->in[1], kb->in[2], kb->in[3], kb->in[4], kb->in[5], kb->in[6], kb->in[7], kb->in[8], kb->in[11], kb->in[12], kb->in[18], kb->in[19], kb->in[20], kb->in[21], kb->in[22], kb->in[9], kb->in[10]}; \
                    convert_weights<CVM_WIN[layer]>(F2, I, (F2.vcu - (F2.G * 3) / 4) * NWAVES + F2.wave, (F2.G / 4) * NWAVES); \
                } \
            } \
            END_PH(); \
            if (IN_PH()) { FRAME(); REPEAT(REP_M1, REPEAT(REP_CMP, m_compress(F, layer)); REPEAT(REP_S1, m_ssd_s1(F, layer, INP(13), INP(14), INP(15), INP(16))); REPEAT(REP_SB, m_sb(F))); } \
            END_PH(); \
            if (IN_PH()) { FRAME(); REPEAT(REP_M2, REPEAT(REP_S2, m_ssd_s2(F)); REPEAT(REP_NSA, m_nsa(F))); } \
            END_PH(); \
            if (IN_PH()) { FRAME(); REPEAT(REP_M3, REPEAT(REP_S3, m_ssd_s3(F, layer, INP(17))); REPEAT(REP_N2, m_norms2(F))); } \
            END_PH(); \
             \
            if (IN_PH()) { \
                FRAME(); \
                pg8::Gemm g{(const bf16*)(F.R + R_MIXED), wptr(F, layer, WL_OUT), M, D, D}; pg8::StaticOrder S; S.init(M, D, F.G, F.vcu); \
                EpiResid E{F.out, F.out, (bf16*)(F.ws + WS_XB), ssptr(F, 3 * layer + 2), 1.0f, gu8(seg + 1) ? 1 : 0}; \
                pg8::gemm_phase<EpiResid, pg8::StaticOrder, true, GEMM_SP2>(glds, g, S, E); \
            } \
            END_PH(); \
        } \
     \
    } while (0)
__global__ void __launch_bounds__(NTHR, 2) mega_fwd(Args args) {
    extern __shared__ __attribute__((aligned(16))) unsigned char lds[];
    volatile LAS unsigned* MISC = (volatile LAS unsigned*)((LAS unsigned char*)lds + MISC_OFF);
    if (threadIdx.x < 64) MISC[threadIdx.x] = 0u;
    __syncthreads();
    if (MK_ONE_LAUNCH) (void)xcd_barrier_post((unsigned*)(args.ws + WS_CTL) + CW_BAR, MISC + 8);
    int pc = 0;
#define IN_PH() ({ KArgs _k = kargs(); (_k->ph_lo <= pc && pc < _k->ph_hi); })
#define END_PH() do { KArgs _k = kargs(); \
        if (MK_ONE_LAUNCH && pc + 1 < _k->ph_hi && pc >= _k->ph_lo) { XcdBarrier _b; _b.bar = (unsigned*)(_k->ws + WS_CTL) + CW_BAR; _b.x = xb_xcc_id(); _b.st = MISC + 8; xcd_barrier(_b); } \
        ++pc; } while (0)
#define FRAME() KArgs ka = kargs(); Frame F = make_frame(ka->ws, ka->out, lds)
#define INP(k) (ka->in[k])
    LAS unsigned char* glds = (LAS unsigned char*)lds;

    if (IN_PH()) { FRAME();
        ProIn I{INP(0), INP(1), INP(2), INP(3), INP(4), INP(5), INP(6), INP(7), INP(8), INP(11), INP(12), INP(18), INP(19), INP(20), INP(21), INP(22), INP(9), INP(10)};
        REPEAT(REP_PRO, REPEAT(REP_PA, p_prologue(F, I))); }
    END_PH();
    if (IN_PH()) { FRAME();
        ProIn I{INP(0), INP(1), INP(2), INP(3), INP(4), INP(5), INP(6), INP(7), INP(8), INP(11), INP(12), INP(18), INP(19), INP(20), INP(21), INP(22), INP(9), INP(10)};
        REPEAT(REP_PRO, REPEAT(REP_PB, p_prologue_b(F, I))); }
    END_PH();
    SEG_BODY(0); SEG_BODY(1); SEG_BODY(2); SEG_BODY(3);
    if (!FUSE_X) {
    if (IN_PH()) { FRAME(); p_final(F, INP(23)); }
    END_PH();
    }
#undef IN_PH
#undef END_PH
#undef FRAME
#undef INP
#undef SEG_BODY
}
constexpr int N_PHASES = 2 + 4 * 2 + 2 * 5 + (FUSE_X ? 0 : (wini8(0) ? 1 : 0) + (wini8(1) ? 1 : 0) + 1);

extern "C" void kernel_launch(void* const* d_in, const int* in_sizes, int n_in, void* d_out, int out_size, void* d_ws, size_t ws_size, hipStream_t stream) {
    static int grid = 0;
    if (grid == 0) {
        if (n_in != 24 || in_sizes[0] != M * D || out_size != M * D || ws_size < WS_END) {
            fprintf(stderr, "kernel_launch: shape/workspace mismatch: n_in %d in0 %d out %d ws %zu (need %zu); nothing launched\n", n_in, n_in > 0 ? in_sizes[0] : -1, out_size, ws_size, (size_t)WS_END);
            grid = -1; return; }
        int dev = 0, cus = 0, per_cu = 0;
        if (hipGetDevice(&dev) != hipSuccess || hipDeviceGetAttribute(&cus, hipDeviceAttributeMultiprocessorCount, dev) != hipSuccess) { grid = -1; return; }
        if (hipFuncSetAttribute((const void*)mega_fwd, hipFuncAttributeMaxDynamicSharedMemorySize, LDS_BYTES) != hipSuccess) { fprintf(stderr, "kernel_launch: hipFuncSetAttribute failed\n"); grid = -1; return; }
        if (hipOccupancyMaxActiveBlocksPerMultiprocessor(&per_cu, (const void*)mega_fwd, NTHR, LDS_BYTES) != hipSuccess || per_cu < 1) { fprintf(stderr, "kernel_launch: occupancy query reports %d\n", per_cu); }
        (void)hipGetLastError();
        if (FUSE_X && cus != 256) { fprintf(stderr, "kernel_launch: the fused down-GEMM epilogues need exactly 256 workgroups (one output tile each), this device has %d CUs; nothing launched\n", cus); grid = -1; return; }
        grid = cus;
    }
    if (grid < 0) return;
    (void)hipMemsetAsync((char*)d_ws + WS_CTL, 0, CTL_ZERO_BYTES, stream);
    Args a{};
    for (int i = 0; i < 24; ++i) a.in[i] = (const float*)d_in[i];
    a.out = (float*)d_out; a.ws = (unsigned char*)d_ws;
#if MK_ONE_LAUNCH
    a.ph_lo = 0; a.ph_hi = N_PHASES;
    hipLaunchKernelGGL(mega_fwd, dim3(grid), dim3(NTHR), LDS_BYTES, stream, a);
#else
    for (int p = 0; p < N_PHASES; ++p) { a.ph_lo = p; a.ph_hi = p + 1; hipLaunchKernelGGL(mega_fwd, dim3(grid), dim3(NTHR), LDS_BYTES, stream, a); }
#endif
}
```

```cpp
#include <hip/hip_runtime.h>
#include <cstdio>
#include <cstdint>

#ifndef GEMM_SP2
#define GEMM_SP2 true
#endif
#ifndef REP_PRO
#define REP_PRO 1
#endif
#ifndef REP_GU
#define REP_GU 1
#endif
#ifndef REP_WIN
#define REP_WIN 1
#endif
#ifndef REP_M1
#define REP_M1 1
#endif
#ifndef REP_M2
#define REP_M2 1
#endif
#ifndef REP_M3
#define REP_M3 1
#endif
#ifndef REP_CMP
#define REP_CMP 1
#endif
#ifndef REP_S1
#define REP_S1 1
#endif
#ifndef REP_SB
#define REP_SB 1
#endif
#ifndef REP_S2
#define REP_S2 1
#endif
#ifndef REP_NSA
#define REP_NSA 1
#endif
#ifndef REP_S1A
#define REP_S1A 1
#endif
#ifndef REP_S1B
#define REP_S1B 1
#endif
#ifndef REP_S1C
#define REP_S1C 1
#endif
#ifndef REP_CMPA
#define REP_CMPA 1
#endif
#ifndef REP_CMPB
#define REP_CMPB 1
#endif
#ifndef REP_S3
#define REP_S3 1
#endif
#ifndef REP_N2
#define REP_N2 1
#endif
#ifndef REP_PA
#define REP_PA 1
#endif
#ifndef REP_PB
#define REP_PB 1
#endif
#ifndef REP_AMAX
#define REP_AMAX 1
#endif
#define REPEAT(N, ...) do { __VA_ARGS__; if ((N) > 1) { __VA_ARGS__; } } while (0)
#ifndef GU8_MASK
#define GU8_MASK 0xE
#endif
#ifndef GU_I8
#define GU_I8 1
#endif
#ifndef FUSE_X
#define FUSE_X 1
#endif
#ifndef WIN_I8
#define WIN_I8 2
#endif
#ifndef DN8_MASK
#define DN8_MASK 0xF
#endif
#ifndef MK_ONE_LAUNCH
#define MK_ONE_LAUNCH 1
#endif

namespace pg8 {
#define PG8_LAS __attribute__((address_space(3)))
typedef unsigned short bf16_t;
typedef short bf16x8 __attribute__((ext_vector_type(8)));
typedef float f32x4 __attribute__((ext_vector_type(4)));
typedef unsigned u32x4 __attribute__((ext_vector_type(4)));
typedef int i32x4 __attribute__((ext_vector_type(4)));
typedef int i32x8 __attribute__((ext_vector_type(8)));
constexpr int BM = 256, BK = 64, HALF = 128, HTB = HALF * BK * 2  , STAGE_BYTES = 8 * HTB, NXCD = 8, WGM = 8;

__host__ __device__ __forceinline__ int lds_byte(int r, int c) { const int st = (r >> 4) * 2 + (c >> 5), rr = r & 15, cc = c & 31, ob = rr * 64 + cc * 2; return st * 1024 + (ob ^ (((ob >> 9) & 1) << 5)); }
__host__ __device__ __forceinline__ void stage_rc(int b, int& R, int& C) { const int st = b / 1024, sb = b % 1024, swz = sb ^ (((sb >> 9) & 1) << 5); R = (st >> 1) * 16 + swz / 64; C = (st & 1) * 32 + (swz % 64) / 2; }
__host__ __device__ __forceinline__ int perm32(int rho) { const int n = rho >> 4, i = rho & 15; return 8 * (i >> 2) + 4 * n + (i & 3); }

struct Unit { int pm, pn; };
struct Gemm { const bf16_t* A; const bf16_t* Bt; int M, N, K; };

struct StaticOrder {
    int nM, nN, nwg, G, c;
    __host__ __device__ void init(int M, int N, int G_, int c_) { nM = M / BM; nN = N / BM; nwg = nM * nN; G = G_; c = c_; }
    __host__ __device__ bool next(int i, Unit& u) const {
        const long L = (long)i * G + c; if (L >= nwg) return false;
        int wgid = (int)L; { const int q = nwg / NXCD, r = nwg % NXCD, xcd = wgid % NXCD, off = wgid / NXCD; wgid = (xcd < r ? xcd * (q + 1) : r * (q + 1) + (xcd - r) * q) + off; }
        const int nig = WGM * nN, gid = wgid / nig, fm = gid * WGM, gsz = (nM - fm) < WGM ? (nM - fm) : WGM;
        u.pm = fm + ((wgid % nig) % gsz); u.pn = (wgid % nig) / gsz; return true;
    }
    __device__ __forceinline__ void a_ready(const Unit&) const {}
    __device__ __forceinline__ void done(const Unit&) const {}
};

__device__ __forceinline__ unsigned cvt_pk_bf16(float lo, float hi) { unsigned r; asm volatile("v_cvt_pk_bf16_f32 %0, %1, %2" : "=v"(r) : "v"(lo), "v"(hi)); return r; }

template <class Epi, class Sched, bool ALIGN_EPI = false, bool SP2 = false, int QM = 0>
__device__ __forceinline__ void gemm_phase(PG8_LAS unsigned char* lds, const Gemm g, const Sched& S, const Epi& E) {
    constexpr bool FP8 = (QM == 1);
    int tid = threadIdx.x; asm volatile("" : "+v"(tid));
    const int wid = __builtin_amdgcn_readfirstlane(tid >> 6), lane = tid & 63, wr = wid >> 2, wc = wid & 3, fr = lane & 15, fq = lane >> 4;
    const int K = g.K, nt = K / BK;
    unsigned voffA[2], voffB[2];
#pragma unroll
    for (int i = 0; i < 2; ++i) { int R, C; stage_rc(tid * 16 + i * 8192, R, C); const int Rb = Epi::PERM ? ((R & ~31) + perm32(R & 31)) : R;
        voffA[i] = (unsigned)(R * K + C) * 2u; voffB[i] = (unsigned)(Rb * K + C) * 2u; }
    const size_t kstep = (size_t)(BK * 2);
    const size_t hstep = (size_t)HALF * K * 2;
    const size_t tstep = 2 * hstep;
    const unsigned ldsw = (unsigned)wid * 1024u;
    const int aoff = lds_byte(wr * 64 + fr, fq * 8), boff = lds_byte(wc * 32 + fr, fq * 8);
#define PG8_SA(b, h) (((b) * 2 + (h)) * HTB)
#define PG8_SB(b, h) ((4 + (b) * 2 + (h)) * HTB)
#define PG8_STAGE(bufoff, gbase, voff) do { _Pragma("unroll") for (int _i = 0; _i < 2; ++_i) \
        __builtin_amdgcn_global_load_lds((const unsigned*)((const char*)(gbase) + (voff)[_i]), (PG8_LAS unsigned*)(lds + (bufoff) + ldsw + _i * 8192), 16, 0, 0); } while (0)
#define PG8_LDA(dst, b, h) do { _Pragma("unroll") for (int m = 0; m < 4; ++m) { if constexpr (FP8) { dst##8[m] = __builtin_shufflevector(*(const PG8_LAS i32x4*)(lds + PG8_SA(b, h) + aoff + m * 2048), *(const PG8_LAS i32x4*)(lds + PG8_SA(b, h) + aoff + m * 2048 + 1024), 0, 1, 2, 3, 4, 5, 6, 7); } \
        else { _Pragma("unroll") for (int k = 0; k < 2; ++k) dst[m][k] = *(const PG8_LAS bf16x8*)(lds + PG8_SA(b, h) + aoff + m * 2048 + k * 1024); } } } while (0)
#define PG8_LDB(dst, b, h) do { _Pragma("unroll") for (int n = 0; n < 2; ++n) { if constexpr (FP8) { dst##8[n] = __builtin_shufflevector(*(const PG8_LAS i32x4*)(lds + PG8_SB(b, h) + boff + n * 2048), *(const PG8_LAS i32x4*)(lds + PG8_SB(b, h) + boff + n * 2048 + 1024), 0, 1, 2, 3, 4, 5, 6, 7); } \
        else { _Pragma("unroll") for (int k = 0; k < 2; ++k) dst[n][k] = *(const PG8_LAS bf16x8*)(lds + PG8_SB(b, h) + boff + n * 2048 + k * 1024); } } } while (0)
#define PG8_MMA(ai, bj, At, Bt) do { __builtin_amdgcn_s_setprio(1); _Pragma("unroll") for (int m = 0; m < 4; ++m) _Pragma("unroll") for (int n = 0; n < 2; ++n) { \
        if constexpr (FP8) { asm("v_mfma_f32_16x16x128_f8f6f4 %0, %1, %2, %0" : "+v"(acc[ai][bj][m][n]) : "v"(Bt##8[n]), "v"(At##8[m])); }   \
        else if constexpr (QM == 2) { _Pragma("unroll") for (int k = 0; k < 2; ++k) acc[ai][bj][m][n] = __builtin_bit_cast(f32x4, __builtin_amdgcn_mfma_i32_16x16x64_i8(__builtin_bit_cast(i32x4, Bt[n][k]), __builtin_bit_cast(i32x4, At[m][k]), __builtin_bit_cast(i32x4, acc[ai][bj][m][n]), 0, 0, 0)); }   \
        else { _Pragma("unroll") for (int k = 0; k < 2; ++k) acc[ai][bj][m][n] = __builtin_amdgcn_mfma_f32_16x16x32_bf16(Bt[n][k], At[m][k], acc[ai][bj][m][n], 0, 0, 0); } } \
        __builtin_amdgcn_s_setprio(0); } while (0)
#define PG8_WAIT_V(n) asm volatile("s_waitcnt vmcnt(" #n ")" ::: "memory")
#define PG8_WAIT_L(n) asm volatile("s_waitcnt lgkmcnt(" #n ")" ::: "memory")
#define PG8_BAR __builtin_amdgcn_s_barrier()
#define PG8_SCHED __builtin_amdgcn_sched_barrier(0)
    Unit cur, nxt; int ui = 0;
    if (!S.next(0, cur)) return;
    f32x4 acc[2][2][4][2];
#pragma unroll
    for (int a = 0; a < 2; ++a)
#pragma unroll
        for (int b = 0; b < 2; ++b)
#pragma unroll
            for (int m = 0; m < 4; ++m)
#pragma unroll
                for (int n = 0; n < 2; ++n) acc[a][b][m][n] = (f32x4){0.f, 0.f, 0.f, 0.f};
    bf16x8 At[4][2], B0[2][2], B1[2][2]; i32x8 At8[4], B08[2], B18[2];
    const char* cA = (const char*)g.A + (size_t)cur.pm * tstep; const char* cB = (const char*)g.Bt + (size_t)cur.pn * tstep;
    S.a_ready(cur);
    if constexpr (SP2) {
        PG8_STAGE(PG8_SB(0, 0), cB, voffB); PG8_STAGE(PG8_SB(0, 1), cB + hstep, voffB); PG8_STAGE(PG8_SA(0, 0), cA, voffA); PG8_STAGE(PG8_SA(0, 1), cA + hstep, voffA);
        if (wr == 1) PG8_BAR;
        PG8_WAIT_V(2); PG8_BAR;
        PG8_STAGE(PG8_SB(1, 0), cB + kstep, voffB); PG8_STAGE(PG8_SA(1, 0), cA + kstep, voffA); PG8_STAGE(PG8_SB(1, 1), cB + hstep + kstep, voffB);
        PG8_WAIT_V(6); PG8_BAR;
    } else {
        PG8_STAGE(PG8_SB(0, 0), cB, voffB); PG8_STAGE(PG8_SA(0, 0), cA, voffA); PG8_STAGE(PG8_SB(0, 1), cB + hstep, voffB); PG8_STAGE(PG8_SA(0, 1), cA + hstep, voffA);
        if (wr == 1) PG8_BAR;
        PG8_WAIT_V(4); PG8_BAR;
        PG8_STAGE(PG8_SB(1, 0), cB + kstep, voffB); PG8_STAGE(PG8_SA(1, 0), cA + kstep, voffA); PG8_STAGE(PG8_SB(1, 1), cB + hstep + kstep, voffB);
        PG8_WAIT_V(6); PG8_BAR;
    }
    for (;;) {
        const bool has_next = S.next(ui + 1, nxt);
        const char* nA = has_next ? (const char*)g.A + (size_t)nxt.pm * tstep : cA; const char* nB = has_next ? (const char*)g.Bt + (size_t)nxt.pn * tstep : cB;
        for (int t = 0; t < nt; t += 2) {
            const bool last = (t == nt - 2);
            const char* a1 = cA + (size_t)(t + 1) * kstep;
            const char* a2 = last ? nA : cA + (size_t)(t + 2) * kstep; const char* b2 = last ? nB : cB + (size_t)(t + 2) * kstep;
            const char* a3 = a2 + kstep; const char* b3 = b2 + kstep;
            if (last && has_next) S.a_ready(nxt);
            if constexpr (SP2) {
            PG8_LDB(B0, 0, 0); PG8_LDB(B1, 0, 1); PG8_SCHED; PG8_LDA(At, 0, 0); PG8_STAGE(PG8_SA(1, 1), a1 + hstep, voffA);
            PG8_WAIT_V(8); PG8_WAIT_L(0); PG8_BAR; PG8_MMA(0, 0, At, B0); PG8_MMA(0, 1, At, B1); PG8_BAR; PG8_SCHED;
            PG8_LDA(At, 0, 1); PG8_STAGE(PG8_SB(0, 0), b2, voffB); PG8_STAGE(PG8_SB(0, 1), b2 + hstep, voffB); PG8_STAGE(PG8_SA(0, 0), a2, voffA);
            PG8_WAIT_V(8); PG8_WAIT_L(0); PG8_BAR; PG8_MMA(1, 0, At, B0); PG8_MMA(1, 1, At, B1); PG8_BAR; PG8_SCHED;
            PG8_LDB(B0, 1, 0); PG8_LDB(B1, 1, 1); PG8_SCHED; PG8_LDA(At, 1, 0); PG8_STAGE(PG8_SA(0, 1), a2 + hstep, voffA);
            PG8_WAIT_V(8); PG8_WAIT_L(0); PG8_BAR; PG8_MMA(0, 0, At, B0); PG8_MMA(0, 1, At, B1); PG8_BAR; PG8_SCHED;
            PG8_LDA(At, 1, 1); PG8_STAGE(PG8_SB(1, 0), b3, voffB); PG8_STAGE(PG8_SB(1, 1), b3 + hstep, voffB); PG8_STAGE(PG8_SA(1, 0), a3, voffA);
            PG8_WAIT_V(8); PG8_WAIT_L(0); PG8_BAR; PG8_MMA(1, 0, At, B0); PG8_MMA(1, 1, At, B1); PG8_BAR; PG8_SCHED;
            } else {
            PG8_LDB(B0, 0, 0); PG8_SCHED; PG8_LDA(At, 0, 0); PG8_STAGE(PG8_SA(1, 1), a1 + hstep, voffA);
            PG8_WAIT_L(8); PG8_BAR; PG8_WAIT_L(0); PG8_MMA(0, 0, At, B0); PG8_BAR; PG8_SCHED;
            PG8_LDB(B1, 0, 1); PG8_STAGE(PG8_SB(0, 0), b2, voffB);
            PG8_BAR; PG8_WAIT_L(0); PG8_MMA(0, 1, At, B1); PG8_BAR;
            PG8_LDA(At, 0, 1); PG8_STAGE(PG8_SA(0, 0), a2, voffA);
            PG8_BAR; PG8_WAIT_L(0); PG8_MMA(1, 0, At, B0); PG8_BAR; PG8_SCHED;
            PG8_STAGE(PG8_SB(0, 1), b2 + hstep, voffB);
            PG8_WAIT_V(6); PG8_BAR; PG8_MMA(1, 1, At, B1); PG8_BAR;
            PG8_LDB(B0, 1, 0); PG8_SCHED; PG8_LDA(At, 1, 0); PG8_STAGE(PG8_SA(0, 1), a2 + hstep, voffA);
            PG8_WAIT_L(8); PG8_BAR; PG8_WAIT_L(0); PG8_MMA(0, 0, At, B0); PG8_BAR; PG8_SCHED;
            PG8_LDB(B1, 1, 1); PG8_STAGE(PG8_SB(1, 0), b3, voffB);
            PG8_BAR; PG8_WAIT_L(0); PG8_MMA(0, 1, At, B1); PG8_BAR;
            PG8_LDA(At, 1, 1); PG8_STAGE(PG8_SA(1, 0), a3, voffA);
            PG8_BAR; PG8_WAIT_L(0); PG8_MMA(1, 0, At, B0); PG8_BAR; PG8_SCHED;
            PG8_STAGE(PG8_SB(1, 1), b3 + hstep, voffB);
            PG8_WAIT_V(6); PG8_BAR; PG8_MMA(1, 1, At, B1); PG8_BAR;
            }
        }
        if constexpr (ALIGN_EPI) { if (wr == 0) PG8_BAR; }
        if constexpr (!Epi::AFTER_DRAIN) E(acc, cur, wr, wc, fr, fq);
        S.done(cur);
        if (!has_next) break;
#pragma unroll
        for (int a = 0; a < 2; ++a)
#pragma unroll
            for (int b = 0; b < 2; ++b)
#pragma unroll
                for (int m = 0; m < 4; ++m)
#pragma unroll
                    for (int n = 0; n < 2; ++n) acc[a][b][m][n] = (f32x4){0.f, 0.f, 0.f, 0.f};
        cur = nxt; cA = nA; cB = nB; ++ui;
        if constexpr (ALIGN_EPI) { if (wr == 1) PG8_BAR; }
    }
    PG8_WAIT_V(0);
    if constexpr (!ALIGN_EPI) { if (wr == 0) PG8_BAR; }
    PG8_BAR;
    if constexpr (Epi::AFTER_DRAIN) E.fused(acc, cur, wr, wc, fr, fq, lds);
#undef PG8_SA
#undef PG8_SB
#undef PG8_STAGE
#undef PG8_LDA
#undef PG8_LDB
#undef PG8_MMA
#undef PG8_WAIT_V
#undef PG8_WAIT_L
#undef PG8_BAR
#undef PG8_SCHED
}
}

constexpr int NWAVES = 8, NTHR = 512;
constexpr int BATCH = 4, T = 2048, M = BATCH * T, D = 2048, FF = 5632, DEPTH = 2;
constexpr int NIN_SRC = 5416, NIN = 5632;
constexpr int NGU = 2 * FF;
constexpr float EPS = 1e-6f;
constexpr float LOG2E = 1.4426950408889634f;
constexpr float QSCALE = 0.125f * LOG2E;
constexpr int NSS = 7;

constexpr size_t MiB = 1u << 20;
constexpr size_t WS_CTL = 0, CTL_ZERO_BYTES = 1 * MiB;
constexpr int CW_TMO = 0, CW_BAR = 4096, CW_PX = 8192  , CW_SS = 16384;
static_assert((CW_SS + 2 * NSS * M) * 4 <= (int)CTL_ZERO_BYTES, "ctl");
typedef unsigned long long u64;
constexpr float SS_SCALE = 1048576.0f, SS_INV = 1.0f / 1048576.0f;
constexpr size_t WS_TAB = 1 * MiB;
constexpr size_t WS_W = 2 * MiB;
constexpr size_t W_GU = (size_t)NGU * D * 2, W_DN = (size_t)D * FF * 2, W_IN = (size_t)NIN * D * 2, W_OUT = (size_t)D * D * 2;
constexpr size_t WL_GU1 = 0, WL_DN1 = WL_GU1 + W_GU, WL_IN = WL_DN1 + W_DN, WL_OUT = WL_IN + W_IN, WL_GU2 = WL_OUT + W_OUT, WL_DN2 = WL_GU2 + W_GU, WL_SIZE = WL_DN2 + W_DN;
static_assert(WL_SIZE == 162 * MiB, "weights per layer");
constexpr size_t WS_XB = WS_W + DEPTH * WL_SIZE;
constexpr size_t WS_CW = WS_XB + (size_t)M * D * 2;
constexpr size_t WS_R = WS_CW + 1 * MiB;
constexpr size_t TAB_PB = 8192;
constexpr size_t R_H = 0;
constexpr size_t R_QN = 0, R_QS = R_QN + 8 * MiB, R_KS = R_QS + 8 * MiB, R_KN = R_KS + 8 * MiB, R_CMPRAW = R_KN + 4 * MiB, R_VNT = R_CMPRAW + 8 * MiB,
                 R_VST = R_VNT + 4 * MiB, R_Z = R_VST + 8 * MiB, R_XBC = R_Z + 16 * MiB, R_DTG = R_XBC + 24 * MiB, R_XT = R_DTG + 2 * MiB, R_BM = R_XT + 16 * MiB,
                 R_CM = R_BM + 4 * MiB, R_DT = R_CM + 4 * MiB, R_KCMP = R_DT + 1 * MiB, R_VCMPT = R_KCMP + 1 * MiB, R_SELM = R_VCMPT + 1 * MiB, R_MIXED = R_SELM + 1 * MiB,
                 R_OC = R_MIXED + 32 * MiB, R_ONSA = R_OC + 16 * MiB, R_OSB = R_ONSA + 16 * MiB, R_YS = R_OSB + 16 * MiB, R_ST = R_YS + 32 * MiB, R_HIN = R_ST + 64 * MiB,
                 R_ACS = R_HIN + 32 * MiB, R_AEND = R_ACS + 1 * MiB, R_END = R_AEND + 1 * MiB;
constexpr size_t WS_END = WS_R + R_END;
static_assert((size_t)M * FF * 2 <= R_MIXED, "H must not overlay MIXED");

typedef unsigned short bf16;
typedef unsigned v4u __attribute__((ext_vector_type(4)));
typedef unsigned v2u __attribute__((ext_vector_type(2)));
typedef float f32x4 __attribute__((ext_vector_type(4)));
#define LAS __attribute__((address_space(3)))
#define LDS_WAIT() asm volatile("s_waitcnt lgkmcnt(0)" ::: "memory")

__device__ __forceinline__ float bf2f(bf16 v) { return __uint_as_float(((unsigned)v) << 16); }
__device__ __forceinline__ unsigned f2bf(float f) { unsigned u = __float_as_uint(f); return (u + 0x7fffu + ((u >> 16) & 1u)) >> 16; }
__device__ __forceinline__ unsigned pk2(float lo, float hi) { unsigned r; asm("v_cvt_pk_bf16_f32 %0, %1, %2" : "=v"(r) : "v"(lo), "v"(hi)); return r; }
__device__ __forceinline__ float wave_sum(float v) {
#pragma unroll
    for (int o = 1; o < 64; o <<= 1) v += __shfl_xor(v, o);
    return v;
}
__device__ __forceinline__ float wave_max(float v) {
#pragma unroll
    for (int o = 1; o < 64; o <<= 1) v = fmaxf(v, __shfl_xor(v, o));
    return v;
}
__device__ __forceinline__ float fexp2(float x) { return __builtin_amdgcn_exp2f(x); }
__device__ __forceinline__ float frcp(float x) { return __builtin_amdgcn_rcpf(x); }
__device__ __forceinline__ float silu_f(float v) { return v * frcp(1.0f + fexp2(-v * LOG2E)); }
__device__ __forceinline__ float sigmoid_f(float v) { return frcp(1.0f + fexp2(-v * LOG2E)); }

#define XB_TMO      128
#define XB_XCNT(j)  (256  + 64 * (j))
#define XB_XSUB(j)  (1280 + 64 * (j))
#define XB_XGEN(j)  (2304 + 64 * (j))
#define XB_TOP      3328
#define XB_TOPGEN   3392
#define XCD_BAR_WORDS 3456
#define XB_SPIN_CAP (1u << 18)
__device__ __forceinline__ unsigned xb_ld(unsigned* p)              { return __hip_atomic_load(p, __ATOMIC_RELAXED, __HIP_MEMORY_SCOPE_AGENT); }
__device__ __forceinline__ unsigned xb_add(unsigned* p, unsigned v) { return __hip_atomic_fetch_add(p, v, __ATOMIC_RELAXED, __HIP_MEMORY_SCOPE_AGENT); }
__device__ __forceinline__ unsigned xb_xcc_id() { return (unsigned)__builtin_amdgcn_s_getreg((3 << 11) | 20) & 0xFu; }
#define XB_SPIN(cond, bar) do { unsigned _sp = 0; while (cond) { __builtin_amdgcn_s_sleep(1); \
    if ((++_sp & 255u) == 0u) { if (xb_ld(&(bar)[XB_TMO])) break; if (_sp > XB_SPIN_CAP) { atomicAdd(&(bar)[XB_TMO], 1u); break; } } } } while (0)
struct XcdBarrier { unsigned* bar; unsigned x; volatile LAS unsigned* st; };
__device__ __forceinline__ XcdBarrier xcd_barrier_post(unsigned* bar, volatile LAS unsigned* st) {
    XcdBarrier b; b.bar = bar; b.x = xb_xcc_id(); b.st = st;
    if (threadIdx.x == 0) (void)xb_add(&bar[XB_XCNT(b.x)], 1u);
    return b;
}
__device__ __forceinline__ void xcd_barrier_complete(unsigned* bar, unsigned x, unsigned& nloc, unsigned& nx) {
    const unsigned G = gridDim.x * gridDim.y * gridDim.z;
    unsigned sum, cnt, mine, sp = 0u;
    for (;;) {
        sum = 0u; cnt = 0u; mine = 0u;
#pragma unroll
        for (unsigned j = 0; j < 16; ++j) { const unsigned c = xb_ld(&bar[XB_XCNT(j)]); sum += c; cnt += (c > 0u) ? 1u : 0u; mine = (j == x) ? c : mine; }
        if (sum == G) break;
        __builtin_amdgcn_s_sleep(1);
        if ((++sp & 255u) == 0u) { if (xb_ld(&bar[XB_TMO])) break; if (sp > XB_SPIN_CAP) { atomicAdd(&bar[XB_TMO], 1u); break; } }
    }
    nloc = mine > 0u ? mine : 1u; nx = cnt > 0u ? cnt : 1u;
}
__device__ __forceinline__ void xcd_barrier(const XcdBarrier& b) {
    asm volatile("s_waitcnt vmcnt(0)" ::: "memory");
    __syncthreads();
    if (threadIdx.x == 0) {
        unsigned* bar = b.bar;
        __builtin_amdgcn_s_waitcnt(0);
        unsigned nloc = b.st[0], nx = b.st[1];
        if (nloc == 0u) { xcd_barrier_complete(bar, b.x, nloc, nx); b.st[0] = nloc; b.st[1] = nx; }
        const unsigned old = xb_add(&bar[XB_XSUB(b.x)], 1u);
        const unsigned gen = old / nloc;
        if (old + 1u == (gen + 1u) * nloc) {
            __builtin_amdgcn_fence(__ATOMIC_RELEASE, "agent");
            asm volatile("s_waitcnt vmcnt(0)" ::: "memory");
            const unsigned og = xb_add(&bar[XB_TOP], 1u);
            const unsigned tg = og / nx;
            if (og + 1u == (tg + 1u) * nx) xb_add(&bar[XB_TOPGEN], 1u);
            else XB_SPIN(xb_ld(&bar[XB_TOPGEN]) == tg, bar);
            __builtin_amdgcn_fence(__ATOMIC_ACQUIRE, "agent");
            xb_add(&bar[XB_XGEN(b.x)], 1u);
            asm volatile("s_waitcnt vmcnt(0)" ::: "memory");
        } else {
            XB_SPIN(xb_ld(&bar[XB_XGEN(b.x)]) == gen, bar);
            __builtin_amdgcn_fence(__ATOMIC_ACQUIRE, "agent");
            asm volatile("s_waitcnt vmcnt(0)" ::: "memory");
        }
    }
    __syncthreads();
}


constexpr int RING_BYTES = 131072;
constexpr int MISC_OFF = RING_BYTES;
constexpr int LDS_BYTES = 147456;

__device__ __forceinline__ float rstd_of(u64 ssq) { return rsqrtf((float)ssq * (SS_INV / D) + EPS); }
constexpr bool gu8(int seg) { return seg >= 0 && seg < 4 && ((GU8_MASK >> seg) & 1); }
constexpr bool gui8(int seg) { return GU_I8 != 0 && seg == 0; }
constexpr int CW_WMAX = 8;
constexpr size_t TAB_PX = 131072;
constexpr size_t TAB_XS = 32768;
constexpr bool wini8(int l) { return l >= 0 && l < 2 && ((WIN_I8 >> l) & 1); }
constexpr bool dn8(int seg) { return seg >= 0 && seg < 4 && ((DN8_MASK >> seg) & 1); }
constexpr float H8_SCALE = 16.0f, DN8_UNSCALE = 1.0f / (16.0f * 256.0f);
constexpr float X8_SCALE = 16.0f, W8_SCALE = 256.0f, GU8_UNSCALE = 1.0f / (16.0f * 256.0f);
__device__ __forceinline__ float sat8(float v) { return __builtin_amdgcn_fmed3f(v, -448.0f, 448.0f); }
__device__ __forceinline__ unsigned pk4_fp8(float a, float b, float c, float d) { int w = 0; w = __builtin_amdgcn_cvt_pk_fp8_f32(sat8(a), sat8(b), w, false); w = __builtin_amdgcn_cvt_pk_fp8_f32(sat8(c), sat8(d), w, true); return (unsigned)w; }
__device__ __forceinline__ size_t kfrag_off(int t, int d0) { return ((size_t)((t >> 5) * 4 + (d0 >> 4)) * 64 + 32 * ((d0 >> 3) & 1) + (t & 31)) * 8; }
__device__ __forceinline__ size_t vfrag_off(int t, int d) { const int q = t & 15; return ((size_t)(((t >> 5) * 2 + (d >> 5)) * 2 + ((t >> 4) & 1)) * 64 + 32 * ((q >> 2) & 1) + (d & 31)) * 8 + 4 * (q >> 3) + (q & 3); }
struct EpiGateUp {
    static constexpr bool PERM = true, AFTER_DRAIN = false;
    bf16* H; const u64* ss; float unscale; int h8; const float* xs; int i8;
    __device__ __forceinline__ void operator()(const f32x4 (&acc)[2][2][4][2], const pg8::Unit& u, int wr, int wc, int fr, int fq) const {
        const int row0 = u.pm * 256 + wr * 64 + fr, hcol = u.pn * 128 + wc * 32 + 8 * fq;
#pragma unroll
        for (int ai = 0; ai < 2; ++ai)
#pragma unroll
            for (int m = 0; m < 4; ++m) {
                const int row = row0 + ai * 128 + m * 16;
                float r = rstd_of(ss[row]) * unscale;
                if (i8) r *= xs[row];
                float h[8];
#pragma unroll
                for (int n = 0; n < 2; ++n)
#pragma unroll
                    for (int j = 0; j < 4; ++j) {
                        const float gf = acc[ai][0][m][n][j], uf = acc[ai][1][m][n][j];
                        const float ga = i8 ? (float)__float_as_int(gf) : gf, ua = i8 ? (float)__float_as_int(uf) : uf;
                        const float g = ga * r, uu = ua * r; h[n * 4 + j] = silu_f(g) * uu; }
                if (h8) { v2u w8; w8.x = pk4_fp8(h[0] * H8_SCALE, h[1] * H8_SCALE, h[2] * H8_SCALE, h[3] * H8_SCALE); w8.y = pk4_fp8(h[4] * H8_SCALE, h[5] * H8_SCALE, h[6] * H8_SCALE, h[7] * H8_SCALE);
                    *(v2u*)((unsigned char*)H + (size_t)row * FF + hcol) = w8; }
                else { v4u w; w.x = pk2(h[0], h[1]); w.y = pk2(h[2], h[3]); w.z = pk2(h[4], h[5]); w.w = pk2(h[6], h[7]);
                    *(v4u*)(H + (size_t)row * FF + hcol) = w; }
            }
    }
};
struct EpiResid {
    static constexpr bool PERM = true, AFTER_DRAIN = false;
    const float* xin; float* xout; bf16* xb; u64* ss_out; float alpha; int out8;
    __device__ __forceinline__ void operator()(const f32x4 (&acc)[2][2][4][2], const pg8::Unit& u, int wr, int wc, int fr, int fq) const {
        const int row0 = u.pm * 256 + wr * 64 + fr, col0 = u.pn * 256 + wc * 32 + 8 * fq;
#pragma unroll
        for (int ai = 0; ai < 2; ++ai)
#pragma unroll
            for (int m = 0; m < 4; ++m) {
                const int row = row0 + ai * 128 + m * 16;
                float s = 0.f;
#pragma unroll
                for (int bj = 0; bj < 2; ++bj) {
                    const size_t off = (size_t)row * D + col0 + bj * 128;
                    const f32x4 x0 = *(const f32x4*)(xin + off), x1 = *(const f32x4*)(xin + off + 4);
                    const f32x4 y0 = x0 + acc[ai][bj][m][0] * alpha, y1 = x1 + acc[ai][bj][m][1] * alpha;
                    *(f32x4*)(xout + off) = y0; *(f32x4*)(xout + off + 4) = y1;
                    if (out8 == 2) { }
                    else if (out8) { v2u w8; w8.x = pk4_fp8(y0[0] * X8_SCALE, y0[1] * X8_SCALE, y0[2] * X8_SCALE, y0[3] * X8_SCALE); w8.y = pk4_fp8(y1[0] * X8_SCALE, y1[1] * X8_SCALE, y1[2] * X8_SCALE, y1[3] * X8_SCALE);
                        *(v2u*)((unsigned char*)xb + off) = w8; }
                    else { v4u w; w.x = pk2(y0[0], y0[1]); w.y = pk2(y0[2], y0[3]); w.z = pk2(y1[0], y1[1]); w.w = pk2(y1[2], y1[3]);
                        *(v4u*)(xb + off) = w; }
                    s += (y0[0] * y0[0] + y0[1] * y0[1]) + (y0[2] * y0[2] + y0[3] * y0[3]) + (y1[0] * y1[0] + y1[1] * y1[1]) + (y1[2] * y1[2] + y1[3] * y1[3]);
                }
                s += __shfl_xor(s, 16); s += __shfl_xor(s, 32);
                if (fq == 0) atomicAdd(ss_out + row, (u64)(s * SS_SCALE + 0.5f));
                asm volatile("" ::: "memory");
            }
    }
};
struct PanelX {
    float* slots;
    unsigned* cnt;
    template <int OP  >
    __device__ __forceinline__ void run(const float (&part)[2][4], const pg8::Unit& u, int wr, int wc, int fr, int fq, PG8_LAS unsigned char* lds) const {
        PG8_LAS float* P = (PG8_LAS float*)lds;
        PG8_LAS float* S = (PG8_LAS float*)(lds + 8192);
        int tid = threadIdx.x; asm volatile("" : "+v"(tid));
        const int wid = __builtin_amdgcn_readfirstlane(tid >> 6), lane = tid & 63;
        if (fq == 0) {
#pragma unroll
            for (int ai = 0; ai < 2; ++ai)
#pragma unroll
                for (int m = 0; m < 4; ++m) P[(ai * 128 + wr * 64 + m * 16 + fr) * 4 + wc] = part[ai][m];
        }
        asm volatile("s_waitcnt lgkmcnt(0)" ::: "memory"); __builtin_amdgcn_s_barrier(); asm volatile("" ::: "memory");
        const int row = wid * 32 + (lane & 31);
        if (lane < 32) {
            const float a = P[row * 4 + 0], b = P[row * 4 + 1], c = P[row * 4 + 2], d = P[row * 4 + 3];
            const float v = OP == 0 ? (a + b) + (c + d) : fmaxf(fmaxf(a, b), fmaxf(c, d));
            __hip_atomic_store((unsigned*)slots + (size_t)(u.pm * 256 + row) * 8 + u.pn, __float_as_uint(v), __ATOMIC_RELAXED, __HIP_MEMORY_SCOPE_AGENT);
        }
        asm volatile("s_waitcnt vmcnt(0)" ::: "memory");
        if (lane == 0) __hip_atomic_fetch_add(cnt + 64 * u.pm, 1u, __ATOMIC_RELAXED, __HIP_MEMORY_SCOPE_AGENT);
        if (wid == 0) {
            unsigned sp = 0u;
            while ((unsigned)__builtin_amdgcn_readfirstlane((int)__hip_atomic_load(cnt + 64 * u.pm, __ATOMIC_RELAXED, __HIP_MEMORY_SCOPE_AGENT)) < 64u) { __builtin_amdgcn_s_sleep(2); if (++sp > (1u << 22)) break; }
            __builtin_amdgcn_fence(__ATOMIC_ACQUIRE, "agent");
        }
        asm volatile("s_waitcnt vmcnt(0) lgkmcnt(0)" ::: "memory"); __builtin_amdgcn_s_barrier(); asm volatile("" ::: "memory");
        if (lane < 32) {
            const unsigned* sl = (const unsigned*)slots + (size_t)(u.pm * 256 + row) * 8;
            float t[8];
#pragma unroll
            for (int q = 0; q < 8; ++q) t[q] = __uint_as_float(__hip_atomic_load(sl + q, __ATOMIC_RELAXED, __HIP_MEMORY_SCOPE_AGENT));
            S[row] = OP == 0 ? ((t[0] + t[1]) + (t[2] + t[3])) + ((t[4] + t[5]) + (t[6] + t[7])) : fmaxf(fmaxf(fmaxf(t[0], t[1]), fmaxf(t[2], t[3])), fmaxf(fmaxf(t[4], t[5]), fmaxf(t[6], t[7])));
        }
        asm volatile("s_waitcnt lgkmcnt(0)" ::: "memory"); __builtin_amdgcn_s_barrier(); asm volatile("" ::: "memory");
    }
};
__device__ __forceinline__ unsigned pk4_i8(float a, float b, float c, float d);
struct EpiResidFin {
    static constexpr bool PERM = true, AFTER_DRAIN = true;
    const float* xin; float* out; const float* gain; float alpha; PanelX px;
    __device__ __forceinline__ void fused(f32x4 (&acc)[2][2][4][2], const pg8::Unit& u, int wr, int wc, int fr, int fq, PG8_LAS unsigned char* lds) const {
        const int row0 = u.pm * 256 + wr * 64 + fr, col0 = u.pn * 256 + wc * 32 + 8 * fq;
        float part[2][4];
#pragma unroll
        for (int ai = 0; ai < 2; ++ai)
#pragma unroll
            for (int m = 0; m < 4; ++m) {
                const int row = row0 + ai * 128 + m * 16;
                float s = 0.f;
#pragma unroll
                for (int bj = 0; bj < 2; ++bj) {
                    const size_t off = (size_t)row * D + col0 + bj * 128;
                    const f32x4 x0 = *(const f32x4*)(xin + off), x1 = *(const f32x4*)(xin + off + 4);
                    const f32x4 y0 = x0 + acc[ai][bj][m][0] * alpha, y1 = x1 + acc[ai][bj][m][1] * alpha;
                    acc[ai][bj][m][0] = y0; acc[ai][bj][m][1] = y1;
                    s += (y0[0] * y0[0] + y0[1] * y0[1]) + (y0[2] * y0[2] + y0[3] * y0[3]) + (y1[0] * y1[0] + y1[1] * y1[1]) + (y1[2] * y1[2] + y1[3] * y1[3]);
                }
                s += __shfl_xor(s, 16); s += __shfl_xor(s, 32);
                part[ai][m] = s;
                asm volatile("" : "+v"(acc[ai][0][m][0]), "+v"(acc[ai][0][m][1]), "+v"(acc[ai][1][m][0]), "+v"(acc[ai][1][m][1]));
            }
        px.run<0>(part, u, wr, wc, fr, fq, lds);
        const PG8_LAS float* S = (const PG8_LAS float*)(lds + 8192);
        f32x4 g[2][2];
#pragma unroll
        for (int bj = 0; bj < 2; ++bj) { g[bj][0] = *(const f32x4*)(gain + col0 + bj * 128); g[bj][1] = *(const f32x4*)(gain + col0 + bj * 128 + 4); }
#pragma unroll
        for (int ai = 0; ai < 2; ++ai)
#pragma unroll
            for (int m = 0; m < 4; ++m) {
                const int rl = ai * 128 + wr * 64 + m * 16 + fr, row = u.pm * 256 + rl;
                const float r = rsqrtf(S[rl] * (1.0f / D) + EPS);
#pragma unroll
                for (int bj = 0; bj < 2; ++bj) {
                    const size_t off = (size_t)row * D + col0 + bj * 128;
                    *(f32x4*)(out + off) = acc[ai][bj][m][0] * r * g[bj][0]; *(f32x4*)(out + off + 4) = acc[ai][bj][m][1] * r * g[bj][1];
                }
            }
    }
};
struct EpiResidQ8 {
    static constexpr bool PERM = true, AFTER_DRAIN = true;
    const float* xin; float* xout; unsigned char* xb8; float* xs; u64* ss_out; float alpha; PanelX px;
    __device__ __forceinline__ void fused(f32x4 (&acc)[2][2][4][2], const pg8::Unit& u, int wr, int wc, int fr, int fq, PG8_LAS unsigned char* lds) const {
        const int row0 = u.pm * 256 + wr * 64 + fr, col0 = u.pn * 256 + wc * 32 + 8 * fq;
        float part[2][4];
#pragma unroll
        for (int ai = 0; ai < 2; ++ai)
#pragma unroll
            for (int m = 0; m < 4; ++m) {
                const int row = row0 + ai * 128 + m * 16;
                float s = 0.f, mx = 0.f;
#pragma unroll
                for (int bj = 0; bj < 2; ++bj) {
                    const size_t off = (size_t)row * D + col0 + bj * 128;
                    const f32x4 x0 = *(const f32x4*)(xin + off), x1 = *(const f32x4*)(xin + off + 4);
                    const f32x4 y0 = x0 + acc[ai][bj][m][0] * alpha, y1 = x1 + acc[ai][bj][m][1] * alpha;
                    acc[ai][bj][m][0] = y0; acc[ai][bj][m][1] = y1;
                    *(f32x4*)(xout + off) = y0; *(f32x4*)(xout + off + 4) = y1;
                    s += (y0[0] * y0[0] + y0[1] * y0[1]) + (y0[2] * y0[2] + y0[3] * y0[3]) + (y1[0] * y1[0] + y1[1] * y1[1]) + (y1[2] * y1[2] + y1[3] * y1[3]);
                    mx = fmaxf(fmaxf(fmaxf(mx, fmaxf(fabsf(y0[0]), fabsf(y0[1]))), fmaxf(fabsf(y0[2]), fabsf(y0[3]))), fmaxf(fmaxf(fabsf(y1[0]), fabsf(y1[1])), fmaxf(fabsf(y1[2]), fabsf(y1[3]))));
                }
                s += __shfl_xor(s, 16); s += __shfl_xor(s, 32);
                mx = fmaxf(mx, __shfl_xor(mx, 16)); mx = fmaxf(mx, __shfl_xor(mx, 32));
                if (fq == 0) atomicAdd(ss_out + row, (u64)(s * SS_SCALE + 0.5f));
                part[ai][m] = mx;
                asm volatile("" : "+v"(acc[ai][0][m][0]), "+v"(acc[ai][0][m][1]), "+v"(acc[ai][1][m][0]), "+v"(acc[ai][1][m][1]) :: "memory");
            }
        px.run<1>(part, u, wr, wc, fr, fq, lds);
        const PG8_LAS float* S = (const PG8_LAS float*)(lds + 8192);
        if (u.pn == 0) { int tid = threadIdx.x; asm volatile("" : "+v"(tid)); if (tid < 256) xs[u.pm * 256 + tid] = fmaxf(S[tid], 1e-30f) * (1.0f / 127.0f); }
#pragma unroll
        for (int ai = 0; ai < 2; ++ai)
#pragma unroll
            for (int m = 0; m < 4; ++m) {
                const int rl = ai * 128 + wr * 64 + m * 16 + fr, row = u.pm * 256 + rl;
                const float inv = 127.0f / fmaxf(S[rl], 1e-30f);
#pragma unroll
                for (int bj = 0; bj < 2; ++bj) {
                    const f32x4 y0 = acc[ai][bj][m][0] * inv, y1 = acc[ai][bj][m][1] * inv;
                    v2u w8; w8.x = pk4_i8(y0[0], y0[1], y0[2], y0[3]); w8.y = pk4_i8(y1[0], y1[1], y1[2], y1[3]);
                    *(v2u*)(xb8 + (size_t)row * D + col0 + bj * 128) = w8;
                }
            }
    }
};
struct EpiWin {
    static constexpr bool PERM = true, AFTER_DRAIN = false;
    unsigned char* R; const u64* ss; const float* xs; float wsc; int i8;
    __device__ __forceinline__ void operator()(const f32x4 (&acc)[2][2][4][2], const pg8::Unit& u, int wr, int wc, int fr, int fq) const {
        const int row0 = u.pm * 256 + wr * 64 + fr;
        const int pn = u.pn;
        unsigned off = 0u; int ld = 0, cbase = 0, cls = 0, hbase = 0, nh = 0; float sc = 1.f;
        if (pn < 2)       { off = (unsigned)R_QN; ld = 512; cbase = pn * 256; sc = QSCALE; }
        else if (pn < 4)  { off = (unsigned)R_QS; ld = 512; cbase = (pn - 2) * 256; sc = QSCALE; }
        else if (pn < 6)  { cls = 4; off = (unsigned)R_KS; hbase = (pn - 4) * 4; nh = 8; }
        else if (pn == 6) { cls = 4; off = (unsigned)R_KN; hbase = 0; nh = 4; }
        else if (pn == 7) { cls = 1; off = (unsigned)R_CMPRAW; }
        else if (pn == 8) { cls = 2; off = (unsigned)R_VNT; hbase = 0; nh = 4; }
        else if (pn < 11) { cls = 2; off = (unsigned)R_VST; hbase = (pn - 9) * 4; nh = 8; }
        else if (pn < 15) { off = (unsigned)R_Z; ld = 1024; cbase = (pn - 11) * 256; }
        else if (pn < 21) { off = (unsigned)R_XBC; ld = 1536; cbase = (pn - 15) * 256; }
        else              { cls = 3; off = (unsigned)R_DTG; }
        unsigned char* const dst = R + off;
#pragma unroll
        for (int ai = 0; ai < 2; ++ai)
#pragma unroll
            for (int m = 0; m < 4; ++m) {
                const int row = row0 + ai * 128 + m * 16;
                float r = rstd_of(ss[row]) * sc;
                if (i8) r *= xs[row] * wsc;
#pragma unroll
                for (int bj = 0; bj < 2; ++bj) {
                    const int col = bj * 128 + wc * 32 + 8 * fq;
                    float v[8];
#pragma unroll
                    for (int n = 0; n < 2; ++n)
#pragma unroll
                        for (int j = 0; j < 4; ++j) { const float af = acc[ai][bj][m][n][j]; v[n * 4 + j] = (i8 ? (float)__float_as_int(af) : af) * r; }
                    if (cls == 0) {
                        v4u w; w.x = pk2(v[0], v[1]); w.y = pk2(v[2], v[3]); w.z = pk2(v[4], v[5]); w.w = pk2(v[6], v[7]);
                        *(v4u*)((bf16*)dst + (size_t)row * ld + cbase + col) = w;
                    } else if (cls == 1) {
                        v4u w; w.x = pk2(v[0], v[1]); w.y = pk2(v[2], v[3]); w.z = pk2(v[4], v[5]); w.w = pk2(v[6], v[7]);
                        const int seg = col >> 6, d0 = col & 63, b = row / T, t = row % T, c1 = t >> 4, l1 = t & 15;
                        bf16* base = (bf16*)dst + (size_t)(seg * 4 + b) * (4 * 128 * 512);
                        *(v4u*)(base + ((size_t)((c1 >> 5) * 128 + 4 * l1 + (d0 >> 4)) * 64 + 32 * ((d0 >> 3) & 1) + (c1 & 31)) * 8) = w;
                        if (c1 > 0) { const int c0 = c1 - 1, l0 = l1 + 16;
                            *(v4u*)(base + ((size_t)((c0 >> 5) * 128 + 4 * l0 + (d0 >> 4)) * 64 + 32 * ((d0 >> 3) & 1) + (c0 & 31)) * 8) = w; }
                    } else if (cls == 4) {
                        v4u w; w.x = pk2(v[0], v[1]); w.y = pk2(v[2], v[3]); w.z = pk2(v[4], v[5]); w.w = pk2(v[6], v[7]);
                        const int b = row / T, t = row % T, hs = hbase + (col >> 6), d0 = col & 63;
                        *(v4u*)((bf16*)dst + (size_t)(b * nh + hs) * (T * 64) + kfrag_off(t, d0)) = w;
                    } else if (cls == 2) {
                        const int b = row / T, t = row % T, hs = hbase + (col >> 6), d0 = col & 63;
                        bf16* tp = (bf16*)dst + (size_t)(b * nh + hs) * (T * 64) + vfrag_off(t, d0);
#pragma unroll
                        for (int j = 0; j < 8; ++j) tp[8 * j] = (bf16)f2bf(v[j]);
                    } else {
                        if (col < 64) { float* o = (float*)dst + (size_t)row * 64 + col; *(f32x4*)o = (f32x4){v[0], v[1], v[2], v[3]}; *(f32x4*)(o + 4) = (f32x4){v[4], v[5], v[6], v[7]}; }
                    }
                }
            }
    }
};

struct Args { const float* in[24]; float* out; unsigned char* ws; int ph_lo, ph_hi; };
struct Frame {
    unsigned char* lds; int tid, lane, wave, vcu, G;
    float* out; unsigned char* ws; unsigned char* R; float* ctlf;
};
__device__ __forceinline__ bf16* wptr(const Frame& F, int layer, size_t off) { return (bf16*)(F.ws + WS_W + (size_t)layer * WL_SIZE + off); }
__device__ __forceinline__ u64* ssptr(const Frame& F, int i) { return (u64*)(F.ctlf + CW_SS) + (size_t)i * M; }
typedef const __attribute__((address_space(4))) Args* KArgs;
__device__ __forceinline__ KArgs kargs() { KArgs p = (KArgs)__builtin_amdgcn_kernarg_segment_ptr(); asm volatile("" : "+s"(p)); return p; }
__device__ __forceinline__ Frame make_frame(unsigned char* ws, float* out, unsigned char* lds) {
    int tid = threadIdx.x, vcu = blockIdx.x, G = gridDim.x; asm volatile("" : "+v"(tid), "+s"(vcu), "+s"(G));
    Frame F; F.lds = lds; F.tid = tid; F.lane = F.tid & 63; F.wave = __builtin_amdgcn_readfirstlane(F.tid >> 6); F.G = G; F.vcu = vcu;
    F.out = out; F.ws = ws; F.R = ws + WS_R; F.ctlf = (float*)(ws + WS_CTL); return F;
}

__device__ __forceinline__ int win_src_col(int n) {
    if (n < 512) return n;
    if (n < 1024) return 1304 + (n - 512);
    if (n < 1536) return 1304 + 512 + (n - 1024);
    if (n < 2304) {
        const int tile = (n - 1536) >> 8, i = (n - 1536) & 255, seg = i >> 6, d = i & 63;
        int branch, kv, hk;
        if (tile == 0) { branch = 1 + (seg >> 1); kv = 0; hk = seg & 1; }
        else if (tile == 1) { branch = 0; kv = seg >> 1; hk = seg & 1; }
        else { branch = 1 + (seg >> 1); kv = 1; hk = seg & 1; }
        return 512 + ((branch * 2 + kv) * 2 + hk) * 64 + d;
    }
    if (n < 2816) return 1304 + 1024 + (n - 2304);
    if (n < 3840) return 2840 + (n - 2816);
    if (n < 5376) return 3864 + (n - 3840);
    const int i = n - 5376;
    if (i < 16) return 5400 + i;
    if (i < 40) return 1280 + (i - 16);
    return -1;
}
template <bool FRAG>
__device__ __forceinline__ void transpose_item(const float* W, int ldw, int srccol, const float* gain, bf16* WT, int K, int n0, int k0, float* scr, int lane) {
#pragma unroll 8
    for (int i = 0; i < 32; ++i) { const int kk = 2 * i + (lane >> 5);
        float v = 0.f; if (srccol >= 0) v = W[(size_t)(k0 + kk) * ldw + srccol]; if (gain) v *= gain[k0 + kk];
        scr[kk * 33 + (lane & 31)] = v; }
    __builtin_amdgcn_wave_barrier(); LDS_WAIT();
    const int c = lane & 7;
#pragma unroll
    for (int j = 0; j < 4; ++j) { const int n = (lane >> 3) + 8 * j; const float* s = scr + (8 * c) * 33 + n;
        v4u o; o.x = pk2(s[0 * 33], s[1 * 33]); o.y = pk2(s[2 * 33], s[3 * 33]); o.z = pk2(s[4 * 33], s[5 * 33]); o.w = pk2(s[6 * 33], s[7 * 33]);
        if (FRAG) { const int nn = n0 + n, k8 = k0 + 8 * c; *(v4u*)(WT + ((size_t)((nn >> 5) * (K / 16) + (k8 >> 4)) * 64 + 32 * ((k8 >> 3) & 1) + (nn & 31)) * 8) = o; }
        else *(v4u*)(WT + (size_t)(n0 + n) * K + k0 + 8 * c) = o; }
    __builtin_amdgcn_wave_barrier(); LDS_WAIT();
}
template <int MODE>
__device__ __forceinline__ void transpose_item4(const float* W0, const float* W1, int ldw, const float* gain, bf16* WT, int K, int n0, int k0, int lane) {
    const int kc = lane & 3, ng = lane >> 2;
#pragma unroll 1
    for (int sub = 0; sub < 4; ++sub) {
        const int nn = n0 + 64 * sub + 4 * ng;
        const float* W = W0; int col = nn;
        if (MODE == 1) { W = ((nn & 255) >= 128) ? W1 : W0; col = (nn >> 8) * 128 + (nn & 127); }
        if (MODE == 2) col = win_src_col(nn);
#pragma unroll
        for (int ks = 0; ks < 2; ++ks) {
            const int kk = k0 + 32 * ks + 8 * kc;
            const float* src = W + (size_t)kk * ldw + (col >= 0 ? col : 0);
            f32x4 v[8];
#pragma unroll
            for (int i = 0; i < 8; ++i) v[i] = *(const f32x4*)(src + (size_t)i * ldw) * (gain ? gain[kk + i] : 1.0f);
            if (MODE == 2 && col < 0) {
#pragma unroll
                for (int i = 0; i < 8; ++i) v[i] = (f32x4){0.f, 0.f, 0.f, 0.f};
            }
            bf16* drow = WT + (size_t)nn * K + kk;
#pragma unroll
            for (int j = 0; j < 4; ++j) { v4u o; o.x = pk2(v[0][j], v[1][j]); o.y = pk2(v[2][j], v[3][j]); o.z = pk2(v[4][j], v[5][j]); o.w = pk2(v[6][j], v[7][j]);
                *(v4u*)(drow + (size_t)j * K) = o; }
        }
    }
}
__device__ __forceinline__ unsigned pk4_i8(float a, float b, float c, float d) {
    const int ia = __float2int_rn(__builtin_amdgcn_fmed3f(a, -127.f, 127.f)), ib = __float2int_rn(__builtin_amdgcn_fmed3f(b, -127.f, 127.f)), ic = __float2int_rn(__builtin_amdgcn_fmed3f(c, -127.f, 127.f)), id = __float2int_rn(__builtin_amdgcn_fmed3f(d, -127.f, 127.f));
    return (unsigned)(ia & 0xff) | ((unsigned)(ib & 0xff) << 8) | ((unsigned)(ic & 0xff) << 16) | ((unsigned)id << 24);
}
template <int MODE, bool I8 = false>
__device__ __forceinline__ void transpose_item_8(const float* W0, const float* W1, int ldw, const float* gain, unsigned char* WT, int K, int n0, int k0, int lane, float wsc = W8_SCALE) {
    const int kc = lane & 3, ng = lane >> 2;
#pragma unroll 1
    for (int sub = 0; sub < 4; ++sub) {
        const int nn = n0 + 64 * sub + 4 * ng;
        const float* W = W0; int col = nn;
        if (MODE == 1) { W = ((nn & 255) >= 128) ? W1 : W0; col = (nn >> 8) * 128 + (nn & 127); }
        if (MODE == 2) col = win_src_col(nn);
#pragma unroll 1
        for (int ks = 0; ks < 2; ++ks) {
            const int kk = k0 + 64 * ks + 16 * kc;
            const float* src = W + (size_t)kk * ldw + (col >= 0 ? col : 0);
            f32x4 v[16];
#pragma unroll
            for (int i = 0; i < 16; ++i) v[i] = *(const f32x4*)(src + (size_t)i * ldw) * ((gain ? gain[kk + i] : 1.0f) * wsc);
            if (MODE == 2 && col < 0) {
#pragma unroll
                for (int i = 0; i < 16; ++i) v[i] = (f32x4){0.f, 0.f, 0.f, 0.f};
            }
            unsigned char* drow = WT + (size_t)nn * K + kk;
#pragma unroll
            for (int j = 0; j < 4; ++j) { v4u o;
                if (I8) { o.x = pk4_i8(v[0][j], v[1][j], v[2][j], v[3][j]); o.y = pk4_i8(v[4][j], v[5][j], v[6][j], v[7][j]); o.z = pk4_i8(v[8][j], v[9][j], v[10][j], v[11][j]); o.w = pk4_i8(v[12][j], v[13][j], v[14][j], v[15][j]); }
                else { o.x = pk4_fp8(v[0][j], v[1][j], v[2][j], v[3][j]); o.y = pk4_fp8(v[4][j], v[5][j], v[6][j], v[7][j]); o.z = pk4_fp8(v[8][j], v[9][j], v[10][j], v[11][j]); o.w = pk4_fp8(v[12][j], v[13][j], v[14][j], v[15][j]); }
                *(v4u*)(drow + (size_t)j * K) = o; }
        }
    }
}
__device__ __forceinline__ int t5_bucket(int dist) {
    if (dist < 16) return dist;
    return 16 + (dist >= 19) + (dist >= 21) + (dist >= 24) + (dist >= 27) + (dist >= 31) + (dist >= 35) + (dist >= 40) + (dist >= 46) + (dist >= 52) + (dist >= 59)
              + (dist >= 67) + (dist >= 77) + (dist >= 87) + (dist >= 99) + (dist >= 113);
}
struct ProIn { const float *x, *relb, *n1, *g1, *u1, *d1, *nm, *win, *wout, *nnsa, *nsb, *nssd, *n2, *g2, *u2, *d2, *cpos, *cw; };
constexpr unsigned CV_GU(int sg) { return 1u << sg; }
constexpr unsigned CV_DN(int sg) { return 16u << sg; }
constexpr unsigned CV_IN(int l) { return 256u << l; }
constexpr unsigned CV_OUT(int l) { return 1024u << l; }
template <unsigned MASK>
__device__ __forceinline__ void convert_weights(Frame& F, const ProIn I, int gw, int NGW) {
    const int lane = F.lane;
    constexpr int I_GU8 = (D / 128) * (NGU / 256), I_GU16 = (D / 64) * (NGU / 256), I_DN16 = (FF / 64) * (D / 256), I_DN8 = (FF / 128) * (D / 256), I_IN16 = (D / 64) * (NIN / 256), I_IN8 = (D / 128) * (NIN / 256), I_OUT = (D / 64) * (D / 256);
    constexpr int C_GU[4] = {(MASK & 1u) ? ((gu8(0) || gui8(0)) ? I_GU8 : I_GU16) : 0, (MASK & 2u) ? (gu8(1) ? I_GU8 : I_GU16) : 0, (MASK & 4u) ? (gu8(2) ? I_GU8 : I_GU16) : 0, (MASK & 8u) ? (gu8(3) ? I_GU8 : I_GU16) : 0};
    constexpr int C_DN[4] = {(MASK & 16u) ? (dn8(0) ? I_DN8 : I_DN16) : 0, (MASK & 32u) ? (dn8(1) ? I_DN8 : I_DN16) : 0, (MASK & 64u) ? (dn8(2) ? I_DN8 : I_DN16) : 0, (MASK & 128u) ? (dn8(3) ? I_DN8 : I_DN16) : 0};
    constexpr int C_IN[2] = {(MASK & 256u) ? (wini8(0) ? I_IN8 : I_IN16) : 0, (MASK & 512u) ? (wini8(1) ? I_IN8 : I_IN16) : 0};
    constexpr int C_OUT[2] = {(MASK & 1024u) ? I_OUT : 0, (MASK & 2048u) ? I_OUT : 0};
    constexpr int I_ALL = C_GU[0] + C_GU[1] + C_GU[2] + C_GU[3] + C_DN[0] + C_DN[1] + C_DN[2] + C_DN[3] + C_IN[0] + C_IN[1] + C_OUT[0] + C_OUT[1];
    for (int it = gw; it < I_ALL; it += NGW) {
        int r = it; bool done = false;
#pragma unroll
        for (int sg = 0; sg < 4; ++sg) {
            if (C_GU[sg] > 0 && !done && r < C_GU[sg]) {
                const int l = sg >> 1, f = sg & 1;
                const int nb = r % (NGU / 256), kb = r / (NGU / 256), n0 = nb * 256;
                const float* gain = (f == 0 ? I.n1 : I.n2) + (size_t)l * D;
                const float* Wg = (f == 0 ? I.g1 : I.g2) + (size_t)l * D * FF; const float* Wu = (f == 0 ? I.u1 : I.u2) + (size_t)l * D * FF;
                if (gui8(sg)) { const float wmax = __uint_as_float(((const unsigned*)F.ctlf)[CW_WMAX]);
                    transpose_item_8<1, true>(Wg, Wu, FF, gain, (unsigned char*)wptr(F, l, f == 0 ? WL_GU1 : WL_GU2), D, n0, kb * 128, lane, 127.0f / wmax); }
                else if (gu8(sg)) transpose_item_8<1>(Wg, Wu, FF, gain, (unsigned char*)wptr(F, l, f == 0 ? WL_GU1 : WL_GU2), D, n0, kb * 128, lane);
                else transpose_item4<1>(Wg, Wu, FF, gain, wptr(F, l, f == 0 ? WL_GU1 : WL_GU2), D, n0, kb * 64, lane);
                done = true;
            }
            if (!done) r -= C_GU[sg];
        }
        if (done) continue;
#pragma unroll
        for (int sg = 0; sg < 4; ++sg) {
            if (C_DN[sg] > 0 && !done && r < C_DN[sg]) {
                const int l = sg >> 1, f = sg & 1;
                const int nb = r % (D / 256), kb = r / (D / 256), n0 = nb * 256;
                const float* W = (f == 0 ? I.d1 : I.d2) + (size_t)l * FF * D;
                if (dn8(sg)) transpose_item_8<0>(W, W, D, nullptr, (unsigned char*)wptr(F, l, f == 0 ? WL_DN1 : WL_DN2), FF, n0, kb * 128, lane);
                else transpose_item4<0>(W, W, D, nullptr, wptr(F, l, f == 0 ? WL_DN1 : WL_DN2), FF, n0, kb * 64, lane);
                done = true;
            }
            if (!done) r -= C_DN[sg];
        }
        if (done) continue;
#pragma unroll
        for (int l = 0; l < 2; ++l) {
            if (C_IN[l] > 0 && !done && r < C_IN[l]) {
                const int nb = r % (NIN / 256), kb = r / (NIN / 256), n0 = nb * 256, k0 = kb * 64;
                const float* W = I.win + (size_t)l * D * NIN_SRC;
                if (wini8(l)) { const float wmax = __uint_as_float(((const unsigned*)F.ctlf)[CW_WMAX + 1 + l]);
                    transpose_item_8<2, true>(W, W, NIN_SRC, I.nm + (size_t)l * D, (unsigned char*)wptr(F, l, WL_IN), D, n0, kb * 128, lane, 127.0f / wmax); }
                else transpose_item4<2>(W, W, NIN_SRC, I.nm + (size_t)l * D, wptr(F, l, WL_IN), D, n0, k0, lane);
                done = true;
            }
            if (!done) r -= C_IN[l];
        }
        if (done) continue;
#pragma unroll
        for (int l = 0; l < 2; ++l) {
            if (C_OUT[l] > 0 && !done && r < C_OUT[l]) {
                const int nb = r % (D / 256), kb = r / (D / 256), n0 = nb * 256, k0 = kb * 64;
                const float* W = I.wout + (size_t)l * D * D;
                const float* gbase = (k0 < 512) ? I.nnsa + (size_t)l * 512 : (k0 < 1024) ? I.nsb + (size_t)l * 512 - 512 : I.nssd + (size_t)l * 1024 - 1024;
                transpose_item4<0>(W, W, D, gbase, wptr(F, l, WL_OUT), D, n0, k0, lane);
                done = true;
            }
            if (!done) r -= C_OUT[l];
        }
    }
}
constexpr unsigned CVM_PRO = 0xFFFu;
constexpr unsigned CVM_GU[4] = {0u, 0u, 0u, 0u};
constexpr unsigned CVM_WIN[2] = {0u, 0u};
static_assert((CVM_PRO | CVM_GU[0] | CVM_GU[1] | CVM_GU[2] | CVM_GU[3] | CVM_WIN[0] | CVM_WIN[1]) == 0xFFFu, "every matrix converted exactly once");
#ifndef COOP_CVT
#define COOP_CVT 1
#endif
constexpr bool COOP_OK = COOP_CVT && GU_I8 && GU8_MASK == 0xE && DN8_MASK == 0xF && (WIN_I8 & ~2) == 0;
struct CvtStep { const float* src; const float* gain; unsigned char* dst; float wsc; int ldw, K, i8, valid, b16; };
constexpr int CS_INB = (D / 64) * (NIN / 256), CS_OUT = (D / 64) * (D / 256);
constexpr int CS_GU = (D / 128) * (NGU / 256), CS_DN = (FF / 128) * (D / 256), CS_IN = (D / 128) * (NIN / 256);
constexpr int CS_ONE = 4 * CS_GU + 4 * CS_DN + (wini8(1) ? CS_IN : 0);
constexpr int CS_ALL = CS_ONE + (wini8(0) ? 0 : CS_INB) + (wini8(1) ? 0 : CS_INB) + 2 * CS_OUT;
__device__ __forceinline__ CvtStep cvt_decode(const Frame& F, const float* Ig1, const float* Iu1, const float* Id1, const float* Ig2, const float* Iu2, const float* Id2, const float* In1, const float* In2, const float* Inm, const float* Iwin,
                                              const float* Iwout, const float* Innsa, const float* Insb, const float* Inssd, int r, int wave, int lane) {
    CvtStep c; c.valid = 1; c.i8 = 0; c.b16 = 0; c.wsc = W8_SCALE; c.gain = nullptr;
    if (r < 4 * CS_GU) {
        const int sg = r / CS_GU, rr = r % CS_GU, l = sg >> 1, f = sg & 1, nb = rr % (NGU / 256), kb = rr / (NGU / 256), nn = nb * 256 + 4 * lane, k0 = kb * 128;
        const float* W = ((nn & 255) >= 128 ? (f == 0 ? Iu1 : Iu2) : (f == 0 ? Ig1 : Ig2)) + (size_t)l * D * FF;
        c.src = W + (size_t)(k0 + 16 * wave) * FF + (nn >> 8) * 128 + (nn & 127); c.ldw = FF; c.gain = (f == 0 ? In1 : In2) + (size_t)l * D + k0 + 16 * wave;
        c.dst = (unsigned char*)wptr(F, l, f == 0 ? WL_GU1 : WL_GU2) + (size_t)(nb * 256) * D + k0; c.K = D;
        if (sg == 0) { c.i8 = 1; c.wsc = 127.0f / __uint_as_float(((const unsigned*)F.ctlf)[CW_WMAX]); }
    } else if (r < 4 * CS_GU + 4 * CS_DN) {
        const int q = r - 4 * CS_GU, sg = q / CS_DN, rr = q % CS_DN, l = sg >> 1, f = sg & 1, nb = rr % (D / 256), kb = rr / (D / 256), nn = nb * 256 + 4 * lane, k0 = kb * 128;
        c.src = (f == 0 ? Id1 : Id2) + (size_t)l * FF * D + (size_t)(k0 + 16 * wave) * D + nn; c.ldw = D;
        c.dst = (unsigned char*)wptr(F, l, f == 0 ? WL_DN1 : WL_DN2) + (size_t)(nb * 256) * FF + k0; c.K = FF;
    } else if (r >= CS_ONE) {
        int q = r - CS_ONE; c.b16 = 1; c.wsc = 1.0f;
        constexpr int NB16 = (wini8(0) ? 0 : 1) + (wini8(1) ? 0 : 1);
        if (q < NB16 * CS_INB) {
            const int l = (NB16 == 2) ? q / CS_INB : (wini8(0) ? 1 : 0), rr = q % CS_INB, nb = rr % (NIN / 256), kb = rr / (NIN / 256), nn = nb * 256 + 4 * lane, k0 = kb * 64, col = win_src_col(nn);
            c.valid = col >= 0;
            c.src = Iwin + (size_t)l * D * NIN_SRC + (size_t)(k0 + 8 * wave) * NIN_SRC + (col >= 0 ? col : 0); c.ldw = NIN_SRC; c.gain = Inm + (size_t)l * D + k0 + 8 * wave;
            c.dst = (unsigned char*)wptr(F, l, WL_IN) + ((size_t)(nb * 256) * D + k0) * 2; c.K = 2 * D;
        } else {
            q -= NB16 * CS_INB;
            const int l = q / CS_OUT, rr = q % CS_OUT, nb = rr % (D / 256), kb = rr / (D / 256), nn = nb * 256 + 4 * lane, k0 = kb * 64;
            c.src = Iwout + (size_t)l * D * D + (size_t)(k0 + 8 * wave) * D + nn; c.ldw = D;
            c.gain = ((k0 < 512) ? Innsa + (size_t)l * 512 : (k0 < 1024) ? Insb + (size_t)l * 512 - 512 : Inssd + (size_t)l * 1024 - 1024) + k0 + 8 * wave;
            c.dst = (unsigned char*)wptr(F, l, WL_OUT) + ((size_t)(nb * 256) * D + k0) * 2; c.K = 2 * D;
        }
    } else {
        const int rr = r - 4 * CS_GU - 4 * CS_DN, l = 1, nb = rr % (NIN / 256), kb = rr / (NIN / 256), nn = nb * 256 + 4 * lane, k0 = kb * 128, col = win_src_col(nn);
        c.valid = col >= 0;
        c.src = Iwin + (size_t)l * D * NIN_SRC + (size_t)(k0 + 16 * wave) * NIN_SRC + (col >= 0 ? col : 0); c.ldw = NIN_SRC; c.gain = Inm + (size_t)l * D + k0 + 16 * wave;
        c.dst = (unsigned char*)wptr(F, l, WL_IN) + (size_t)(nb * 256) * D + k0; c.K = D;
        c.i8 = 1; c.wsc = 127.0f / __uint_as_float(((const unsigned*)F.ctlf)[CW_WMAX + 1 + l]);
    }
    return c;
}
__device__ __forceinline__ void coop_convert(Frame& F, const ProIn PI) {
    constexpr int LSTR = 144;
    const float *Ig1 = PI.g1, *Iu1 = PI.u1, *Id1 = PI.d1, *Ig2 = PI.g2, *Iu2 = PI.u2, *Id2 = PI.d2, *In1 = PI.n1, *In2 = PI.n2, *Inm = PI.nm, *Iwin = PI.win, *Iwout = PI.wout, *Innsa = PI.nnsa, *Insb = PI.nsb, *Inssd = PI.nssd;
    asm volatile("" : "+s"(Ig1), "+s"(Iu1), "+s"(Id1), "+s"(Ig2), "+s"(Iu2), "+s"(Id2), "+s"(In1), "+s"(In2), "+s"(Inm), "+s"(Iwin), "+s"(Iwout), "+s"(Innsa), "+s"(Insb), "+s"(Inssd));
#define CVT_DECODE(rr) cvt_decode(F, Ig1, Iu1, Id1, Ig2, Iu2, Id2, In1, In2, Inm, Iwin, Iwout, Innsa, Insb, Inssd, (rr), wave, lane)
    LAS unsigned char* const l3 = (LAS unsigned char*)F.lds;
    const int lane = F.lane, wave = F.wave, tid = F.tid;
    int r = F.vcu;
    if (r >= CS_ALL) return;
    CvtStep c = CVT_DECODE(r);
    f32x4 v[16];
#pragma unroll
    for (int i = 0; i < 16; ++i) if (i < 8 || !c.b16) v[i] = *(const f32x4*)(c.src + (size_t)i * c.ldw);
    int buf = 0;
#pragma unroll 1
    for (;;) {
        LAS unsigned char* tile = l3 + buf * (256 * LSTR);
#pragma unroll
        for (int i = 0; i < 16; ++i) if (i < 8 || !c.b16) { const float sc = (c.gain ? c.gain[i] : 1.0f) * c.wsc; v[i] = c.valid ? v[i] * sc : (f32x4){0.f, 0.f, 0.f, 0.f}; }
#pragma unroll
        for (int j = 0; j < 4; ++j) { v4u o;
            if (c.b16) { o.x = pk2(v[0][j], v[1][j]); o.y = pk2(v[2][j], v[3][j]); o.z = pk2(v[4][j], v[5][j]); o.w = pk2(v[6][j], v[7][j]); }
            else if (c.i8) { o.x = pk4_i8(v[0][j], v[1][j], v[2][j], v[3][j]); o.y = pk4_i8(v[4][j], v[5][j], v[6][j], v[7][j]); o.z = pk4_i8(v[8][j], v[9][j], v[10][j], v[11][j]); o.w = pk4_i8(v[12][j], v[13][j], v[14][j], v[15][j]); }
            else { o.x = pk4_fp8(v[0][j], v[1][j], v[2][j], v[3][j]); o.y = pk4_fp8(v[4][j], v[5][j], v[6][j], v[7][j]); o.z = pk4_fp8(v[8][j], v[9][j], v[10][j], v[11][j]); o.w = pk4_fp8(v[12][j], v[13][j], v[14][j], v[15][j]); }
            *(LAS v4u*)(tile + (4 * lane + j) * LSTR + 16 * wave) = o; }
        unsigned char* const dst = c.dst; const int K = c.K;
        const int rn = r + F.G; const bool more = rn < CS_ALL;
        if (more) { c = CVT_DECODE(rn);
#pragma unroll
            for (int i = 0; i < 16; ++i) if (i < 8 || !c.b16) v[i] = *(const f32x4*)(c.src + (size_t)i * c.ldw); }
        asm volatile("s_waitcnt lgkmcnt(0)" ::: "memory"); __builtin_amdgcn_s_barrier(); asm volatile("" ::: "memory");
#pragma unroll
        for (int ps = 0; ps < 4; ++ps) { const int row = (tid >> 3) + 64 * ps, q = tid & 7;
            const v4u w = *(const LAS v4u*)(tile + row * LSTR + 16 * q);
            *(v4u*)(dst + (size_t)row * K + 16 * q) = w; }
        if (!more) break;
        r = rn; buf ^= 1;
    }
#undef CVT_DECODE
    __syncthreads();
}
__device__ __forceinline__ void p_prologue_b(Frame& F, const ProIn I) {
    const int gw = F.vcu * NWAVES + F.wave, NGW = F.G * NWAVES;
    if (COOP_OK) coop_convert(F, I);
    else convert_weights<CVM_PRO>(F, I, gw, NGW);
}
__device__ __forceinline__ void p_prologue(Frame& F, const ProIn I) {
    float* scr = (float*)(F.lds + F.wave * 16384);
    const int gw = F.vcu * NWAVES + F.wave, NGW = F.G * NWAVES, lane = F.lane;
    if (GU_I8 || WIN_I8) {
        float wmx = 0.f, wmi0 = 0.f, wmi1 = 0.f;
        if (WIN_I8)
        for (int it = gw; it < DEPTH * D; it += NGW) {
            const int l = it / D, k = it % D;
            if (!((WIN_I8 >> l) & 1)) continue; const f32x4* wr = (const f32x4*)(I.win + ((size_t)l * D + k) * NIN_SRC); float mx = 0.f;
            constexpr int NV = NIN_SRC / 4;
            f32x4 vv[(NV + 63) / 64];
#pragma unroll
            for (int q = 0; q < (NV + 63) / 64; ++q) { const int idx = lane + 64 * q; vv[q] = (idx < NV) ? wr[idx] : (f32x4){0.f, 0.f, 0.f, 0.f}; }
#pragma unroll
            for (int q = 0; q < (NV + 63) / 64; ++q) mx = fmaxf(fmaxf(mx, fmaxf(fabsf(vv[q][0]), fabsf(vv[q][1]))), fmaxf(fabsf(vv[q][2]), fabsf(vv[q][3])));
            mx = wave_max(mx) * fabsf(I.nm[(size_t)l * D + k]);
            if (l == 0) wmi0 = fmaxf(wmi0, mx); else wmi1 = fmaxf(wmi1, mx);
        }
        if (GU_I8)
        for (int rep_m = 0; rep_m < REP_AMAX; ++rep_m)
        for (int it = gw; it < 2 * D; it += NGW) {
            const int mat = it / D, k = it % D; const float* wr = (mat ? I.u1 : I.g1) + (size_t)k * FF; float mx = 0.f;
            f32x4 vv[FF / 256];
#pragma unroll
            for (int q = 0; q < FF / 256; ++q) vv[q] = *((const f32x4*)wr + lane + 64 * q);
#pragma unroll
            for (int q = 0; q < FF / 256; ++q) mx = fmaxf(fmaxf(mx, fmaxf(fabsf(vv[q][0]), fabsf(vv[q][1]))), fmaxf(fabsf(vv[q][2]), fabsf(vv[q][3])));
            wmx = fmaxf(wmx, wave_max(mx) * fabsf(I.n1[k]));
        }
        float* red = (float*)(F.lds + 131072 - 128);
        if (lane == 0) { red[F.wave] = wmx; red[8 + F.wave] = wmi0; red[16 + F.wave] = wmi1; }
        __syncthreads();
        if (F.tid < 3) { float m8 = red[8 * F.tid];
#pragma unroll
            for (int q = 1; q < NWAVES; ++q) m8 = fmaxf(m8, red[8 * F.tid + q]);
            if (F.tid == 0 ? GU_I8 != 0 : WIN_I8 != 0) atomicMax((unsigned*)F.ctlf + CW_WMAX + F.tid, __float_as_uint(m8)); }
        __syncthreads();
    }
    if (blockIdx.x >= 64 && blockIdx.x < 64 + DEPTH * 2 * 16) {
        const int idx = (int)blockIdx.x - 64, mat = idx & 3, sl = idx >> 2, dd = F.tid & 63, sub = F.tid >> 6;
        const float* w = I.cw + (size_t)mat * 2048 * 64; const float* pos = I.cpos + (size_t)mat * 2048;
        float a = 0.f;
#pragma unroll
        for (int k = 0; k < 16; ++k) { const int kk = sl * 128 + sub * 16 + k; a += pos[kk] * w[kk * 64 + dd]; }
        float* red = (float*)F.lds;
        red[F.tid] = a;
        __syncthreads();
        if (F.tid < 64) { float t = 0.f;
#pragma unroll
            for (int q = 0; q < 8; ++q) t += red[q * 64 + F.tid];
            ((float*)(F.ws + WS_TAB + TAB_PB))[(mat * 16 + sl) * 64 + F.tid] = t; }
        __syncthreads();
    }
    if (F.wave == NWAVES - 1)
    for (int it = F.vcu; it < DEPTH * 2 * 64; it += F.G) {
        const int mat = it >> 6, r = it & 63, nb = r & 1, kb = r >> 1;
        transpose_item<true>(I.cw + (size_t)mat * 2048 * 64, 64, nb * 32 + (lane & 31), nullptr, (bf16*)(F.ws + WS_CW) + (size_t)mat * 64 * 2048, 2048, nb * 32, kb * 64, scr, lane);
    }
    {
        const float* x = I.x; bf16* xb = (bf16*)(F.ws + WS_XB); u64* ss0 = ssptr(F, 0);
        for (int m = gw; m < M; m += NGW) {
            const f32x4* xr = (const f32x4*)(x + (size_t)m * D) + lane; float s = 0.f;
            if (gui8(0)) {
                f32x4 v[8]; float mx = 0.f;
#pragma unroll
                for (int j = 0; j < 8; ++j) { v[j] = xr[64 * j]; s += (v[j][0] * v[j][0] + v[j][1] * v[j][1]) + (v[j][2] * v[j][2] + v[j][3] * v[j][3]); mx = fmaxf(fmaxf(mx, fmaxf(fabsf(v[j][0]), fabsf(v[j][1]))), fmaxf(fabsf(v[j][2]), fabsf(v[j][3]))); }
                mx = fmaxf(wave_max(mx), 1e-30f);
                const float inv = 127.0f / mx;
                unsigned* o = (unsigned*)((unsigned char*)xb + (size_t)m * D) + lane;
#pragma unroll
                for (int j = 0; j < 8; ++j) o[64 * j] = pk4_i8(v[j][0] * inv, v[j][1] * inv, v[j][2] * inv, v[j][3] * inv);
                if (lane == 0) ((float*)(F.ws + WS_TAB + TAB_XS))[m] = mx * (1.0f / 127.0f);
            } else if (gu8(0)) {
                unsigned* o = (unsigned*)((unsigned char*)xb + (size_t)m * D) + lane;
#pragma unroll
                for (int j = 0; j < 8; ++j) { const f32x4 v = xr[64 * j]; s += (v[0] * v[0] + v[1] * v[1]) + (v[2] * v[2] + v[3] * v[3]); o[64 * j] = pk4_fp8(v[0] * X8_SCALE, v[1] * X8_SCALE, v[2] * X8_SCALE, v[3] * X8_SCALE); }
            } else {
                v2u* o = (v2u*)(xb + (size_t)m * D) + lane;
#pragma unroll
                for (int j = 0; j < 8; ++j) { const f32x4 v = xr[64 * j]; s += (v[0] * v[0] + v[1] * v[1]) + (v[2] * v[2] + v[3] * v[3]); v2u w; w.x = pk2(v[0], v[1]); w.y = pk2(v[2], v[3]); o[64 * j] = w; }
            }
            s = wave_sum(s);
            if (lane == 0) ss0[m] = (u64)(s * SS_SCALE + 0.5f);
        }
    }
    if (blockIdx.x == 0) {
        float* tab = (float*)(F.ws + WS_TAB);
        for (int i = F.tid; i < 8 * 129; i += NTHR) { const int h = i / 129, dist = i % 129; tab[i] = I.relb[t5_bucket(dist) * 8 + h] * LOG2E; }
    }
}

typedef short bf16x8 __attribute__((ext_vector_type(8)));
typedef float f32x16 __attribute__((ext_vector_type(16)));
__device__ __forceinline__ unsigned cvtpk(float lo, float hi) { unsigned r; asm volatile("v_cvt_pk_bf16_f32 %0, %1, %2" : "=v"(r) : "v"(lo), "v"(hi)); return r; }
__device__ __forceinline__ bf16x8 mk_frag(v2u a, v2u b) { v4u w; w.x = a.x; w.y = a.y; w.z = b.x; w.w = b.y; return __builtin_bit_cast(bf16x8, w); }
__device__ __forceinline__ bf16x8 acc_frag(const f32x16& x, int s) {
    v4u w;
    if (s == 0) { w.x = cvtpk(x[0], x[1]); w.y = cvtpk(x[2], x[3]); w.z = cvtpk(x[4], x[5]); w.w = cvtpk(x[6], x[7]); }
    else        { w.x = cvtpk(x[8], x[9]); w.y = cvtpk(x[10], x[11]); w.z = cvtpk(x[12], x[13]); w.w = cvtpk(x[14], x[15]); }
    return __builtin_bit_cast(bf16x8, w);
}
#define MFMA32(a, b, c) __builtin_amdgcn_mfma_f32_32x32x16_bf16((a), (b), (c), 0, 0, 0)
template <bool DIAG>
__device__ __forceinline__ void sb_block(f32x16& O0, f32x16& O1, float& Rc, const bf16x8 (&Kc)[4], const bf16x8 (&Vc)[4], const bf16x8 (&Qf)[4], int r, int h) {
    f32x16 S;
#pragma unroll
    for (int i = 0; i < 16; ++i) S[i] = 0.f;
#pragma unroll
    for (int s = 0; s < 4; ++s) S = MFMA32(Kc[s], Qf[s], S);
    f32x4 B4[4], W4[4];
#pragma unroll
    for (int k = 0; k < 4; ++k) {
        f32x4 e4;
#pragma unroll
        for (int c = 0; c < 4; ++c) e4[c] = fexp2(__builtin_amdgcn_fmed3f(S[4 * k + c], -100.f, 100.f));
        const f32x4 d4 = e4 + 1.0f;
        f32x4 w4;
#pragma unroll
        for (int c = 0; c < 4; ++c) w4[c] = frcp(d4[c]);
        f32x4 b4 = e4 * w4;
        if (DIAG) {
#pragma unroll
            for (int c = 0; c < 4; ++c) if (c + 8 * k + 4 * h >= r) { w4[c] = 1.f; b4[c] = 0.f; }
        }
        W4[k] = w4; B4[k] = b4;
    }
    float G[4], oth[4];
#pragma unroll
    for (int k = 0; k < 4; ++k) {
        const float s2 = W4[k][3], s1 = s2 * W4[k][2], s0 = s1 * W4[k][1];
        G[k] = s0 * W4[k][0];
        B4[k] = B4[k] * (f32x4){s0, s1, s2, 1.0f};
    }
#pragma unroll
    for (int k = 0; k < 4; ++k) oth[k] = __shfl_xor(G[k], 32);
    const float EO3 = G[3] * oth[3], EO2 = G[2] * oth[2], EO1 = G[1] * oth[1], EO0 = G[0] * oth[0];
    float Tk[4]; Tk[3] = Rc; Tk[2] = EO3 * Rc; Tk[1] = Tk[2] * EO2; Tk[0] = Tk[1] * EO1;
    Rc = Tk[0] * EO0;
#pragma unroll
    for (int k = 0; k < 4; ++k) { const float sk = h == 0 ? Tk[k] * oth[k] : Tk[k]; B4[k] = B4[k] * sk; }
    v4u p0, p1;
    p0.x = cvtpk(B4[0][0], B4[0][1]); p0.y = cvtpk(B4[0][2], B4[0][3]); p0.z = cvtpk(B4[1][0], B4[1][1]); p0.w = cvtpk(B4[1][2], B4[1][3]);
    p1.x = cvtpk(B4[2][0], B4[2][1]); p1.y = cvtpk(B4[2][2], B4[2][3]); p1.z = cvtpk(B4[3][0], B4[3][1]); p1.w = cvtpk(B4[3][2], B4[3][3]);
    const bf16x8 P0 = __builtin_bit_cast(bf16x8, p0), P1 = __builtin_bit_cast(bf16x8, p1);
    O0 = MFMA32(Vc[0], P0, O0); O0 = MFMA32(Vc[1], P1, O0);
    O1 = MFMA32(Vc[2], P0, O1); O1 = MFMA32(Vc[3], P1, O1);
}
__device__ __forceinline__ void m_sb(Frame& F) {
    const bf16* qs = (const bf16*)(F.R + R_QS); const bf16* ks = (const bf16*)(F.R + R_KS); const bf16* vst = (const bf16*)(F.R + R_VST); float* osb = (float*)(F.R + R_OSB);
    const int lane = F.lane, r = lane & 31, h = lane >> 5;
    for (int unit = F.vcu; unit < 256; unit += F.G) {
        const int b = unit >> 6, p = (unit >> 1) & 31, head = (unit & 1) * 4 + (F.wave & 3);
#pragma unroll 1
        for (int pass = 0; pass < 1; ++pass) {
            const int qt = (F.wave >> 2) ? 63 - p : p;
            bf16x8 Qf[4];
            { const bf16* qrow = qs + (size_t)(b * T + 32 * qt + r) * 512 + head * 64 + 8 * h;
#pragma unroll
              for (int s = 0; s < 4; ++s) Qf[s] = *(const bf16x8*)(qrow + 16 * s); }
            const bf16* kbase = ks + (size_t)(b * 8 + head) * (T * 64) + lane * 8;
            const bf16* vbase = vst + (size_t)(b * 8 + head) * (T * 64) + lane * 8;
            f32x16 O0, O1;
#pragma unroll
            for (int i = 0; i < 16; ++i) { O0[i] = 0.f; O1[i] = 0.f; }
            float Rc = 1.f;
#define SB_LOAD(Kx, Vx, kbx) do { _Pragma("unroll") for (int s = 0; s < 4; ++s) { Kx[s] = *(const bf16x8*)(kbase + (size_t)((kbx) * 4 + s) * 512); Vx[s] = *(const bf16x8*)(vbase + (size_t)((kbx) * 4 + s) * 512); } } while (0)
            bf16x8 Kc[4], Vc[4], Kn[4], Vn[4];
            SB_LOAD(Kn, Vn, qt);
            SB_LOAD(Kc, Vc, (qt > 0 ? qt - 1 : 0));
            sb_block<true>(O0, O1, Rc, Kn, Vn, Qf, r, h);
            int kb = qt - 1;
#pragma unroll 1
            for (; kb >= 1; kb -= 2) {
                if (__all(Rc == 0.f)) { kb = -1; break; }
                SB_LOAD(Kn, Vn, kb - 1);
                sb_block<false>(O0, O1, Rc, Kc, Vc, Qf, r, h);
                SB_LOAD(Kc, Vc, (kb >= 2 ? kb - 2 : 0));
                sb_block<false>(O0, O1, Rc, Kn, Vn, Qf, r, h);
            }
            if (kb == 0) sb_block<false>(O0, O1, Rc, Kc, Vc, Qf, r, h);
#undef SB_LOAD
            float* orow = osb + (size_t)(b * T + 32 * qt + r) * 512 + head * 64 + 4 * h;
#pragma unroll
            for (int k = 0; k < 4; ++k) { *(f32x4*)(orow + 8 * k) = (f32x4){O0[4 * k], O0[4 * k + 1], O0[4 * k + 2], O0[4 * k + 3]};
                                          *(f32x4*)(orow + 32 + 8 * k) = (f32x4){O1[4 * k], O1[4 * k + 1], O1[4 * k + 2], O1[4 * k + 3]}; }
        }
    }
}
template <int MODE>
__device__ __forceinline__ void nsa_block(f32x16& O0, f32x16& O1, float& mrun, float& lrun, const bf16x8 (&Kc)[4], const bf16x8 (&Vc)[4], const bf16x8 (&Qf)[4], const LAS float* tabl, float tab128,
                                          int qt, int kb, unsigned msk, int r, int h) {
    f32x16 S;
#pragma unroll
    for (int i = 0; i < 16; ++i) S[i] = 0.f;
#pragma unroll
    for (int s = 0; s < 4; ++s) S = MFMA32(Kc[s], Qf[s], S);
    const int dq = qt - kb;
    const bool bit = MODE == 0 ? ((msk >> (kb >> 1)) & 1u) != 0u : true;
    const bool fast = MODE == 0 ? dq >= 5 : (dq >= 5 && dq <= 15);
    float bm;
    if (fast) {
        const float boff = bit ? tab128 : -3.0e38f;
        S = S + boff;
        bm = fmaxf(fmaxf(fmaxf(S[0], S[1]), fmaxf(S[2], S[3])), fmaxf(fmaxf(S[4], S[5]), fmaxf(S[6], S[7])));
        bm = fmaxf(bm, fmaxf(fmaxf(fmaxf(S[8], S[9]), fmaxf(S[10], S[11])), fmaxf(fmaxf(S[12], S[13]), fmaxf(S[14], S[15]))));
    } else {
        int d0 = 32 * dq + r - 4 * h;
        asm volatile("" : "+v"(d0));
        bm = -3.0e38f;
#pragma unroll
        for (int i = 0; i < 16; ++i) {
            const int dist = d0 - ((i & 3) + 8 * (i >> 2));
            const bool valid = bit && dist >= 0 && (MODE == 0 || dist < 512);
            const float sv = valid ? S[i] + tabl[dist < 0 ? 0 : (dist > 128 ? 128 : dist)] : -3.0e38f;
            S[i] = sv; bm = fmaxf(bm, sv);
        }
    }
    bm = fmaxf(bm, __shfl_xor(bm, 32));
    const float mnew = fmaxf(mrun, bm);
    if (__any(mnew != mrun)) {
        const float alpha = fexp2(mrun - mnew);
        lrun *= alpha; O0 = O0 * alpha; O1 = O1 * alpha; mrun = mnew;
    }
    if (fast) {
        S = S - mrun;
#pragma unroll
        for (int i = 0; i < 16; ++i) S[i] = fexp2(S[i]);
    } else {
#pragma unroll
        for (int i = 0; i < 16; ++i) S[i] = S[i] > -1.0e38f ? fexp2(S[i] - mrun) : 0.f;
    }
    lrun += ((S[0] + S[1]) + (S[2] + S[3])) + ((S[4] + S[5]) + (S[6] + S[7])) + ((S[8] + S[9]) + (S[10] + S[11])) + ((S[12] + S[13]) + (S[14] + S[15]));
    const bf16x8 P0 = acc_frag(S, 0), P1 = acc_frag(S, 1);
    O0 = MFMA32(Vc[0], P0, O0); O0 = MFMA32(Vc[1], P1, O0);
    O1 = MFMA32(Vc[2], P0, O1); O1 = MFMA32(Vc[3], P1, O1);
}
template <int MODE>
__device__ __forceinline__ void nsa_pass(f32x16& Ot0, f32x16& Ot1, const bf16x8 (&Qf)[4], const bf16* kbase, const bf16* vbase, const LAS float* tabl, int qt, int kb_lo, unsigned msk, float gate, int r, int h) {
    f32x16 O0, O1;
#pragma unroll
    for (int i = 0; i < 16; ++i) { O0[i] = 0.f; O1[i] = 0.f; }
    float mrun = -3.0e38f, lrun = 0.f;
    const float tab128 = tabl[128];
#define NSA_LD(X, base, kbx) do { _Pragma("unroll") for (int s = 0; s < 4; ++s) X[s] = *(const bf16x8*)((base) + (size_t)((kbx) * 4 + s) * 512); } while (0)
    bf16x8 Kc[4], Kn[4], Vc[4];
    NSA_LD(Kc, kbase, kb_lo);
    int kb = kb_lo;
#pragma unroll 1
    for (; kb + 1 <= qt; kb += 2) {
        NSA_LD(Vc, vbase, kb); NSA_LD(Kn, kbase, kb + 1);
        nsa_block<MODE>(O0, O1, mrun, lrun, Kc, Vc, Qf, tabl, tab128, qt, kb, msk, r, h);
        NSA_LD(Vc, vbase, kb + 1); NSA_LD(Kc, kbase, (kb + 2 <= qt ? kb + 2 : qt));
        nsa_block<MODE>(O0, O1, mrun, lrun, Kn, Vc, Qf, tabl, tab128, qt, kb + 1, msk, r, h);
    }
    if (kb == qt) { NSA_LD(Vc, vbase, kb); nsa_block<MODE>(O0, O1, mrun, lrun, Kc, Vc, Qf, tabl, tab128, qt, kb, msk, r, h); }
#undef NSA_LD
    lrun += __shfl_xor(lrun, 32);
    const float sc = gate / lrun;
    Ot0 = Ot0 + O0 * sc; Ot1 = Ot1 + O1 * sc;
}
__device__ __forceinline__ void m_nsa(Frame& F) {
    const bf16* qn = (const bf16*)(F.R + R_QN); const bf16* kn = (const bf16*)(F.R + R_KN); const bf16* vnt = (const bf16*)(F.R + R_VNT);
    const bf16* kc = (const bf16*)(F.R + R_KCMP); const bf16* vct = (const bf16*)(F.R + R_VCMPT); const float* dtg = (const float*)(F.R + R_DTG);
    float* onsa = (float*)(F.R + R_ONSA);
    LAS unsigned char* const l3 = (LAS unsigned char*)F.lds;
    LAS float* PS = (LAS float*)l3;
    LAS unsigned* SEL = (LAS unsigned*)(l3 + 32768);
    LAS float* TAB = (LAS float*)(l3 + 33024);
    LAS float* PINV = (LAS float*)(l3 + 37376);
    volatile LAS unsigned* HB = (volatile LAS unsigned*)(l3 + 38400);
    unsigned hb_target = 0u;
#define HALF_BARRIER() do { asm volatile("s_waitcnt vmcnt(0) lgkmcnt(0)" ::: "memory"); hb_target += 4u; if (lane == 0) __hip_atomic_fetch_add((LAS unsigned*)(HB + 16 * half), 1u, __ATOMIC_RELAXED, __HIP_MEMORY_SCOPE_WORKGROUP); \
        while ((unsigned)__builtin_amdgcn_readfirstlane((int)HB[16 * half]) < hb_target) __builtin_amdgcn_s_sleep(1); asm volatile("" ::: "memory"); } while (0)
    const int lane = F.lane, r = lane & 31, h = lane >> 5, g = F.wave & 3, half = F.wave >> 2;
    { const float* tab = (const float*)(F.ws + WS_TAB); for (int i = F.tid; i < 8 * 129; i += NTHR) TAB[i] = tab[i]; }
    __syncthreads();
    if (F.tid < 32) HB[F.tid] = 0u;
    __syncthreads();
    for (int unit = F.vcu; unit < 256; unit += F.G) {
        const int b = unit >> 6, p = (unit >> 1) & 31, hk = unit & 1, head = hk * 4 + g;
        const LAS float* tabl = TAB + head * 129;
#pragma unroll 1
        for (int pass = 0; pass < 1; ++pass) {
            const int qt = half ? 63 - p : p;
            int ln = lane; asm volatile("" : "+v"(ln));
            const int t = 32 * qt + r, row = b * T + 32 * qt + (ln & 31);
            bf16x8 Qf[4];
            { const bf16* qrow = qn + (size_t)row * 512 + head * 64 + 8 * (ln >> 5);
#pragma unroll
              for (int s = 0; s < 4; ++s) Qf[s] = *(const bf16x8*)(qrow + 16 * s); }
            const float* gl = dtg + (size_t)row * 64 + 16 + head * 3;
            const float g0 = sigmoid_f(gl[0]), g1 = sigmoid_f(gl[1]), g2 = sigmoid_f(gl[2]);
            f32x16 Ot0, Ot1;
            {
                const bf16* kcb = kc + (size_t)(b * 2 + hk) * (128 * 64) + ln * 8;
                float mx = -3.0e38f;
                const int ncb = (qt >> 4) + 1 < 4 ? (qt >> 4) + 1 : 4;
#pragma unroll 1
                for (int cb = 0; cb < ncb; ++cb) {
                    f32x16 S;
#pragma unroll
                    for (int i = 0; i < 16; ++i) S[i] = 0.f;
#pragma unroll
                    for (int s = 0; s < 4; ++s) S = MFMA32(*(const bf16x8*)(kcb + (size_t)(cb * 4 + s) * 512), Qf[s], S);
#pragma unroll
                    for (int i = 0; i < 16; ++i) {
                        const int c = 32 * cb + (i & 3) + 8 * (i >> 2) + 4 * h, dist = t - (16 * c + 31);
                        const bool valid = dist >= 0 && c < 127;
                        const float sv = valid ? S[i] + tabl[dist < 0 ? 0 : (dist > 128 ? 128 : dist)] : -3.0e38f;
                        mx = fmaxf(mx, sv);
                    }
                }
                mx = fmaxf(mx, __shfl_xor(mx, 32));
                const bf16* vcb = vct + (size_t)(b * 2 + hk) * (128 * 64) + ln * 8;
                f32x16 O0, O1;
#pragma unroll
                for (int i = 0; i < 16; ++i) { O0[i] = 0.f; O1[i] = 0.f; }
                float sum = 0.f, carry = 0.f;
                LAS float* psw = PS + ((half * 4 + g) * 32) * 32 + r;
#pragma unroll 1
                for (int cb = 0; cb < 4; ++cb) {
                    f32x16 S;
#pragma unroll
                    for (int i = 0; i < 16; ++i) S[i] = 0.f;
#pragma unroll
                    for (int s = 0; s < 4; ++s) S = MFMA32(*(const bf16x8*)(kcb + (size_t)(cb * 4 + s) * 512), Qf[s], S);
#pragma unroll
                    for (int i = 0; i < 16; ++i) {
                        const int c = 32 * cb + (i & 3) + 8 * (i >> 2) + 4 * h, dist = t - (16 * c + 31);
                        const bool valid = dist >= 0 && c < 127;
                        const float pv = valid ? fexp2(S[i] + tabl[dist < 0 ? 0 : (dist > 128 ? 128 : dist)] - mx) : 0.f;
                        S[i] = pv; sum += pv;
                    }
                    float pco[4];
#pragma unroll
                    for (int k = 0; k < 4; ++k) pco[k] = __shfl_xor(0.5f * S[4 * k + 3], 32);
#pragma unroll
                    for (int k = 0; k < 4; ++k) {
                        const float own = S[4 * k] + S[4 * k + 1] + S[4 * k + 2] + 0.5f * S[4 * k + 3];
                        const float cin = h ? pco[k] : (k > 0 ? pco[k > 0 ? k - 1 : 0] : carry);
                        psw[(8 * cb + 2 * k + h) * 32] = own + cin;
                    }
                    carry = pco[3];
#pragma unroll
                    for (int s = 0; s < 2; ++s) {
                        const bf16x8 Pf = acc_frag(S, s);
                        O0 = MFMA32(*(const bf16x8*)(vcb + (size_t)((cb * 2 + 0) * 2 + s) * 512), Pf, O0);
                        O1 = MFMA32(*(const bf16x8*)(vcb + (size_t)((cb * 2 + 1) * 2 + s) * 512), Pf, O1);
                    }
                }
                sum += __shfl_xor(sum, 32);
                const float inv = sum > 0.f ? 1.0f / sum : 0.f;
                if (h == 0) PINV[(half * 4 + g) * 32 + r] = inv;
                const float gi = g0 * inv;
#pragma unroll
                for (int i = 0; i < 16; ++i) { Ot0[i] = gi * O0[i]; Ot1[i] = gi * O1[i]; }
            }
            HALF_BARRIER();
            {
                const int tt = 8 * g + (ln >> 3), s8 = ln & 7, tq = 32 * qt + tt, cur = tq >> 6;
                const float iv0 = PINV[(half * 4 + 0) * 32 + tt], iv1 = PINV[(half * 4 + 1) * 32 + tt], iv2 = PINV[(half * 4 + 2) * 32 + tt], iv3 = PINV[(half * 4 + 3) * 32 + tt];
                float sc[4];
#pragma unroll
                for (int i = 0; i < 4; ++i) {
                    const int j = s8 + 8 * i;
                    const LAS float* pp = PS + ((half * 4) * 32 + j) * 32 + tt;
                    const float v = (pp[0] * iv0 + pp[1024] * iv1) + (pp[2048] * iv2 + pp[3072] * iv3);
                    sc[i] = (64 * j <= tq) ? v + ((j == 0 || j == cur || j == cur - 1) ? 1000.f : 0.f) : -3.0e38f;
                }
                unsigned mk = 0u;
#pragma unroll 1
                for (int it = 0; it < 8; ++it) {
                    float bv = sc[0]; int bj = s8;
#pragma unroll
                    for (int i = 1; i < 4; ++i) if (sc[i] > bv) { bv = sc[i]; bj = s8 + 8 * i; }
#pragma unroll
                    for (int off = 1; off < 8; off <<= 1) { const float ov = __shfl_xor(bv, off); const int oj = __shfl_xor(bj, off); if (ov > bv || (ov == bv && oj < bj)) { bv = ov; bj = oj; } }
                    if (bv > -1.0e38f) mk |= 1u << bj;
                    const bool mine = (bj & 7) == s8;
#pragma unroll
                    for (int i = 0; i < 4; ++i) sc[i] = (mine && (bj >> 3) == i) ? -3.0e38f : sc[i];
                }
                if (s8 == 0) SEL[half * 32 + tt] = mk;
            }
            HALF_BARRIER();
            const unsigned msk = SEL[half * 32 + r];
            nsa_pass<0>(Ot0, Ot1, Qf, kn + (size_t)(b * 4 + hk) * (T * 64) + ln * 8, vnt + (size_t)(b * 4 + hk) * (T * 64) + ln * 8, tabl, qt, 0, msk, g1, r, h);
            nsa_pass<1>(Ot0, Ot1, Qf, kn + (size_t)(b * 4 + 2 + hk) * (T * 64) + ln * 8, vnt + (size_t)(b * 4 + 2 + hk) * (T * 64) + ln * 8, tabl, qt, qt > 16 ? qt - 16 : 0, 0u, g2, r, h);
            float* orow = onsa + (size_t)row * 512 + head * 64 + 4 * (ln >> 5);
#pragma unroll
            for (int k = 0; k < 4; ++k) { *(f32x4*)(orow + 8 * k) = (f32x4){Ot0[4 * k], Ot0[4 * k + 1], Ot0[4 * k + 2], Ot0[4 * k + 3]};
                                          *(f32x4*)(orow + 32 + 8 * k) = (f32x4){Ot1[4 * k], Ot1[4 * k + 1], Ot1[4 * k + 2], Ot1[4 * k + 3]}; }
            HALF_BARRIER();
        }
    }
}
#undef HALF_BARRIER
__device__ __forceinline__ void m_compress(Frame& F, int layer) {
    const bf16* raw = (const bf16*)(F.R + R_CMPRAW); bf16* kc = (bf16*)(F.R + R_KCMP); bf16* vct = (bf16*)(F.R + R_VCMPT);
    LAS float* RED = (LAS float*)(LAS unsigned char*)F.lds;
    const int lane = F.lane, w = F.wave;
    for (int item = F.vcu; item < 128; item += F.G) {
        const int dt = item & 1, rest = item >> 1, ct = rest & 3, hk = (rest >> 2) & 1, b = (rest >> 3) & 3, kind = rest >> 5, mat = layer * 2 + kind;
        const bf16* ap = raw + ((size_t)(((kind * 2 + hk) * 4 + b) * 4 + ct) * 128 + 16 * w) * 512 + lane * 8;
        const bf16* bp = (const bf16*)(F.ws + WS_CW) + (size_t)mat * (64 * 2048) + (size_t)(128 * dt + 16 * w) * 512 + lane * 8;
        const float* pb = (const float*)(F.ws + WS_TAB + TAB_PB) + mat * 16 * 64 + 32 * dt + (lane & 31);
        float pbv = 0.f;
#pragma unroll
        for (int sl = 0; sl < 16; ++sl) pbv += pb[sl * 64];
        f32x16 a0;
        for (int rep_a = 0; rep_a < REP_CMPA; ++rep_a) {
#pragma unroll
        for (int i = 0; i < 16; ++i) a0[i] = 0.f;
#pragma unroll
        for (int s = 0; s < 16; ++s) a0 = MFMA32(*(const bf16x8*)(ap + (size_t)s * 512), *(const bf16x8*)(bp + (size_t)s * 512), a0);
        }
        for (int rep_b = 0; rep_b < REP_CMPB; ++rep_b) {
#pragma unroll
        for (int i = 0; i < 16; ++i) RED[(w * 16 + i) * 64 + lane] = a0[i];
        __syncthreads();
#pragma unroll
        for (int q = 0; q < 2; ++q) {
            const int o = F.tid + NTHR * q, ln = o & 63, i = (o >> 6) & 15;
            float sum = 0.f;
#pragma unroll
            for (int ww = 0; ww < 8; ++ww) sum += RED[(ww * 16 + i) * 64 + ln];
            const int c = 32 * ct + (i & 3) + 8 * (i >> 2) + 4 * (ln >> 5), dd = 32 * dt + (ln & 31);
            const float val = c < 127 ? sum + pbv : 0.f;
            if (kind == 0) kc[(size_t)(b * 2 + hk) * (128 * 64) + kfrag_off(c, dd & ~7) + (dd & 7)] = (bf16)f2bf(val);
            else vct[(size_t)(b * 2 + hk) * (128 * 64) + vfrag_off(c, dd)] = (bf16)f2bf(val);
        }
        __syncthreads();
        }
    }
}
constexpr int SL = 64, SNC = T / SL;
__device__ __forceinline__ void m_ssd_s1(Frame& F, int layer, const float* conv_w, const float* conv_b, const float* dt_bias, const float* a_log) {
    const bf16* xbc = (const bf16*)(F.R + R_XBC); const float* dtg = (const float*)(F.R + R_DTG);
    bf16* xt = (bf16*)(F.R + R_XT); bf16* bm = (bf16*)(F.R + R_BM); bf16* cm = (bf16*)(F.R + R_CM); float* dtb = (float*)(F.R + R_DT); float* acsb = (float*)(F.R + R_ACS); float* aend = (float*)(F.R + R_AEND);
    bf16* st = (bf16*)(F.R + R_ST);
    const float* cw = conv_w + (size_t)layer * 4 * 1536; const float* cb = conv_b + (size_t)layer * 1536;
    LAS unsigned char* const l3 = (LAS unsigned char*)F.lds;
    LAS bf16* XTL = (LAS bf16*)l3;
    LAS bf16* BMTL = (LAS bf16*)(l3 + 73728);
    LAS float* SCL = (LAS float*)(l3 + 92160);
    const int lane = F.lane, r = lane & 31, h = lane >> 5, e = F.wave;
    for (int item = F.vcu; item < BATCH * SNC * 2; item += F.G) {
        const int g = item & 1, c = (item >> 1) & (SNC - 1), b = item >> 6, t0 = c * SL;
        for (int rep_a = 0; rep_a < REP_S1A; ++rep_a)
#pragma unroll 1
        for (int id = F.tid; id < 96 * 16; id += NTHR) {
            const int c8 = id % 96, q = id / 96;
            const int col = c8 < 64 ? 512 * g + 8 * c8 : (c8 < 80 ? 1024 + 128 * g + 8 * (c8 - 64) : 1280 + 128 * g + 8 * (c8 - 80));
            float u[7][8];
#pragma unroll
            for (int i = 0; i < 7; ++i) {
                const int tt = t0 + 4 * q - 3 + i;
                v4u w = (v4u){0u, 0u, 0u, 0u};
                if (tt >= 0) w = *(const v4u*)(xbc + ((size_t)b * T + tt) * 1536 + col);
                u[i][0] = __uint_as_float(w.x << 16); u[i][1] = __uint_as_float(w.x & 0xffff0000u); u[i][2] = __uint_as_float(w.y << 16); u[i][3] = __uint_as_float(w.y & 0xffff0000u);
                u[i][4] = __uint_as_float(w.z << 16); u[i][5] = __uint_as_float(w.z & 0xffff0000u); u[i][6] = __uint_as_float(w.w << 16); u[i][7] = __uint_as_float(w.w & 0xffff0000u);
            }
            float wk[4][8], bias[8];
#pragma unroll
            for (int k = 0; k < 4; ++k) { const f32x4 a0 = *(const f32x4*)(cw + k * 1536 + col), a1 = *(const f32x4*)(cw + k * 1536 + col + 4);
                wk[k][0] = a0[0]; wk[k][1] = a0[1]; wk[k][2] = a0[2]; wk[k][3] = a0[3]; wk[k][4] = a1[0]; wk[k][5] = a1[1]; wk[k][6] = a1[2]; wk[k][7] = a1[3]; }
            { const f32x4 a0 = *(const f32x4*)(cb + col), a1 = *(const f32x4*)(cb + col + 4);
              bias[0] = a0[0]; bias[1] = a0[1]; bias[2] = a0[2]; bias[3] = a0[3]; bias[4] = a1[0]; bias[5] = a1[1]; bias[6] = a1[2]; bias[7] = a1[3]; }
            float y[4][8];
#pragma unroll
            for (int j = 0; j < 4; ++j)
#pragma unroll
                for (int i = 0; i < 8; ++i) y[j][i] = silu_f(bias[i] + wk[0][i] * u[j][i] + wk[1][i] * u[j + 1][i] + wk[2][i] * u[j + 2][i] + wk[3][i] * u[j + 3][i]);
            if (c8 < 64) {
                const int he = c8 >> 3, p0 = 8 * (c8 & 7);
#pragma unroll
                for (int i = 0; i < 8; ++i) { v2u pk; pk.x = pk2(y[0][i], y[1][i]); pk.y = pk2(y[2][i], y[3][i]);
                    *(LAS v2u*)(XTL + (he * 64 + p0 + i) * 72 + 4 * q) = pk; }
            } else {
                const int n0 = 8 * (c8 < 80 ? c8 - 64 : c8 - 80);
                if (c8 < 80) {
#pragma unroll
                    for (int i = 0; i < 8; ++i) { v2u pk; pk.x = pk2(y[0][i], y[1][i]); pk.y = pk2(y[2][i], y[3][i]); *(LAS v2u*)(BMTL + (n0 + i) * 72 + 4 * q) = pk; }
                }
                bf16* dst = (c8 < 80 ? bm : cm) + ((size_t)((((b * 2 + g) * SNC + c) * 2 + (q >> 3)) * 8 + (n0 >> 4)) * 64 + 32 * ((n0 >> 3) & 1) + 4 * (q & 7)) * 8;
#pragma unroll
                for (int j = 0; j < 4; ++j) { v4u pk; pk.x = pk2(y[j][0], y[j][1]); pk.y = pk2(y[j][2], y[j][3]); pk.z = pk2(y[j][4], y[j][5]); pk.w = pk2(y[j][6], y[j][7]); *(v4u*)(dst + 8 * j) = pk; }
            }
        }
        for (int rep_b = 0; rep_b < REP_S1B; ++rep_b) {
            const int hd = 8 * g + e;
            const float v = dtg[((size_t)b * T + t0 + lane) * 64 + hd] + dt_bias[layer * 16 + hd];
            const float dtv = v > 20.f ? v : log1pf(expf(v));
            const float a = -expf(a_log[layer * 16 + hd]);
            float cs = dtv * a;
#pragma unroll
            for (int off = 1; off < 64; off <<= 1) { const float up = __shfl_up(cs, off); if (lane >= off) cs += up; }
            const float cend = __shfl(cs, 63);
            dtb[(size_t)(b * 16 + hd) * T + t0 + lane] = dtv; acsb[(size_t)(b * 16 + hd) * T + t0 + lane] = cs;
            if (lane == 0) aend[(size_t)(b * 16 + hd) * SNC + c] = cend;
            SCL[e * 64 + lane] = dtv * fexp2((cend - cs) * LOG2E);
        }
        __syncthreads();
#pragma unroll
        for (int ps = 0; ps < 8; ++ps) { const int row = (F.tid >> 3) + 64 * ps, q8 = F.tid & 7;
            const v4u wv = *(const LAS v4u*)(XTL + row * 72 + 8 * q8);
            *(v4u*)(xt + ((size_t)(b * 16 + 8 * g) * 64 + row) * T + t0 + 8 * q8) = wv; }
        for (int rep_c = 0; rep_c < REP_S1C; ++rep_c)
#pragma unroll 1
        for (int nh = 0; nh < 2; ++nh) {
            f32x16 acc[2][2];
#pragma unroll
            for (int a = 0; a < 2; ++a)
#pragma unroll
                for (int q = 0; q < 2; ++q)
#pragma unroll
                    for (int i = 0; i < 16; ++i) acc[a][q][i] = 0.f;
#pragma unroll
            for (int s = 0; s < 4; ++s) {
                bf16x8 Af[2], Bf[2];
#pragma unroll
                for (int pt = 0; pt < 2; ++pt) Af[pt] = *(const LAS bf16x8*)(XTL + (e * 64 + 32 * pt + r) * 72 + 16 * s + 8 * h);
                const f32x4 sc0 = *(const LAS f32x4*)(SCL + e * 64 + 16 * s + 8 * h), sc1 = *(const LAS f32x4*)(SCL + e * 64 + 16 * s + 8 * h + 4);
#pragma unroll
                for (int nt = 0; nt < 2; ++nt) {
                    const v4u raw = *(const LAS v4u*)(BMTL + (64 * nh + 32 * nt + r) * 72 + 16 * s + 8 * h);
                    v4u w;
                    w.x = cvtpk(__uint_as_float(raw.x << 16) * sc0[0], __uint_as_float(raw.x & 0xffff0000u) * sc0[1]);
                    w.y = cvtpk(__uint_as_float(raw.y << 16) * sc0[2], __uint_as_float(raw.y & 0xffff0000u) * sc0[3]);
                    w.z = cvtpk(__uint_as_float(raw.z << 16) * sc1[0], __uint_as_float(raw.z & 0xffff0000u) * sc1[1]);
                    w.w = cvtpk(__uint_as_float(raw.w << 16) * sc1[2], __uint_as_float(raw.w & 0xffff0000u) * sc1[3]);
                    Bf[nt] = __builtin_bit_cast(bf16x8, w);
                }
#pragma unroll
                for (int pt = 0; pt < 2; ++pt)
#pragma unroll
                    for (int nt = 0; nt < 2; ++nt) acc[pt][nt] = MFMA32(Af[pt], Bf[nt], acc[pt][nt]);
            }
            bf16* sp = st + ((size_t)((b * SNC + c) * 16 + 8 * g + e) * 64) * 128 + 64 * nh + r;
#pragma unroll
            for (int pt = 0; pt < 2; ++pt)
#pragma unroll
                for (int nt = 0; nt < 2; ++nt)
#pragma unroll
                    for (int i = 0; i < 16; ++i) sp[(size_t)(32 * pt + (i & 3) + 8 * (i >> 2) + 4 * h) * 128 + 32 * nt] = (bf16)f2bf(acc[pt][nt][i]);
        }
        __syncthreads();
    }
}
__device__ __forceinline__ void m_ssd_s2(Frame& F) {
    const bf16* st = (const bf16*)(F.R + R_ST); const float* aend = (const float*)(F.R + R_AEND); bf16* hin = (bf16*)(F.R + R_HIN);
    for (int gid = F.vcu * NTHR + F.tid; gid < BATCH * 16 * 64 * 32; gid += F.G * NTHR) {
        const int n4 = gid & 31, p = (gid >> 5) & 63, hd = (gid >> 11) & 15, b = gid >> 15;
        f32x4 hv = (f32x4){0.f, 0.f, 0.f, 0.f};
        const size_t cstride = (size_t)16 * 64 * 128;
        size_t off = ((size_t)(b * SNC * 16 + hd) * 64 + p) * 128 + 4 * n4;
        size_t hoff = (size_t)(b * SNC * 16 + hd) * (64 * 128) + ((size_t)((p >> 5) * 8 + (n4 >> 2)) * 64 + 32 * ((n4 >> 1) & 1) + (p & 31)) * 8 + 4 * (n4 & 1);
#pragma unroll
        for (int c = 0; c < SNC; ++c) {
            v2u w; w.x = pk2(hv[0], hv[1]); w.y = pk2(hv[2], hv[3]);
            *(v2u*)(hin + hoff) = w; hoff += cstride;
            const float dec = fexp2(aend[(size_t)(b * 16 + hd) * SNC + c] * LOG2E);
            const v2u sw = *(const v2u*)(st + off);
            const f32x4 sv = (f32x4){__uint_as_float(sw.x << 16), __uint_as_float(sw.x & 0xffff0000u), __uint_as_float(sw.y << 16), __uint_as_float(sw.y & 0xffff0000u)};
            hv = hv * dec + sv; off += cstride;
        }
    }
}
__device__ __forceinline__ void m_ssd_s3(Frame& F, int layer, const float* d_skip) {
    const bf16* xt = (const bf16*)(F.R + R_XT); const bf16* bm = (const bf16*)(F.R + R_BM); const bf16* cm = (const bf16*)(F.R + R_CM); const float* dtb = (const float*)(F.R + R_DT); const float* acsb = (const float*)(F.R + R_ACS);
    const bf16* hin = (const bf16*)(F.R + R_HIN); const bf16* zb = (const bf16*)(F.R + R_Z); bf16* mixed = (bf16*)(F.R + R_MIXED);
    LAS unsigned char* const l3 = (LAS unsigned char*)F.lds;
    LAS float* DTL = (LAS float*)l3;
    LAS float* ACL = (LAS float*)(l3 + 2048);
    LAS float* SSQ = (LAS float*)(l3 + 4096);
    const int lane = F.lane, r = lane & 31, h = lane >> 5, e = F.wave;
    for (int item = F.vcu; item < BATCH * SNC * 2; item += F.G) {
        const int g = item & 1, c = (item >> 1) & (SNC - 1), b = item >> 6, t0 = c * SL, hd = 8 * g + e;
        DTL[e * 64 + lane] = dtb[(size_t)(b * 16 + hd) * T + t0 + lane];
        ACL[e * 64 + lane] = acsb[(size_t)(b * 16 + hd) * T + t0 + lane];
        f32x16 cbt[3], yo[2][2];
#pragma unroll
        for (int i = 0; i < 16; ++i) { cbt[0][i] = 0.f; cbt[1][i] = 0.f; cbt[2][i] = 0.f; yo[0][0][i] = 0.f; yo[0][1][i] = 0.f; yo[1][0][i] = 0.f; yo[1][1][i] = 0.f; }
        const bf16* bmp = bm + (size_t)((b * 2 + g) * SNC + c) * (64 * 128) + lane * 8;
        const bf16* cmp_ = cm + (size_t)((b * 2 + g) * SNC + c) * (64 * 128) + lane * 8;
        const bf16* hp = hin + (size_t)((b * SNC + c) * 16 + hd) * (64 * 128) + lane * 8;
#pragma unroll 2
        for (int k = 0; k < 8; ++k) {
            const bf16x8 b0 = *(const bf16x8*)(bmp + (size_t)k * 512), b1 = *(const bf16x8*)(bmp + (size_t)(8 + k) * 512);
            const bf16x8 c0 = *(const bf16x8*)(cmp_ + (size_t)k * 512), c1 = *(const bf16x8*)(cmp_ + (size_t)(8 + k) * 512);
            const bf16x8 h0 = *(const bf16x8*)(hp + (size_t)k * 512), h1 = *(const bf16x8*)(hp + (size_t)(8 + k) * 512);
            cbt[0] = MFMA32(b0, c0, cbt[0]); cbt[1] = MFMA32(b0, c1, cbt[1]); cbt[2] = MFMA32(b1, c1, cbt[2]);
            yo[0][0] = MFMA32(h0, c0, yo[0][0]); yo[0][1] = MFMA32(h0, c1, yo[0][1]); yo[1][0] = MFMA32(h1, c0, yo[1][0]); yo[1][1] = MFMA32(h1, c1, yo[1][1]);
        }
        __builtin_amdgcn_wave_barrier(); LDS_WAIT();
        const float Dk = d_skip[layer * 16 + hd];
        const float acl0 = ACL[e * 64 + r], acl1 = ACL[e * 64 + 32 + r];
        { const float e0 = fexp2(acl0 * LOG2E), e1 = fexp2(acl1 * LOG2E);
#pragma unroll
          for (int i = 0; i < 16; ++i) { yo[0][0][i] *= e0; yo[1][0][i] *= e0; yo[0][1][i] *= e1; yo[1][1][i] *= e1; } }
#pragma unroll
        for (int tl = 0; tl < 3; ++tl) {
            const int stl = tl == 2 ? 1 : 0, ltl = tl == 0 ? 0 : 1;
            const float al = ltl ? acl1 : acl0;
#pragma unroll
            for (int i = 0; i < 16; ++i) {
                const int sidx = 32 * stl + (i & 3) + 8 * (i >> 2) + 4 * h, lidx = 32 * ltl + r;
                const float as = ACL[e * 64 + sidx], ds = DTL[e * 64 + sidx];
                float v = sidx <= lidx ? cbt[tl][i] * fexp2((al - as) * LOG2E) * ds : 0.f;
                if (sidx == lidx) v += Dk;
                cbt[tl][i] = v;
            }
        }
        const bf16* xp = xt + ((size_t)(b * 16 + hd) * 64 + r) * T + t0 + 4 * h;
#pragma unroll
        for (int pt = 0; pt < 2; ++pt) {
            const bf16* xq = xp + (size_t)(32 * pt) * T;
#pragma unroll
            for (int k2 = 0; k2 < 2; ++k2) {
                const bf16x8 a0 = mk_frag(*(const v2u*)(xq + 16 * k2), *(const v2u*)(xq + 16 * k2 + 8));
                const bf16x8 a1 = mk_frag(*(const v2u*)(xq + 32 + 16 * k2), *(const v2u*)(xq + 32 + 16 * k2 + 8));
                yo[pt][0] = MFMA32(a0, acc_frag(cbt[0], k2), yo[pt][0]);
                yo[pt][1] = MFMA32(a0, acc_frag(cbt[1], k2), yo[pt][1]);
                yo[pt][1] = MFMA32(a1, acc_frag(cbt[2], k2), yo[pt][1]);
            }
        }
        float ssq[2] = {0.f, 0.f};
#pragma unroll
        for (int lt = 0; lt < 2; ++lt) {
            const bf16* zp = zb + ((size_t)b * T + t0 + 32 * lt + r) * 1024 + hd * 64 + 4 * h;
#pragma unroll
            for (int pt = 0; pt < 2; ++pt)
#pragma unroll
                for (int k = 0; k < 4; ++k) {
                    const v2u zz = *(const v2u*)(zp + 32 * pt + 8 * k);
                    const float z0 = __uint_as_float(zz.x << 16), z1 = __uint_as_float(zz.x & 0xffff0000u), z2 = __uint_as_float(zz.y << 16), z3 = __uint_as_float(zz.y & 0xffff0000u);
                    float v0 = yo[pt][lt][4 * k] * silu_f(z0), v1 = yo[pt][lt][4 * k + 1] * silu_f(z1), v2 = yo[pt][lt][4 * k + 2] * silu_f(z2), v3 = yo[pt][lt][4 * k + 3] * silu_f(z3);
                    yo[pt][lt][4 * k] = v0; yo[pt][lt][4 * k + 1] = v1; yo[pt][lt][4 * k + 2] = v2; yo[pt][lt][4 * k + 3] = v3;
                    ssq[lt] += (v0 * v0 + v1 * v1) + (v2 * v2 + v3 * v3);
                }
            ssq[lt] += __shfl_xor(ssq[lt], 32);
        }
        if (h == 0) { SSQ[e * 64 + r] = ssq[0]; SSQ[e * 64 + 32 + r] = ssq[1]; }
        __syncthreads();
#pragma unroll
        for (int lt = 0; lt < 2; ++lt) {
            float tot = 0.f;
#pragma unroll
            for (int w = 0; w < 8; ++w) tot += SSQ[w * 64 + 32 * lt + r];
            const float rs = rsqrtf(tot * (1.0f / 512.0f) + EPS);
            bf16* mp = mixed + ((size_t)b * T + t0 + 32 * lt + r) * D + 1024 + hd * 64 + 4 * h;
#pragma unroll
            for (int pt = 0; pt < 2; ++pt)
#pragma unroll
                for (int k = 0; k < 4; ++k) { v2u w; w.x = pk2(yo[pt][lt][4 * k] * rs, yo[pt][lt][4 * k + 1] * rs); w.y = pk2(yo[pt][lt][4 * k + 2] * rs, yo[pt][lt][4 * k + 3] * rs); *(v2u*)(mp + 32 * pt + 8 * k) = w; }
        }
        __syncthreads();
    }
}
__device__ __forceinline__ void m_norms2(Frame& F) {
    const float* onsa = (const float*)(F.R + R_ONSA); const float* osb = (const float*)(F.R + R_OSB); bf16* mixed = (bf16*)(F.R + R_MIXED);
    const int gw = F.vcu * NWAVES + F.wave, NGW = F.G * NWAVES, lane = F.lane;
    for (int w = gw; w < M * 2; w += NGW) {
        const int seg = w & 1, row = w >> 1;
        const float* src = (seg == 0 ? onsa : osb) + (size_t)row * 512;
        const f32x4 v0 = *((const f32x4*)src + lane), v1 = *((const f32x4*)src + 64 + lane);
        float sq = (v0[0] * v0[0] + v0[1] * v0[1]) + (v0[2] * v0[2] + v0[3] * v0[3]) + (v1[0] * v1[0] + v1[1] * v1[1]) + (v1[2] * v1[2] + v1[3] * v1[3]);
        sq = wave_sum(sq);
        const float rr = rsqrtf(sq * (1.0f / 512.0f) + EPS);
        bf16* dst = mixed + (size_t)row * D + seg * 512;
        v2u w0; w0.x = pk2(v0[0] * rr, v0[1] * rr); w0.y = pk2(v0[2] * rr, v0[3] * rr); *((v2u*)dst + lane) = w0;
        v2u w1; w1.x = pk2(v1[0] * rr, v1[1] * rr); w1.y = pk2(v1[2] * rr, v1[3] * rr); *((v2u*)dst + 64 + lane) = w1;
    }
}
__device__ __forceinline__ void p_quant_x(Frame& F) {
    const int gw = F.vcu * NWAVES + F.wave, NGW = F.G * NWAVES, lane = F.lane;
    float* xsc = (float*)(F.ws + WS_TAB + TAB_XS);
    for (int m = gw; m < M; m += 2 * NGW) {
        const int m2 = m + NGW; const bool two = m2 < M;
        const f32x4* xr = (const f32x4*)(F.out + (size_t)m * D) + lane; const f32x4* xr2 = (const f32x4*)(F.out + (size_t)(two ? m2 : m) * D) + lane;
        f32x4 v[8], w[8]; float mx = 0.f, mx2 = 0.f;
#pragma unroll
        for (int j = 0; j < 8; ++j) { v[j] = xr[64 * j]; w[j] = xr2[64 * j]; }
#pragma unroll
        for (int j = 0; j < 8; ++j) { mx = fmaxf(fmaxf(mx, fmaxf(fabsf(v[j][0]), fabsf(v[j][1]))), fmaxf(fabsf(v[j][2]), fabsf(v[j][3])));
                                      mx2 = fmaxf(fmaxf(mx2, fmaxf(fabsf(w[j][0]), fabsf(w[j][1]))), fmaxf(fabsf(w[j][2]), fabsf(w[j][3]))); }
        mx = fmaxf(wave_max(mx), 1e-30f); mx2 = fmaxf(wave_max(mx2), 1e-30f);
        const float inv = 127.0f / mx, inv2 = 127.0f / mx2;
        unsigned* o = (unsigned*)(F.ws + WS_XB + (size_t)m * D) + lane;
#pragma unroll
        for (int j = 0; j < 8; ++j) o[64 * j] = pk4_i8(v[j][0] * inv, v[j][1] * inv, v[j][2] * inv, v[j][3] * inv);
        if (lane == 0) xsc[m] = mx * (1.0f / 127.0f);
        if (two) {
            unsigned* o2 = (unsigned*)(F.ws + WS_XB + (size_t)m2 * D) + lane;
#pragma unroll
            for (int j = 0; j < 8; ++j) o2[64 * j] = pk4_i8(w[j][0] * inv2, w[j][1] * inv2, w[j][2] * inv2, w[j][3] * inv2);
            if (lane == 0) xsc[m2] = mx2 * (1.0f / 127.0f);
        }
    }
}
__device__ __forceinline__ void p_final(Frame& F, const float* gain) {
    const u64* ssf = ssptr(F, 6);
    const int gw = F.vcu * NWAVES + F.wave, NGW = F.G * NWAVES, lane = F.lane;
    for (int m = gw; m < M; m += NGW) {
        const float r = rstd_of(ssf[m]);
        f32x4* xr = (f32x4*)(F.out + (size_t)m * D) + lane;
#pragma unroll
        for (int j = 0; j < 8; ++j) { const f32x4 g = *((const f32x4*)gain + 64 * j + lane); f32x4 v = xr[64 * j]; v = v * r * g; xr[64 * j] = v; }
    }
}

#define SEG_BODY(SEGNO) do { constexpr int seg = (SEGNO); \
        const int layer = seg >> 1, second = seg & 1; \
        if (IN_PH()) { \
            FRAME(); \
            { pg8::Gemm g{(const bf16*)(F.ws + WS_XB), wptr(F, layer, second ? WL_GU2 : WL_GU1), M, NGU, (gu8(seg) || gui8(seg)) ? D / 2 : D}; pg8::StaticOrder S; S.init(M, NGU, F.G, F.vcu); \
            EpiGateUp E{(bf16*)(F.R + R_H), ssptr(F, 3 * layer + (second ? 2 : 0)), gui8(seg) ? __uint_as_float(((const unsigned*)F.ctlf)[CW_WMAX]) * (1.0f / 127.0f) : (gu8(seg) ? GU8_UNSCALE : 1.0f), dn8(seg) ? 1 : 0, \
                        (const float*)(F.ws + WS_TAB + TAB_XS), gui8(seg) ? 1 : 0}; \
            REPEAT(REP_GU, pg8::gemm_phase<EpiGateUp, pg8::StaticOrder, true, GEMM_SP2, gui8(seg) ? 2 : (gu8(seg) ? 1 : 0)>(glds, g, S, E)); } \
            if (CVM_GU[seg] != 0u && F.vcu >= F.G / 2) { \
                KArgs kb = kargs(); Frame F2 = make_frame(kb->ws, kb->out, lds); \
                ProIn I{kb->in[0], kb->in[1], kb->in[2], kb->in[3], kb->in[4], kb->in[5], kb->in[6], kb->in[7], kb->in[8], kb->in[11], kb->in[12], kb->in[18], kb->in[19], kb->in[20], kb->in[21], kb->in[22], kb->in[9], kb->in[10]}; \
                convert_weights<CVM_GU[seg]>(F2, I, (F2.vcu - F2.G / 2) * NWAVES + F2.wave, (F2.G / 2) * NWAVES); \
            } \
        } \
        END_PH(); \
        if (IN_PH()) { \
            FRAME(); \
            pg8::Gemm g{(const bf16*)(F.R + R_H), wptr(F, layer, second ? WL_DN2 : WL_DN1), M, D, dn8(seg) ? FF / 2 : FF}; pg8::StaticOrder S; S.init(M, D, F.G, F.vcu); \
            if (FUSE_X && seg == 3) { \
                EpiResidFin E{(const float*)F.out, F.out, INP(23), dn8(seg) ? 0.5f * DN8_UNSCALE : 0.5f, PanelX{(float*)(F.ws + WS_TAB + TAB_PX) + (size_t)M * 8, (unsigned*)F.ctlf + CW_PX + 2048}}; \
                pg8::gemm_phase<EpiResidFin, pg8::StaticOrder, true, GEMM_SP2, dn8(seg) ? 1 : 0>(glds, g, S, E); \
            } else if (FUSE_X && !second && wini8(layer)) { \
                EpiResidQ8 E{seg == 0 ? INP(0) : (const float*)F.out, F.out, (unsigned char*)(F.ws + WS_XB), (float*)(F.ws + WS_TAB + TAB_XS), ssptr(F, 3 * layer + 1), dn8(seg) ? 0.5f * DN8_UNSCALE : 0.5f, \
                             PanelX{(float*)(F.ws + WS_TAB + TAB_PX), (unsigned*)F.ctlf + CW_PX}}; \
                pg8::gemm_phase<EpiResidQ8, pg8::StaticOrder, true, GEMM_SP2, dn8(seg) ? 1 : 0>(glds, g, S, E); \
            } else { \
            EpiResid E{seg == 0 ? INP(0) : (const float*)F.out, F.out, (bf16*)(F.ws + WS_XB), ssptr(F, second ? 3 * (layer + 1) : 3 * layer + 1), dn8(seg) ? 0.5f * DN8_UNSCALE : 0.5f, (second && gu8(seg + 1)) ? 1 : ((!second && wini8(layer)) ? 2 : 0)}; \
            pg8::gemm_phase<EpiResid, pg8::StaticOrder, true, GEMM_SP2, dn8(seg) ? 1 : 0>(glds, g, S, E); } \
        } \
        END_PH(); \
        if (!second) { \
            if (wini8(layer) && !FUSE_X) { \
                if (IN_PH()) { FRAME(); p_quant_x(F); } \
                END_PH(); \
            } \
            if (IN_PH()) { \
                FRAME(); \
                { pg8::Gemm g{(const bf16*)(F.ws + WS_XB), wptr(F, layer, WL_IN), M, NIN, wini8(layer) ? D / 2 : D}; pg8::StaticOrder S; S.init(M, NIN, F.G, F.vcu); \
                EpiWin E{F.R, ssptr(F, 3 * layer + 1), (const float*)(F.ws + WS_TAB + TAB_XS), wini8(layer) ? __uint_as_float(((const unsigned*)F.ctlf)[CW_WMAX + 1 + layer]) * (1.0f / 127.0f) : 1.0f, wini8(layer) ? 1 : 0}; \
                REPEAT(REP_WIN, pg8::gemm_phase<EpiWin, pg8::StaticOrder, true, GEMM_SP2, wini8(layer) ? 2 : 0>(glds, g, S, E)); } \
                if (CVM_WIN[layer] != 0u && F.vcu >= (F.G * 3) / 4) { \
                    KArgs kb = kargs(); Frame F2 = make_frame(kb->ws, kb->out, lds); \
                    ProIn I{kb->in[0], kb->in[1], kb->in[2], kb->in[3], kb->in[4], kb->in[5], kb->in[6], kb->in[7], kb->in[8], kb->in[11], kb->in[12], kb->in[18], kb->in[19], kb->in[20], kb->in[21], kb->in[22], kb->in[9], kb->in[10]}; \
                    convert_weights<CVM_WIN[layer]>(F2, I, (F2.vcu - (F2.G * 3) / 4) * NWAVES + F2.wave, (F2.G / 4) * NWAVES); \
                } \
            } \
            END_PH(); \
            if (IN_PH()) { FRAME(); REPEAT(REP_M1, REPEAT(REP_CMP, m_compress(F, layer)); REPEAT(REP_S1, m_ssd_s1(F, layer, INP(13), INP(14), INP(15), INP(16))); REPEAT(REP_SB, m_sb(F))); } \
            END_PH(); \
            if (IN_PH()) { FRAME(); REPEAT(REP_M2, REPEAT(REP_S2, m_ssd_s2(F)); REPEAT(REP_NSA, m_nsa(F))); } \
            END_PH(); \
            if (IN_PH()) { FRAME(); REPEAT(REP_M3, REPEAT(REP_S3, m_ssd_s3(F, layer, INP(17))); REPEAT(REP_N2, m_norms2(F))); } \
            END_PH(); \
             \
            if (IN_PH()) { \
                FRAME(); \
                pg8::Gemm g{(const bf16*)(F.R + R_MIXED), wptr(F, layer, WL_OUT), M, D, D}; pg8::StaticOrder S; S.init(M, D, F.G, F.vcu); \
                EpiResid E{F.out, F.out, (bf16*)(F.ws + WS_XB), ssptr(F, 3 * layer + 2), 1.0f, gu8(seg + 1) ? 1 : 0}; \
                pg8::gemm_phase<EpiResid, pg8::StaticOrder, true, GEMM_SP2>(glds, g, S, E); \
            } \
            END_PH(); \
        } \
     \
    } while (0)
__global__ void __launch_bounds__(NTHR, 2) mega_fwd(Args args) {
    extern __shared__ __attribute__((aligned(16))) unsigned char lds[];
    volatile LAS unsigned* MISC = (volatile LAS unsigned*)((LAS unsigned char*)lds + MISC_OFF);
    if (threadIdx.x < 64) MISC[threadIdx.x] = 0u;
    __syncthreads();
    if (MK_ONE_LAUNCH) (void)xcd_barrier_post((unsigned*)(args.ws + WS_CTL) + CW_BAR, MISC + 8);
    int pc = 0;
#define IN_PH() ({ KArgs _k = kargs(); (_k->ph_lo <= pc && pc < _k->ph_hi); })
#define END_PH() do { KArgs _k = kargs(); \
        if (MK_ONE_LAUNCH && pc + 1 < _k->ph_hi && pc >= _k->ph_lo) { XcdBarrier _b; _b.bar = (unsigned*)(_k->ws + WS_CTL) + CW_BAR; _b.x = xb_xcc_id(); _b.st = MISC + 8; xcd_barrier(_b); } \
        ++pc; } while (0)
#define FRAME() KArgs ka = kargs(); Frame F = make_frame(ka->ws, ka->out, lds)
#define INP(k) (ka->in[k])
    LAS unsigned char* glds = (LAS unsigned char*)lds;

    if (IN_PH()) { FRAME();
        ProIn I{INP(0), INP(1), INP(2), INP(3), INP(4), INP(5), INP(6), INP(7), INP(8), INP(11), INP(12), INP(18), INP(19), INP(20), INP(21), INP(22), INP(9), INP(10)};
        REPEAT(REP_PRO, REPEAT(REP_PA, p_prologue(F, I))); }
    END_PH();
    if (IN_PH()) { FRAME();
        ProIn I{INP(0), INP(1), INP(2), INP(3), INP(4), INP(5), INP(6), INP(7), INP(8), INP(11), INP(12), INP(18), INP(19), INP(20), INP(21), INP(22), INP(9), INP(10)};
        REPEAT(REP_PRO, REPEAT(REP_PB, p_prologue_b(F, I))); }
    END_PH();
    SEG_BODY(0); SEG_BODY(1); SEG_BODY(2); SEG_BODY(3);
    if (!FUSE_X) {
    if (IN_PH()) { FRAME(); p_final(F, INP(23)); }
    END_PH();
    }
#undef IN_PH
#undef END_PH
#undef FRAME
#undef INP
#undef SEG_BODY
}
constexpr int N_PHASES = 2 + 4 * 2 + 2 * 5 + (FUSE_X ? 0 : (wini8(0) ? 1 : 0) + (wini8(1) ? 1 : 0) + 1);

extern "C" void kernel_launch(void* const* d_in, const int* in_sizes, int n_in, void* d_out, int out_size, void* d_ws, size_t ws_size, hipStream_t stream) {
    static int grid = 0;
    if (grid == 0) {
        if (n_in != 24 || in_sizes[0] != M * D || out_size != M * D || ws_size < WS_END) {
            fprintf(stderr, "kernel_launch: shape/workspace mismatch: n_in %d in0 %d out %d ws %zu (need %zu); nothing launched\n", n_in, n_in > 0 ? in_sizes[0] : -1, out_size, ws_size, (size_t)WS_END);
            grid = -1; return; }
        int dev = 0, cus = 0, per_cu = 0;
        if (hipGetDevice(&dev) != hipSuccess || hipDeviceGetAttribute(&cus, hipDeviceAttributeMultiprocessorCount, dev) != hipSuccess) { grid = -1; return; }
        if (hipFuncSetAttribute((const void*)mega_fwd, hipFuncAttributeMaxDynamicSharedMemorySize, LDS_BYTES) != hipSuccess) { fprintf(stderr, "kernel_launch: hipFuncSetAttribute failed\n"); grid = -1; return; }
        if (hipOccupancyMaxActiveBlocksPerMultiprocessor(&per_cu, (const void*)mega_fwd, NTHR, LDS_BYTES) != hipSuccess || per_cu < 1) { fprintf(stderr, "kernel_launch: occupancy query reports %d\n", per_cu); }
        (void)hipGetLastError();
        if (FUSE_X && cus != 256) { fprintf(stderr, "kernel_launch: the fused down-GEMM epilogues need exactly 256 workgroups (one output tile each), this device has %d CUs; nothing launched\n", cus); grid = -1; return; }
        grid = cus;
    }
    if (grid < 0) return;
    (void)hipMemsetAsync((char*)d_ws + WS_CTL, 0, CTL_ZERO_BYTES, stream);
    Args a{};
    for (int i = 0; i < 24; ++i) a.in[i] = (const float*)d_in[i];
    a.out = (float*)d_out; a.ws = (unsigned char*)d_ws;
#if MK_ONE_LAUNCH
    a.ph_lo = 0; a.ph_hi = N_PHASES;
    hipLaunchKernelGGL(mega_fwd, dim3(grid), dim3(NTHR), LDS_BYTES, stream, a);
#else
    for (int p = 0; p < N_PHASES; ++p) { a.ph_lo = p; a.ph_hi = p + 1; hipLaunchKernelGGL(mega_fwd, dim3(grid), dim3(NTHR), LDS_BYTES, stream, a); }
#endif
}
```

```cpp
#include <hip/hip_runtime.h>
#include <cstdio>
#include <cstdint>

#ifndef GEMM_SP2
#define GEMM_SP2 true
#endif
#ifndef REP_PRO
#define REP_PRO 1
#endif
#ifndef REP_GU
#define REP_GU 1
#endif
#ifndef REP_WIN
#define REP_WIN 1
#endif
#ifndef REP_M1
#define REP_M1 1
#endif
#ifndef REP_M2
#define REP_M2 1
#endif
#ifndef REP_M3
#define REP_M3 1
#endif
#ifndef REP_CMP
#define REP_CMP 1
#endif
#ifndef REP_S1
#define REP_S1 1
#endif
#ifndef REP_SB
#define REP_SB 1
#endif
#ifndef REP_S2
#define REP_S2 1
#endif
#ifndef REP_NSA
#define REP_NSA 1
#endif
#ifndef REP_S1A
#define REP_S1A 1
#endif
#ifndef REP_S1B
#define REP_S1B 1
#endif
#ifndef REP_S1C
#define REP_S1C 1
#endif
#ifndef REP_CMPA
#define REP_CMPA 1
#endif
#ifndef REP_CMPB
#define REP_CMPB 1
#endif
#ifndef REP_S3
#define REP_S3 1
#endif
#ifndef REP_N2
#define REP_N2 1
#endif
#ifndef REP_PA
#define REP_PA 1
#endif
#ifndef REP_PB
#define REP_PB 1
#endif
#ifndef REP_AMAX
#define REP_AMAX 1
#endif
#define REPEAT(N, ...) do { __VA_ARGS__; if ((N) > 1) { __VA_ARGS__; } } while (0)
#ifndef GU8_MASK
#define GU8_MASK 0xE
#endif
#ifndef GU_I8
#define GU_I8 1
#endif
#ifndef FUSE_X
#define FUSE_X 1
#endif
#ifndef WIN_I8
#define WIN_I8 2
#endif
#ifndef DN8_MASK
#define DN8_MASK 0xF
#endif
#ifndef MK_ONE_LAUNCH
#define MK_ONE_LAUNCH 1
#endif

namespace pg8 {
#define PG8_LAS __attribute__((address_space(3)))
typedef unsigned short bf16_t;
typedef short bf16x8 __attribute__((ext_vector_type(8)));
typedef float f32x4 __attribute__((ext_vector_type(4)));
typedef unsigned u32x4 __attribute__((ext_vector_type(4)));
typedef int i32x4 __attribute__((ext_vector_type(4)));
typedef int i32x8 __attribute__((ext_vector_type(8)));
constexpr int BM = 256, BK = 64, HALF = 128, HTB = HALF * BK * 2  , STAGE_BYTES = 8 * HTB, NXCD = 8, WGM = 8;

__host__ __device__ __forceinline__ int lds_byte(int r, int c) { const int st = (r >> 4) * 2 + (c >> 5), rr = r & 15, cc = c & 31, ob = rr * 64 + cc * 2; return st * 1024 + (ob ^ (((ob >> 9) & 1) << 5)); }
__host__ __device__ __forceinline__ void stage_rc(int b, int& R, int& C) { const int st = b / 1024, sb = b % 1024, swz = sb ^ (((sb >> 9) & 1) << 5); R = (st >> 1) * 16 + swz / 64; C = (st & 1) * 32 + (swz % 64) / 2; }
__host__ __device__ __forceinline__ int perm32(int rho) { const int n = rho >> 4, i = rho & 15; return 8 * (i >> 2) + 4 * n + (i & 3); }

struct Unit { int pm, pn; };
struct Gemm { const bf16_t* A; const bf16_t* Bt; int M, N, K; };

struct StaticOrder {
    int nM, nN, nwg, G, c;
    __host__ __device__ void init(int M, int N, int G_, int c_) { nM = M / BM; nN = N / BM; nwg = nM * nN; G = G_; c = c_; }
    __host__ __device__ bool next(int i, Unit& u) const {
        const long L = (long)i * G + c; if (L >= nwg) return false;
        int wgid = (int)L; { const int q = nwg / NXCD, r = nwg % NXCD, xcd = wgid % NXCD, off = wgid / NXCD; wgid = (xcd < r ? xcd * (q + 1) : r * (q + 1) + (xcd - r) * q) + off; }
        const int nig = WGM * nN, gid = wgid / nig, fm = gid * WGM, gsz = (nM - fm) < WGM ? (nM - fm) : WGM;
        u.pm = fm + ((wgid % nig) % gsz); u.pn = (wgid % nig) / gsz; return true;
    }
    __device__ __forceinline__ void a_ready(const Unit&) const {}
    __device__ __forceinline__ void done(const Unit&) const {}
};

__device__ __forceinline__ unsigned cvt_pk_bf16(float lo, float hi) { unsigned r; asm volatile("v_cvt_pk_bf16_f32 %0, %1, %2" : "=v"(r) : "v"(lo), "v"(hi)); return r; }

template <class Epi, class Sched, bool ALIGN_EPI = false, bool SP2 = false, int QM = 0>
__device__ __forceinline__ void gemm_phase(PG8_LAS unsigned char* lds, const Gemm g, const Sched& S, const Epi& E) {
    constexpr bool FP8 = (QM == 1);
    int tid = threadIdx.x; asm volatile("" : "+v"(tid));
    const int wid = __builtin_amdgcn_readfirstlane(tid >> 6), lane = tid & 63, wr = wid >> 2, wc = wid & 3, fr = lane & 15, fq = lane >> 4;
    const int K = g.K, nt = K / BK;
    unsigned voffA[2], voffB[2];
#pragma unroll
    for (int i = 0; i < 2; ++i) { int R, C; stage_rc(tid * 16 + i * 8192, R, C); const int Rb = Epi::PERM ? ((R & ~31) + perm32(R & 31)) : R;
        voffA[i] = (unsigned)(R * K + C) * 2u; voffB[i] = (unsigned)(Rb * K + C) * 2u; }
    const size_t kstep = (size_t)(BK * 2);
    const size_t hstep = (size_t)HALF * K * 2;
    const size_t tstep = 2 * hstep;
    const unsigned ldsw = (unsigned)wid * 1024u;
    const int aoff = lds_byte(wr * 64 + fr, fq * 8), boff = lds_byte(wc * 32 + fr, fq * 8);
#define PG8_SA(b, h) (((b) * 2 + (h)) * HTB)
#define PG8_SB(b, h) ((4 + (b) * 2 + (h)) * HTB)
#define PG8_STAGE(bufoff, gbase, voff) do { _Pragma("unroll") for (int _i = 0; _i < 2; ++_i) \
        __builtin_amdgcn_global_load_lds((const unsigned*)((const char*)(gbase) + (voff)[_i]), (PG8_LAS unsigned*)(lds + (bufoff) + ldsw + _i * 8192), 16, 0, 0); } while (0)
#define PG8_LDA(dst, b, h) do { _Pragma("unroll") for (int m = 0; m < 4; ++m) { if constexpr (FP8) { dst##8[m] = __builtin_shufflevector(*(const PG8_LAS i32x4*)(lds + PG8_SA(b, h) + aoff + m * 2048), *(const PG8_LAS i32x4*)(lds + PG8_SA(b, h) + aoff + m * 2048 + 1024), 0, 1, 2, 3, 4, 5, 6, 7); } \
        else { _Pragma("unroll") for (int k = 0; k < 2; ++k) dst[m][k] = *(const PG8_LAS bf16x8*)(lds + PG8_SA(b, h) + aoff + m * 2048 + k * 1024); } } } while (0)
#define PG8_LDB(dst, b, h) do { _Pragma("unroll") for (int n = 0; n < 2; ++n) { if constexpr (FP8) { dst##8[n] = __builtin_shufflevector(*(const PG8_LAS i32x4*)(lds + PG8_SB(b, h) + boff + n * 2048), *(const PG8_LAS i32x4*)(lds + PG8_SB(b, h) + boff + n * 2048 + 1024), 0, 1, 2, 3, 4, 5, 6, 7); } \
        else { _Pragma("unroll") for (int k = 0; k < 2; ++k) dst[n][k] = *(const PG8_LAS bf16x8*)(lds + PG8_SB(b, h) + boff + n * 2048 + k * 1024); } } } while (0)
#define PG8_MMA(ai, bj, At, Bt) do { __builtin_amdgcn_s_setprio(1); _Pragma("unroll") for (int m = 0; m < 4; ++m) _Pragma("unroll") for (int n = 0; n < 2; ++n) { \
        if constexpr (FP8) { asm("v_mfma_f32_16x16x128_f8f6f4 %0, %1, %2, %0" : "+v"(acc[ai][bj][m][n]) : "v"(Bt##8[n]), "v"(At##8[m])); }   \
        else if constexpr (QM == 2) { _Pragma("unroll") for (int k = 0; k < 2; ++k) acc[ai][bj][m][n] = __builtin_bit_cast(f32x4, __builtin_amdgcn_mfma_i32_16x16x64_i8(__builtin_bit_cast(i32x4, Bt[n][k]), __builtin_bit_cast(i32x4, At[m][k]), __builtin_bit_cast(i32x4, acc[ai][bj][m][n]), 0, 0, 0)); }   \
        else { _Pragma("unroll") for (int k = 0; k < 2; ++k) acc[ai][bj][m][n] = __builtin_amdgcn_mfma_f32_16x16x32_bf16(Bt[n][k], At[m][k], acc[ai][bj][m][n], 0, 0, 0); } } \
        __builtin_amdgcn_s_setprio(0); } while (0)
#define PG8_WAIT_V(n) asm volatile("s_waitcnt vmcnt(" #n ")" ::: "memory")
#define PG8_WAIT_L(n) asm volatile("s_waitcnt lgkmcnt(" #n ")" ::: "memory")
#define PG8_BAR __builtin_amdgcn_s_barrier()
#define PG8_SCHED __builtin_amdgcn_sched_barrier(0)
    Unit cur, nxt; int ui = 0;
    if (!S.next(0, cur)) return;
    f32x4 acc[2][2][4][2];
#pragma unroll
    for (int a = 0; a < 2; ++a)
#pragma unroll
        for (int b = 0; b < 2; ++b)
#pragma unroll
            for (int m = 0; m < 4; ++m)
#pragma unroll
                for (int n = 0; n < 2; ++n) acc[a][b][m][n] = (f32x4){0.f, 0.f, 0.f, 0.f};
    bf16x8 At[4][2], B0[2][2], B1[2][2]; i32x8 At8[4], B08[2], B18[2];
    const char* cA = (const char*)g.A + (size_t)cur.pm * tstep; const char* cB = (const char*)g.Bt + (size_t)cur.pn * tstep;
    S.a_ready(cur);
    if constexpr (SP2) {
        PG8_STAGE(PG8_SB(0, 0), cB, voffB); PG8_STAGE(PG8_SB(0, 1), cB + hstep, voffB); PG8_STAGE(PG8_SA(0, 0), cA, voffA); PG8_STAGE(PG8_SA(0, 1), cA + hstep, voffA);
        if (wr == 1) PG8_BAR;
        PG8_WAIT_V(2); PG8_BAR;
        PG8_STAGE(PG8_SB(1, 0), cB + kstep, voffB); PG8_STAGE(PG8_SA(1, 0), cA + kstep, voffA); PG8_STAGE(PG8_SB(1, 1), cB + hstep + kstep, voffB);
        PG8_WAIT_V(6); PG8_BAR;
    } else {
        PG8_STAGE(PG8_SB(0, 0), cB, voffB); PG8_STAGE(PG8_SA(0, 0), cA, voffA); PG8_STAGE(PG8_SB(0, 1), cB + hstep, voffB); PG8_STAGE(PG8_SA(0, 1), cA + hstep, voffA);
        if (wr == 1) PG8_BAR;
        PG8_WAIT_V(4); PG8_BAR;
        PG8_STAGE(PG8_SB(1, 0), cB + kstep, voffB); PG8_STAGE(PG8_SA(1, 0), cA + kstep, voffA); PG8_STAGE(PG8_SB(1, 1), cB + hstep + kstep, voffB);
        PG8_WAIT_V(6); PG8_BAR;
    }
    for (;;) {
        const bool has_next = S.next(ui + 1, nxt);
        const char* nA = has_next ? (const char*)g.A + (size_t)nxt.pm * tstep : cA; const char* nB = has_next ? (const char*)g.Bt + (size_t)nxt.pn * tstep : cB;
        for (int t = 0; t < nt; t += 2) {
            const bool last = (t == nt - 2);
            const char* a1 = cA + (size_t)(t + 1) * kstep;
            const char* a2 = last ? nA : cA + (size_t)(t + 2) * kstep; const char* b2 = last ? nB : cB + (size_t)(t + 2) * kstep;
            const char* a3 = a2 + kstep; const char* b3 = b2 + kstep;
            if (last && has_next) S.a_ready(nxt);
            if constexpr (SP2) {
            PG8_LDB(B0, 0, 0); PG8_LDB(B1, 0, 1); PG8_SCHED; PG8_LDA(At, 0, 0); PG8_STAGE(PG8_SA(1, 1), a1 + hstep, voffA);
            PG8_WAIT_V(8); PG8_WAIT_L(0); PG8_BAR; PG8_MMA(0, 0, At, B0); PG8_MMA(0, 1, At, B1); PG8_BAR; PG8_SCHED;
            PG8_LDA(At, 0, 1); PG8_STAGE(PG8_SB(0, 0), b2, voffB); PG8_STAGE(PG8_SB(0, 1), b2 + hstep, voffB); PG8_STAGE(PG8_SA(0, 0), a2, voffA);
            PG8_WAIT_V(8); PG8_WAIT_L(0); PG8_BAR; PG8_MMA(1, 0, At, B0); PG8_MMA(1, 1, At, B1); PG8_BAR; PG8_SCHED;
            PG8_LDB(B0, 1, 0); PG8_LDB(B1, 1, 1); PG8_SCHED; PG8_LDA(At, 1, 0); PG8_STAGE(PG8_SA(0, 1), a2 + hstep, voffA);
            PG8_WAIT_V(8); PG8_WAIT_L(0); PG8_BAR; PG8_MMA(0, 0, At, B0); PG8_MMA(0, 1, At, B1); PG8_BAR; PG8_SCHED;
            PG8_LDA(At, 1, 1); PG8_STAGE(PG8_SB(1, 0), b3, voffB); PG8_STAGE(PG8_SB(1, 1), b3 + hstep, voffB); PG8_STAGE(PG8_SA(1, 0), a3, voffA);
            PG8_WAIT_V(8); PG8_WAIT_L(0); PG8_BAR; PG8_MMA(1, 0, At, B0); PG8_MMA(1, 1, At, B1); PG8_BAR; PG8_SCHED;
            } else {
            PG8_LDB(B0, 0, 0); PG8_SCHED; PG8_LDA(At, 0, 0); PG8_STAGE(PG8_SA(1, 1), a1 + hstep, voffA);
            PG8_WAIT_L(8); PG8_BAR; PG8_WAIT_L(0); PG8_MMA(0, 0, At, B0); PG8_BAR; PG8_SCHED;
            PG8_LDB(B1, 0, 1); PG8_STAGE(PG8_SB(0, 0), b2, voffB);
            PG8_BAR; PG8_WAIT_L(0); PG8_MMA(0, 1, At, B1); PG8_BAR;
            PG8_LDA(At, 0, 1); PG8_STAGE(PG8_SA(0, 0), a2, voffA);
            PG8_BAR; PG8_WAIT_L(0); PG8_MMA(1, 0, At, B0); PG8_BAR; PG8_SCHED;
            PG8_STAGE(PG8_SB(0, 1), b2 + hstep, voffB);
            PG8_WAIT_V(6); PG8_BAR; PG8_MMA(1, 1, At, B1); PG8_BAR;
            PG8_LDB(B0, 1, 0); PG8_SCHED; PG8_LDA(At, 1, 0); PG8_STAGE(PG8_SA(0, 1), a2 + hstep, voffA);
            PG8_WAIT_L(8); PG8_BAR; PG8_WAIT_L(0); PG8_MMA(0, 0, At, B0); PG8_BAR; PG8_SCHED;
            PG8_LDB(B1, 1, 1); PG8_STAGE(PG8_SB(1, 0), b3, voffB);
            PG8_BAR; PG8_WAIT_L(0); PG8_MMA(0, 1, At, B1); PG8_BAR;
            PG8_LDA(At, 1, 1); PG8_STAGE(PG8_SA(1, 0), a3, voffA);
            PG8_BAR; PG8_WAIT_L(0); PG8_MMA(1, 0, At, B0); PG8_BAR; PG8_SCHED;
            PG8_STAGE(PG8_SB(1, 1), b3 + hstep, voffB);
            PG8_WAIT_V(6); PG8_BAR; PG8_MMA(1, 1, At, B1); PG8_BAR;
            }
        }
        if constexpr (ALIGN_EPI) { if (wr == 0) PG8_BAR; }
        if constexpr (!Epi::AFTER_DRAIN) E(acc, cur, wr, wc, fr, fq);
        S.done(cur);
        if (!has_next) break;
#pragma unroll
        for (int a = 0; a < 2; ++a)
#pragma unroll
            for (int b = 0; b < 2; ++b)
#pragma unroll
                for (int m = 0; m < 4; ++m)
#pragma unroll
                    for (int n = 0; n < 2; ++n) acc[a][b][m][n] = (f32x4){0.f, 0.f, 0.f, 0.f};
        cur = nxt; cA = nA; cB = nB; ++ui;
        if constexpr (ALIGN_EPI) { if (wr == 1) PG8_BAR; }
    }
    PG8_WAIT_V(0);
    if constexpr (!ALIGN_EPI) { if (wr == 0) PG8_BAR; }
    PG8_BAR;
    if constexpr (Epi::AFTER_DRAIN) E.fused(acc, cur, wr, wc, fr, fq, lds);
#undef PG8_SA
#undef PG8_SB
#undef PG8_STAGE
#undef PG8_LDA
#undef PG8_LDB
#undef PG8_MMA
#undef PG8_WAIT_V
#undef PG8_WAIT_L
#undef PG8_BAR
#undef PG8_SCHED
}
}

constexpr int NWAVES = 8, NTHR = 512;
constexpr int BATCH = 4, T = 2048, M = BATCH * T, D = 2048, FF = 5632, DEPTH = 2;
constexpr int NIN_SRC = 5416, NIN = 5632;
constexpr int NGU = 2 * FF;
constexpr float EPS = 1e-6f;
constexpr float LOG2E = 1.4426950408889634f;
constexpr float QSCALE = 0.125f * LOG2E;
constexpr int NSS = 7;

constexpr size_t MiB = 1u << 20;
constexpr size_t WS_CTL = 0, CTL_ZERO_BYTES = 1 * MiB;
constexpr int CW_TMO = 0, CW_BAR = 4096, CW_PX = 8192  , CW_SS = 16384;
static_assert((CW_SS + 2 * NSS * M) * 4 <= (int)CTL_ZERO_BYTES, "ctl");
typedef unsigned long long u64;
constexpr float SS_SCALE = 1048576.0f, SS_INV = 1.0f / 1048576.0f;
constexpr size_t WS_TAB = 1 * MiB;
constexpr size_t WS_W = 2 * MiB;
constexpr size_t W_GU = (size_t)NGU * D * 2, W_DN = (size_t)D * FF * 2, W_IN = (size_t)NIN * D * 2, W_OUT = (size_t)D * D * 2;
constexpr size_t WL_GU1 = 0, WL_DN1 = WL_GU1 + W_GU, WL_IN = WL_DN1 + W_DN, WL_OUT = WL_IN + W_IN, WL_GU2 = WL_OUT + W_OUT, WL_DN2 = WL_GU2 + W_GU, WL_SIZE = WL_DN2 + W_DN;
static_assert(WL_SIZE == 162 * MiB, "weights per layer");
constexpr size_t WS_XB = WS_W + DEPTH * WL_SIZE;
constexpr size_t WS_CW = WS_XB + (size_t)M * D * 2;
constexpr size_t WS_R = WS_CW + 1 * MiB;
constexpr size_t TAB_PB = 8192;
constexpr size_t R_H = 0;
constexpr size_t R_QN = 0, R_QS = R_QN + 8 * MiB, R_KS = R_QS + 8 * MiB, R_KN = R_KS + 8 * MiB, R_CMPRAW = R_KN + 4 * MiB, R_VNT = R_CMPRAW + 8 * MiB,
                 R_VST = R_VNT + 4 * MiB, R_Z = R_VST + 8 * MiB, R_XBC = R_Z + 16 * MiB, R_DTG = R_XBC + 24 * MiB, R_XT = R_DTG + 2 * MiB, R_BM = R_XT + 16 * MiB,
                 R_CM = R_BM + 4 * MiB, R_DT = R_CM + 4 * MiB, R_KCMP = R_DT + 1 * MiB, R_VCMPT = R_KCMP + 1 * MiB, R_SELM = R_VCMPT + 1 * MiB, R_MIXED = R_SELM + 1 * MiB,
                 R_OC = R_MIXED + 32 * MiB, R_ONSA = R_OC + 16 * MiB, R_OSB = R_ONSA + 16 * MiB, R_YS = R_OSB + 16 * MiB, R_ST = R_YS + 32 * MiB, R_HIN = R_ST + 64 * MiB,
                 R_ACS = R_HIN + 32 * MiB, R_AEND = R_ACS + 1 * MiB, R_END = R_AEND + 1 * MiB;
constexpr size_t WS_END = WS_R + R_END;
static_assert((size_t)M * FF * 2 <= R_MIXED, "H must not overlay MIXED");

typedef unsigned short bf16;
typedef unsigned v4u __attribute__((ext_vector_type(4)));
typedef unsigned v2u __attribute__((ext_vector_type(2)));
typedef float f32x4 __attribute__((ext_vector_type(4)));
#define LAS __attribute__((address_space(3)))
#define LDS_WAIT() asm volatile("s_waitcnt lgkmcnt(0)" ::: "memory")

__device__ __forceinline__ float bf2f(bf16 v) { return __uint_as_float(((unsigned)v) << 16); }
__device__ __forceinline__ unsigned f2bf(float f) { unsigned u = __float_as_uint(f); return (u + 0x7fffu + ((u >> 16) & 1u)) >> 16; }
__device__ __forceinline__ unsigned pk2(float lo, float hi) { unsigned r; asm("v_cvt_pk_bf16_f32 %0, %1, %2" : "=v"(r) : "v"(lo), "v"(hi)); return r; }
__device__ __forceinline__ float wave_sum(float v) {
#pragma unroll
    for (int o = 1; o < 64; o <<= 1) v += __shfl_xor(v, o);
    return v;
}
__device__ __forceinline__ float wave_max(float v) {
#pragma unroll
    for (int o = 1; o < 64; o <<= 1) v = fmaxf(v, __shfl_xor(v, o));
    return v;
}
__device__ __forceinline__ float fexp2(float x) { return __builtin_amdgcn_exp2f(x); }
__device__ __forceinline__ float frcp(float x) { return __builtin_amdgcn_rcpf(x); }
__device__ __forceinline__ float silu_f(float v) { return v * frcp(1.0f + fexp2(-v * LOG2E)); }
__device__ __forceinline__ float sigmoid_f(float v) { return frcp(1.0f + fexp2(-v * LOG2E)); }

#define XB_TMO      128
#define XB_XCNT(j)  (256  + 64 * (j))
#define XB_XSUB(j)  (1280 + 64 * (j))
#define XB_XGEN(j)  (2304 + 64 * (j))
#define XB_TOP      3328
#define XB_TOPGEN   3392
#define XCD_BAR_WORDS 3456
#define XB_SPIN_CAP (1u << 18)
__device__ __forceinline__ unsigned xb_ld(unsigned* p)              { return __hip_atomic_load(p, __ATOMIC_RELAXED, __HIP_MEMORY_SCOPE_AGENT); }
__device__ __forceinline__ unsigned xb_add(unsigned* p, unsigned v) { return __hip_atomic_fetch_add(p, v, __ATOMIC_RELAXED, __HIP_MEMORY_SCOPE_AGENT); }
__device__ __forceinline__ unsigned xb_xcc_id() { return (unsigned)__builtin_amdgcn_s_getreg((3 << 11) | 20) & 0xFu; }
#define XB_SPIN(cond, bar) do { unsigned _sp = 0; while (cond) { __builtin_amdgcn_s_sleep(1); \
    if ((++_sp & 255u) == 0u) { if (xb_ld(&(bar)[XB_TMO])) break; if (_sp > XB_SPIN_CAP) { atomicAdd(&(bar)[XB_TMO], 1u); break; } } } } while (0)
struct XcdBarrier { unsigned* bar; unsigned x; volatile LAS unsigned* st; };
__device__ __forceinline__ XcdBarrier xcd_barrier_post(unsigned* bar, volatile LAS unsigned* st) {
    XcdBarrier b; b.bar = bar; b.x = xb_xcc_id(); b.st = st;
    if (threadIdx.x == 0) (void)xb_add(&bar[XB_XCNT(b.x)], 1u);
    return b;
}
__device__ __forceinline__ void xcd_barrier_complete(unsigned* bar, unsigned x, unsigned& nloc, unsigned& nx) {
    const unsigned G = gridDim.x * gridDim.y * gridDim.z;
    unsigned sum, cnt, mine, sp = 0u;
    for (;;) {
        sum = 0u; cnt = 0u; mine = 0u;
#pragma unroll
        for (unsigned j = 0; j < 16; ++j) { const unsigned c = xb_ld(&bar[XB_XCNT(j)]); sum += c; cnt += (c > 0u) ? 1u : 0u; mine = (j == x) ? c : mine; }
        if (sum == G) break;
        __builtin_amdgcn_s_sleep(1);
        if ((++sp & 255u) == 0u) { if (xb_ld(&bar[XB_TMO])) break; if (sp > XB_SPIN_CAP) { atomicAdd(&bar[XB_TMO], 1u); break; } }
    }
    nloc = mine > 0u ? mine : 1u; nx = cnt > 0u ? cnt : 1u;
}
__device__ __forceinline__ void xcd_barrier(const XcdBarrier& b) {
    asm volatile("s_waitcnt vmcnt(0)" ::: "memory");
    __syncthreads();
    if (threadIdx.x == 0) {
        unsigned* bar = b.bar;
        __builtin_amdgcn_s_waitcnt(0);
        unsigned nloc = b.st[0], nx = b.st[1];
        if (nloc == 0u) { xcd_barrier_complete(bar, b.x, nloc, nx); b.st[0] = nloc; b.st[1] = nx; }
        const unsigned old = xb_add(&bar[XB_XSUB(b.x)], 1u);
        const unsigned gen = old / nloc;
        if (old + 1u == (gen + 1u) * nloc) {
            __builtin_amdgcn_fence(__ATOMIC_RELEASE, "agent");
            asm volatile("s_waitcnt vmcnt(0)" ::: "memory");
            const unsigned og = xb_add(&bar[XB_TOP], 1u);
            const unsigned tg = og / nx;
            if (og + 1u == (tg + 1u) * nx) xb_add(&bar[XB_TOPGEN], 1u);
            else XB_SPIN(xb_ld(&bar[XB_TOPGEN]) == tg, bar);
            __builtin_amdgcn_fence(__ATOMIC_ACQUIRE, "agent");
            xb_add(&bar[XB_XGEN(b.x)], 1u);
            asm volatile("s_waitcnt vmcnt(0)" ::: "memory");
        } else {
            XB_SPIN(xb_ld(&bar[XB_XGEN(b.x)]) == gen, bar);
            __builtin_amdgcn_fence(__ATOMIC_ACQUIRE, "agent");
            asm volatile("s_waitcnt vmcnt(0)" ::: "memory");
        }
    }
    __syncthreads();
}


constexpr int RING_BYTES = 131072;
constexpr int MISC_OFF = RING_BYTES;
constexpr int LDS_BYTES = 147456;

__device__ __forceinline__ float rstd_of(u64 ssq) { return rsqrtf((float)ssq * (SS_INV / D) + EPS); }
constexpr bool gu8(int seg) { return seg >= 0 && seg < 4 && ((GU8_MASK >> seg) & 1); }
constexpr bool gui8(int seg) { return GU_I8 != 0 && seg == 0; }
constexpr int CW_WMAX = 8;
constexpr size_t TAB_PX = 131072;
constexpr size_t TAB_XS = 32768;
constexpr bool wini8(int l) { return l >= 0 && l < 2 && ((WIN_I8 >> l) & 1); }
constexpr bool dn8(int seg) { return seg >= 0 && seg < 4 && ((DN8_MASK >> seg) & 1); }
constexpr float H8_SCALE = 16.0f, DN8_UNSCALE = 1.0f / (16.0f * 256.0f);
constexpr float X8_SCALE = 16.0f, W8_SCALE = 256.0f, GU8_UNSCALE = 1.0f / (16.0f * 256.0f);
__device__ __forceinline__ float sat8(float v) { return __builtin_amdgcn_fmed3f(v, -448.0f, 448.0f); }
__device__ __forceinline__ unsigned pk4_fp8(float a, float b, float c, float d) { int w = 0; w = __builtin_amdgcn_cvt_pk_fp8_f32(sat8(a), sat8(b), w, false); w = __builtin_amdgcn_cvt_pk_fp8_f32(sat8(c), sat8(d), w, true); return (unsigned)w; }
__device__ __forceinline__ size_t kfrag_off(int t, int d0) { return ((size_t)((t >> 5) * 4 + (d0 >> 4)) * 64 + 32 * ((d0 >> 3) & 1) + (t & 31)) * 8; }
__device__ __forceinline__ size_t vfrag_off(int t, int d) { const int q = t & 15; return ((size_t)(((t >> 5) * 2 + (d >> 5)) * 2 + ((t >> 4) & 1)) * 64 + 32 * ((q >> 2) & 1) + (d & 31)) * 8 + 4 * (q >> 3) + (q & 3); }
struct EpiGateUp {
    static constexpr bool PERM = true, AFTER_DRAIN = false;
    bf16* H; const u64* ss; float unscale; int h8; const float* xs; int i8;
    __device__ __forceinline__ void operator()(const f32x4 (&acc)[2][2][4][2], const pg8::Unit& u, int wr, int wc, int fr, int fq) const {
        const int row0 = u.pm * 256 + wr * 64 + fr, hcol = u.pn * 128 + wc * 32 + 8 * fq;
#pragma unroll
        for (int ai = 0; ai < 2; ++ai)
#pragma unroll
            for (int m = 0; m < 4; ++m) {
                const int row = row0 + ai * 128 + m * 16;
                float r = rstd_of(ss[row]) * unscale;
                if (i8) r *= xs[row];
                float h[8];
#pragma unroll
                for (int n = 0; n < 2; ++n)
#pragma unroll
                    for (int j = 0; j < 4; ++j) {
                        const float gf = acc[ai][0][m][n][j], uf = acc[ai][1][m][n][j];
                        const float ga = i8 ? (float)__float_as_int(gf) : gf, ua = i8 ? (float)__float_as_int(uf) : uf;
                        const float g = ga * r, uu = ua * r; h[n * 4 + j] = silu_f(g) * uu; }
                if (h8) { v2u w8; w8.x = pk4_fp8(h[0] * H8_SCALE, h[1] * H8_SCALE, h[2] * H8_SCALE, h[3] * H8_SCALE); w8.y = pk4_fp8(h[4] * H8_SCALE, h[5] * H8_SCALE, h[6] * H8_SCALE, h[7] * H8_SCALE);
                    *(v2u*)((unsigned char*)H + (size_t)row * FF + hcol) = w8; }
                else { v4u w; w.x = pk2(h[0], h[1]); w.y = pk2(h[2], h[3]); w.z = pk2(h[4], h[5]); w.w = pk2(h[6], h[7]);
                    *(v4u*)(H + (size_t)row * FF + hcol) = w; }
            }
    }
};
struct EpiResid {
    static constexpr bool PERM = true, AFTER_DRAIN = false;
    const float* xin; float* xout; bf16* xb; u64* ss_out; float alpha; int out8;
    __device__ __forceinline__ void operator()(const f32x4 (&acc)[2][2][4][2], const pg8::Unit& u, int wr, int wc, int fr, int fq) const {
        const int row0 = u.pm * 256 + wr * 64 + fr, col0 = u.pn * 256 + wc * 32 + 8 * fq;
#pragma unroll
        for (int ai = 0; ai < 2; ++ai)
#pragma unroll
            for (int m = 0; m < 4; ++m) {
                const int row = row0 + ai * 128 + m * 16;
                float s = 0.f;
#pragma unroll
                for (int bj = 0; bj < 2; ++bj) {
                    const size_t off = (size_t)row * D + col0 + bj * 128;
                    const f32x4 x0 = *(const f32x4*)(xin + off), x1 = *(const f32x4*)(xin + off + 4);
                    const f32x4 y0 = x0 + acc[ai][bj][m][0] * alpha, y1 = x1 + acc[ai][bj][m][1] * alpha;
                    *(f32x4*)(xout + off) = y0; *(f32x4*)(xout + off + 4) = y1;
                    if (out8 == 2) { }
                    else if (out8) { v2u w8; w8.x = pk4_fp8(y0[0] * X8_SCALE, y0[1] * X8_SCALE, y0[2] * X8_SCALE, y0[3] * X8_SCALE); w8.y = pk4_fp8(y1[0] * X8_SCALE, y1[1] * X8_SCALE, y1[2] * X8_SCALE, y1[3] * X8_SCALE);
                        *(v2u*)((unsigned char*)xb + off) = w8; }
                    else { v4u w; w.x = pk2(y0[0], y0[1]); w.y = pk2(y0[2], y0[3]); w.z = pk2(y1[0], y1[1]); w.w = pk2(y1[2], y1[3]);
                        *(v4u*)(xb + off) = w; }
                    s += (y0[0] * y0[0] + y0[1] * y0[1]) + (y0[2] * y0[2] + y0[3] * y0[3]) + (y1[0] * y1[0] + y1[1] * y1[1]) + (y1[2] * y1[2] + y1[3] * y1[3]);
                }
                s += __shfl_xor(s, 16); s += __shfl_xor(s, 32);
                if (fq == 0) atomicAdd(ss_out + row, (u64)(s * SS_SCALE + 0.5f));
                asm volatile("" ::: "memory");
            }
    }
};
struct PanelX {
    float* slots;
    unsigned* cnt;
    template <int OP  >
    __device__ __forceinline__ void run(const float (&part)[2][4], const pg8::Unit& u, int wr, int wc, int fr, int fq, PG8_LAS unsigned char* lds) const {
        PG8_LAS float* P = (PG8_LAS float*)lds;
        PG8_LAS float* S = (PG8_LAS float*)(lds + 8192);
        int tid = threadIdx.x; asm volatile("" : "+v"(tid));
        const int wid = __builtin_amdgcn_readfirstlane(tid >> 6), lane = tid & 63;
        if (fq == 0) {
#pragma unroll
            for (int ai = 0; ai < 2; ++ai)
#pragma unroll
                for (int m = 0; m < 4; ++m) P[(ai * 128 + wr * 64 + m * 16 + fr) * 4 + wc] = part[ai][m];
        }
        asm volatile("s_waitcnt lgkmcnt(0)" ::: "memory"); __builtin_amdgcn_s_barrier(); asm volatile("" ::: "memory");
        const int row = wid * 32 + (lane & 31);
        if (lane < 32) {
            const float a = P[row * 4 + 0], b = P[row * 4 + 1], c = P[row * 4 + 2], d = P[row * 4 + 3];
            const float v = OP == 0 ? (a + b) + (c + d) : fmaxf(fmaxf(a, b), fmaxf(c, d));
            __hip_atomic_store((unsigned*)slots + (size_t)(u.pm * 256 + row) * 8 + u.pn, __float_as_uint(v), __ATOMIC_RELAXED, __HIP_MEMORY_SCOPE_AGENT);
        }
        asm volatile("s_waitcnt vmcnt(0)" ::: "memory");
        if (lane == 0) __hip_atomic_fetch_add(cnt + 64 * u.pm, 1u, __ATOMIC_RELAXED, __HIP_MEMORY_SCOPE_AGENT);
        if (wid == 0) {
            unsigned sp = 0u;
            while ((unsigned)__builtin_amdgcn_readfirstlane((int)__hip_atomic_load(cnt + 64 * u.pm, __ATOMIC_RELAXED, __HIP_MEMORY_SCOPE_AGENT)) < 64u) { __builtin_amdgcn_s_sleep(2); if (++sp > (1u << 22)) break; }
            __builtin_amdgcn_fence(__ATOMIC_ACQUIRE, "agent");
        }
        asm volatile("s_waitcnt vmcnt(0) lgkmcnt(0)" ::: "memory"); __builtin_amdgcn_s_barrier(); asm volatile("" ::: "memory");
        if (lane < 32) {
            const unsigned* sl = (const unsigned*)slots + (size_t)(u.pm * 256 + row) * 8;
            float t[8];
#pragma unroll
            for (int q = 0; q < 8; ++q) t[q] = __uint_as_float(__hip_atomic_load(sl + q, __ATOMIC_RELAXED, __HIP_MEMORY_SCOPE_AGENT));
            S[row] = OP == 0 ? ((t[0] + t[1]) + (t[2] + t[3])) + ((t[4] + t[5]) + (t[6] + t[7])) : fmaxf(fmaxf(fmaxf(t[0], t[1]), fmaxf(t[2], t[3])), fmaxf(fmaxf(t[4], t[5]), fmaxf(t[6], t[7])));
        }
        asm volatile("s_waitcnt lgkmcnt(0)" ::: "memory"); __builtin_amdgcn_s_barrier(); asm volatile("" ::: "memory");
    }
};
__device__ __forceinline__ unsigned pk4_i8(float a, float b, float c, float d);
struct EpiResidFin {
    static constexpr bool PERM = true, AFTER_DRAIN = true;
    const float* xin; float* out; const float* gain; float alpha; PanelX px;
    __device__ __forceinline__ void fused(f32x4 (&acc)[2][2][4][2], const pg8::Unit& u, int wr, int wc, int fr, int fq, PG8_LAS unsigned char* lds) const {
        const int row0 = u.pm * 256 + wr * 64 + fr, col0 = u.pn * 256 + wc * 32 + 8 * fq;
        float part[2][4];
#pragma unroll
        for (int ai = 0; ai < 2; ++ai)
#pragma unroll
            for (int m = 0; m < 4; ++m) {
                const int row = row0 + ai * 128 + m * 16;
                float s = 0.f;
#pragma unroll
                for (int bj = 0; bj < 2; ++bj) {
                    const size_t off = (size_t)row * D + col0 + bj * 128;
                    const f32x4 x0 = *(const f32x4*)(xin + off), x1 = *(const f32x4*)(xin + off + 4);
                    const f32x4 y0 = x0 + acc[ai][bj][m][0] * alpha, y1 = x1 + acc[ai][bj][m][1] * alpha;
                    acc[ai][bj][m][0] = y0; acc[ai][bj][m][1] = y1;
                    s += (y0[0] * y0[0] + y0[1] * y0[1]) + (y0[2] * y0[2] + y0[3] * y0[3]) + (y1[0] * y1[0] + y1[1] * y1[1]) + (y1[2] * y1[2] + y1[3] * y1[3]);
                }
                s += __shfl_xor(s, 16); s += __shfl_xor(s, 32);
                part[ai][m] = s;
                asm volatile("" : "+v"(acc[ai][0][m][0]), "+v"(acc[ai][0][m][1]), "+v"(acc[ai][1][m][0]), "+v"(acc[ai][1][m][1]));
            }
        px.run<0>(part, u, wr, wc, fr, fq, lds);
        const PG8_LAS float* S = (const PG8_LAS float*)(lds + 8192);
        f32x4 g[2][2];
#pragma unroll
        for (int bj = 0; bj < 2; ++bj) { g[bj][0] = *(const f32x4*)(gain + col0 + bj * 128); g[bj][1] = *(const f32x4*)(gain + col0 + bj * 128 + 4); }
#pragma unroll
        for (int ai = 0; ai < 2; ++ai)
#pragma unroll
            for (int m = 0; m < 4; ++m) {
                const int rl = ai * 128 + wr * 64 + m * 16 + fr, row = u.pm * 256 + rl;
                const float r = rsqrtf(S[rl] * (1.0f / D) + EPS);
#pragma unroll
                for (int bj = 0; bj < 2; ++bj) {
                    const size_t off = (size_t)row * D + col0 + bj * 128;
                    *(f32x4*)(out + off) = acc[ai][bj][m][0] * r * g[bj][0]; *(f32x4*)(out + off + 4) = acc[ai][bj][m][1] * r * g[bj][1];
                }
            }
    }
};
struct EpiResidQ8 {
    static constexpr bool PERM = true, AFTER_DRAIN = true;
    const float* xin; float* xout; unsigned char* xb8; float* xs; u64* ss_out; float alpha; PanelX px;
    __device__ __forceinline__ void fused(f32x4 (&acc)[2][2][4][2], const pg8::Unit& u, int wr, int wc, int fr, int fq, PG8_LAS unsigned char* lds) const {
        const int row0 = u.pm * 256 + wr * 64 + fr, col0 = u.pn * 256 + wc * 32 + 8 * fq;
        float part[2][4];
#pragma unroll
        for (int ai = 0; ai < 2; ++ai)
#pragma unroll
            for (int m = 0; m < 4; ++m) {
                const int row = row0 + ai * 128 + m * 16;
                float s = 0.f, mx = 0.f;
#pragma unroll
                for (int bj = 0; bj < 2; ++bj) {
                    const size_t off = (size_t)row * D + col0 + bj * 128;
                    const f32x4 x0 = *(const f32x4*)(xin + off), x1 = *(const f32x4*)(xin + off + 4);
                    const f32x4 y0 = x0 + acc[ai][bj][m][0] * alpha, y1 = x1 + acc[ai][bj][m][1] * alpha;
                    acc[ai][bj][m][0] = y0; acc[ai][bj][m][1] = y1;
                    *(f32x4*)(xout + off) = y0; *(f32x4*)(xout + off + 4) = y1;
                    s += (y0[0] * y0[0] + y0[1] * y0[1]) + (y0[2] * y0[2] + y0[3] * y0[3]) + (y1[0] * y1[0] + y1[1] * y1[1]) + (y1[2] * y1[2] + y1[3] * y1[3]);
                    mx = fmaxf(fmaxf(fmaxf(mx, fmaxf(fabsf(y0[0]), fabsf(y0[1]))), fmaxf(fabsf(y0[2]), fabsf(y0[3]))), fmaxf(fmaxf(fabsf(y1[0]), fabsf(y1[1])), fmaxf(fabsf(y1[2]), fabsf(y1[3]))));
                }
                s += __shfl_xor(s, 16); s += __shfl_xor(s, 32);
                mx = fmaxf(mx, __shfl_xor(mx, 16)); mx = fmaxf(mx, __shfl_xor(mx, 32));
                if (fq == 0) atomicAdd(ss_out + row, (u64)(s * SS_SCALE + 0.5f));
                part[ai][m] = mx;
                asm volatile("" : "+v"(acc[ai][0][m][0]), "+v"(acc[ai][0][m][1]), "+v"(acc[ai][1][m][0]), "+v"(acc[ai][1][m][1]) :: "memory");
            }
        px.run<1>(part, u, wr, wc, fr, fq, lds);
        const PG8_LAS float* S = (const PG8_LAS float*)(lds + 8192);
        if (u.pn == 0) { int tid = threadIdx.x; asm volatile("" : "+v"(tid)); if (tid < 256) xs[u.pm * 256 + tid] = fmaxf(S[tid], 1e-30f) * (1.0f / 127.0f); }
#pragma unroll
        for (int ai = 0; ai < 2; ++ai)
#pragma unroll
            for (int m = 0; m < 4; ++m) {
                const int rl = ai * 128 + wr * 64 + m * 16 + fr, row = u.pm * 256 + rl;
                const float inv = 127.0f / fmaxf(S[rl], 1e-30f);
#pragma unroll
                for (int bj = 0; bj < 2; ++bj) {
                    const f32x4 y0 = acc[ai][bj][m][0] * inv, y1 = acc[ai][bj][m][1] * inv;
                    v2u w8; w8.x = pk4_i8(y0[0], y0[1], y0[2], y0[3]); w8.y = pk4_i8(y1[0], y1[1], y1[2], y1[3]);
                    *(v2u*)(xb8 + (size_t)row * D + col0 + bj * 128) = w8;
                }
            }
    }
};
struct EpiWin {
    static constexpr bool PERM = true, AFTER_DRAIN = false;
    unsigned char* R; const u64* ss; const float* xs; float wsc; int i8;
    __device__ __forceinline__ void operator()(const f32x4 (&acc)[2][2][4][2], const pg8::Unit& u, int wr, int wc, int fr, int fq) const {
        const int row0 = u.pm * 256 + wr * 64 + fr;
        const int pn = u.pn;
        unsigned off = 0u; int ld = 0, cbase = 0, cls = 0, hbase = 0, nh = 0; float sc = 1.f;
        if (pn < 2)       { off = (unsigned)R_QN; ld = 512; cbase = pn * 256; sc = QSCALE; }
        else if (pn < 4)  { off = (unsigned)R_QS; ld = 512; cbase = (pn - 2) * 256; sc = QSCALE; }
        else if (pn < 6)  { cls = 4; off = (unsigned)R_KS; hbase = (pn - 4) * 4; nh = 8; }
        else if (pn == 6) { cls = 4; off = (unsigned)R_KN; hbase = 0; nh = 4; }
        else if (pn == 7) { cls = 1; off = (unsigned)R_CMPRAW; }
        else if (pn == 8) { cls = 2; off = (unsigned)R_VNT; hbase = 0; nh = 4; }
        else if (pn < 11) { cls = 2; off = (unsigned)R_VST; hbase = (pn - 9) * 4; nh = 8; }
        else if (pn < 15) { off = (unsigned)R_Z; ld = 1024; cbase = (pn - 11) * 256; }
        else if (pn < 21) { off = (unsigned)R_XBC; ld = 1536; cbase = (pn - 15) * 256; }
        else              { cls = 3; off = (unsigned)R_DTG; }
        unsigned char* const dst = R + off;
#pragma unroll
        for (int ai = 0; ai < 2; ++ai)
#pragma unroll
            for (int m = 0; m < 4; ++m) {
                const int row = row0 + ai * 128 + m * 16;
                float r = rstd_of(ss[row]) * sc;
                if (i8) r *= xs[row] * wsc;
#pragma unroll
                for (int bj = 0; bj < 2; ++bj) {
                    const int col = bj * 128 + wc * 32 + 8 * fq;
                    float v[8];
#pragma unroll
                    for (int n = 0; n < 2; ++n)
#pragma unroll
                        for (int j = 0; j < 4; ++j) { const float af = acc[ai][bj][m][n][j]; v[n * 4 + j] = (i8 ? (float)__float_as_int(af) : af) * r; }
                    if (cls == 0) {
                        v4u w; w.x = pk2(v[0], v[1]); w.y = pk2(v[2], v[3]); w.z = pk2(v[4], v[5]); w.w = pk2(v[6], v[7]);
                        *(v4u*)((bf16*)dst + (size_t)row * ld + cbase + col) = w;
                    } else if (cls == 1) {
                        v4u w; w.x = pk2(v[0], v[1]); w.y = pk2(v[2], v[3]); w.z = pk2(v[4], v[5]); w.w = pk2(v[6], v[7]);
                        const int seg = col >> 6, d0 = col & 63, b = row / T, t = row % T, c1 = t >> 4, l1 = t & 15;
                        bf16* base = (bf16*)dst + (size_t)(seg * 4 + b) * (4 * 128 * 512);
                        *(v4u*)(base + ((size_t)((c1 >> 5) * 128 + 4 * l1 + (d0 >> 4)) * 64 + 32 * ((d0 >> 3) & 1) + (c1 & 31)) * 8) = w;
                        if (c1 > 0) { const int c0 = c1 - 1, l0 = l1 + 16;
                            *(v4u*)(base + ((size_t)((c0 >> 5) * 128 + 4 * l0 + (d0 >> 4)) * 64 + 32 * ((d0 >> 3) & 1) + (c0 & 31)) * 8) = w; }
                    } else if (cls == 4) {
                        v4u w; w.x = pk2(v[0], v[1]); w.y = pk2(v[2], v[3]); w.z = pk2(v[4], v[5]); w.w = pk2(v[6], v[7]);
                        const int b = row / T, t = row % T, hs = hbase + (col >> 6), d0 = col & 63;
                        *(v4u*)((bf16*)dst + (size_t)(b * nh + hs) * (T * 64) + kfrag_off(t, d0)) = w;
                    } else if (cls == 2) {
                        const int b = row / T, t = row % T, hs = hbase + (col >> 6), d0 = col & 63;
                        bf16* tp = (bf16*)dst + (size_t)(b * nh + hs) * (T * 64) + vfrag_off(t, d0);
#pragma unroll
                        for (int j = 0; j < 8; ++j) tp[8 * j] = (bf16)f2bf(v[j]);
                    } else {
                        if (col < 64) { float* o = (float*)dst + (size_t)row * 64 + col; *(f32x4*)o = (f32x4){v[0], v[1], v[2], v[3]}; *(f32x4*)(o + 4) = (f32x4){v[4], v[5], v[6], v[7]}; }
                    }
                }
            }
    }
};

struct Args { const float* in[24]; float* out; unsigned char* ws; int ph_lo, ph_hi; };
struct Frame {
    unsigned char* lds; int tid, lane, wave, vcu, G;
    float* out; unsigned char* ws; unsigned char* R; float* ctlf;
};
__device__ __forceinline__ bf16* wptr(const Frame& F, int layer, size_t off) { return (bf16*)(F.ws + WS_W + (size_t)layer * WL_SIZE + off); }
__device__ __forceinline__ u64* ssptr(const Frame& F, int i) { return (u64*)(F.ctlf + CW_SS) + (size_t)i * M; }
typedef const __attribute__((address_space(4))) Args* KArgs;
__device__ __forceinline__ KArgs kargs() { KArgs p = (KArgs)__builtin_amdgcn_kernarg_segment_ptr(); asm volatile("" : "+s"(p)); return p; }
__device__ __forceinline__ Frame make_frame(unsigned char* ws, float* out, unsigned char* lds) {
    int tid = threadIdx.x, vcu = blockIdx.x, G = gridDim.x; asm volatile("" : "+v"(tid), "+s"(vcu), "+s"(G));
    Frame F; F.lds = lds; F.tid = tid; F.lane = F.tid & 63; F.wave = __builtin_amdgcn_readfirstlane(F.tid >> 6); F.G = G; F.vcu = vcu;
    F.out = out; F.ws = ws; F.R = ws + WS_R; F.ctlf = (float*)(ws + WS_CTL); return F;
}

__device__ __forceinline__ int win_src_col(int n) {
    if (n < 512) return n;
    if (n < 1024) return 1304 + (n - 512);
    if (n < 1536) return 1304 + 512 + (n - 1024);
    if (n < 2304) {
        const int tile = (n - 1536) >> 8, i = (n - 1536) & 255, seg = i >> 6, d = i & 63;
        int branch, kv, hk;
        if (tile == 0) { branch = 1 + (seg >> 1); kv = 0; hk = seg & 1; }
        else if (tile == 1) { branch = 0; kv = seg >> 1; hk = seg & 1; }
        else { branch = 1 + (seg >> 1); kv = 1; hk = seg & 1; }
        return 512 + ((branch * 2 + kv) * 2 + hk) * 64 + d;
    }
    if (n < 2816) return 1304 + 1024 + (n - 2304);
    if (n < 3840) return 2840 + (n - 2816);
    if (n < 5376) return 3864 + (n - 3840);
    const int i = n - 5376;
    if (i < 16) return 5400 + i;
    if (i < 40) return 1280 + (i - 16);
    return -1;
}
template <bool FRAG>
__device__ __forceinline__ void transpose_item(const float* W, int ldw, int srccol, const float* gain, bf16* WT, int K, int n0, int k0, float* scr, int lane) {
#pragma unroll 8
    for (int i = 0; i < 32; ++i) { const int kk = 2 * i + (lane >> 5);
        float v = 0.f; if (srccol >= 0) v = W[(size_t)(k0 + kk) * ldw + srccol]; if (gain) v *= gain[k0 + kk];
        scr[kk * 33 + (lane & 31)] = v; }
    __builtin_amdgcn_wave_barrier(); LDS_WAIT();
    const int c = lane & 7;
#pragma unroll
    for (int j = 0; j < 4; ++j) { const int n = (lane >> 3) + 8 * j; const float* s = scr + (8 * c) * 33 + n;
        v4u o; o.x = pk2(s[0 * 33], s[1 * 33]); o.y = pk2(s[2 * 33], s[3 * 33]); o.z = pk2(s[4 * 33], s[5 * 33]); o.w = pk2(s[6 * 33], s[7 * 33]);
        if (FRAG) { const int nn = n0 + n, k8 = k0 + 8 * c; *(v4u*)(WT + ((size_t)((nn >> 5) * (K / 16) + (k8 >> 4)) * 64 + 32 * ((k8 >> 3) & 1) + (nn & 31)) * 8) = o; }
        else *(v4u*)(WT + (size_t)(n0 + n) * K + k0 + 8 * c) = o; }
    __builtin_amdgcn_wave_barrier(); LDS_WAIT();
}
template <int MODE>
__device__ __forceinline__ void transpose_item4(const float* W0, const float* W1, int ldw, const float* gain, bf16* WT, int K, int n0, int k0, int lane) {
    const int kc = lane & 3, ng = lane >> 2;
#pragma unroll 1
    for (int sub = 0; sub < 4; ++sub) {
        const int nn = n0 + 64 * sub + 4 * ng;
        const float* W = W0; int col = nn;
        if (MODE == 1) { W = ((nn & 255) >= 128) ? W1 : W0; col = (nn >> 8) * 128 + (nn & 127); }
        if (MODE == 2) col = win_src_col(nn);
#pragma unroll
        for (int ks = 0; ks < 2; ++ks) {
            const int kk = k0 + 32 * ks + 8 * kc;
            const float* src = W + (size_t)kk * ldw + (col >= 0 ? col : 0);
            f32x4 v[8];
#pragma unroll
            for (int i = 0; i < 8; ++i) v[i] = *(const f32x4*)(src + (size_t)i * ldw) * (gain ? gain[kk + i] : 1.0f);
            if (MODE == 2 && col < 0) {
#pragma unroll
                for (int i = 0; i < 8; ++i) v[i] = (f32x4){0.f, 0.f, 0.f, 0.f};
            }
            bf16* drow = WT + (size_t)nn * K + kk;
#pragma unroll
            for (int j = 0; j < 4; ++j) { v4u o; o.x = pk2(v[0][j], v[1][j]); o.y = pk2(v[2][j], v[3][j]); o.z = pk2(v[4][j], v[5][j]); o.w = pk2(v[6][j], v[7][j]);
                *(v4u*)(drow + (size_t)j * K) = o; }
        }
    }
}
__device__ __forceinline__ unsigned pk4_i8(float a, float b, float c, float d) {
    const int ia = __float2int_rn(__builtin_amdgcn_fmed3f(a, -127.f, 127.f)), ib = __float2int_rn(__builtin_amdgcn_fmed3f(b, -127.f, 127.f)), ic = __float2int_rn(__builtin_amdgcn_fmed3f(c, -127.f, 127.f)), id = __float2int_rn(__builtin_amdgcn_fmed3f(d, -127.f, 127.f));
    return (unsigned)(ia & 0xff) | ((unsigned)(ib & 0xff) << 8) | ((unsigned)(ic & 0xff) << 16) | ((unsigned)id << 24);
}
template <int MODE, bool I8 = false>
__device__ __forceinline__ void transpose_item_8(const float* W0, const float* W1, int ldw, const float* gain, unsigned char* WT, int K, int n0, int k0, int lane, float wsc = W8_SCALE) {
    const int kc = lane & 3, ng = lane >> 2;
#pragma unroll 1
    for (int sub = 0; sub < 4; ++sub) {
        const int nn = n0 + 64 * sub + 4 * ng;
        const float* W = W0; int col = nn;
        if (MODE == 1) { W = ((nn & 255) >= 128) ? W1 : W0; col = (nn >> 8) * 128 + (nn & 127); }
        if (MODE == 2) col = win_src_col(nn);
#pragma unroll 1
        for (int ks = 0; ks < 2; ++ks) {
            const int kk = k0 + 64 * ks + 16 * kc;
            const float* src = W + (size_t)kk * ldw + (col >= 0 ? col : 0);
            f32x4 v[16];
#pragma unroll
            for (int i = 0; i < 16; ++i) v[i] = *(const f32x4*)(src + (size_t)i * ldw) * ((gain ? gain[kk + i] : 1.0f) * wsc);
            if (MODE == 2 && col < 0) {
#pragma unroll
                for (int i = 0; i < 16; ++i) v[i] = (f32x4){0.f, 0.f, 0.f, 0.f};
            }
            unsigned char* drow = WT + (size_t)nn * K + kk;
#pragma unroll
            for (int j = 0; j < 4; ++j) { v4u o;
                if (I8) { o.x = pk4_i8(v[0][j], v[1][j], v[2][j], v[3][j]); o.y = pk4_i8(v[4][j], v[5][j], v[6][j], v[7][j]); o.z = pk4_i8(v[8][j], v[9][j], v[10][j], v[11][j]); o.w = pk4_i8(v[12][j], v[13][j], v[14][j], v[15][j]); }
                else { o.x = pk4_fp8(v[0][j], v[1][j], v[2][j], v[3][j]); o.y = pk4_fp8(v[4][j], v[5][j], v[6][j], v[7][j]); o.z = pk4_fp8(v[8][j], v[9][j], v[10][j], v[11][j]); o.w = pk4_fp8(v[12][j], v[13][j], v[14][j], v[15][j]); }
                *(v4u*)(drow + (size_t)j * K) = o; }
        }
    }
}
__device__ __forceinline__ int t5_bucket(int dist) {
    if (dist < 16) return dist;
    return 16 + (dist >= 19) + (dist >= 21) + (dist >= 24) + (dist >= 27) + (dist >= 31) + (dist >= 35) + (dist >= 40) + (dist >= 46) + (dist >= 52) + (dist >= 59)
              + (dist >= 67) + (dist >= 77) + (dist >= 87) + (dist >= 99) + (dist >= 113);
}
struct ProIn { const float *x, *relb, *n1, *g1, *u1, *d1, *nm, *win, *wout, *nnsa, *nsb, *nssd, *n2, *g2, *u2, *d2, *cpos, *cw; };
constexpr unsigned CV_GU(int sg) { return 1u << sg; }
constexpr unsigned CV_DN(int sg) { return 16u << sg; }
constexpr unsigned CV_IN(int l) { return 256u << l; }
constexpr unsigned CV_OUT(int l) { return 1024u << l; }
template <unsigned MASK>
__device__ __forceinline__ void convert_weights(Frame& F, const ProIn I, int gw, int NGW) {
    const int lane = F.lane;
    constexpr int I_GU8 = (D / 128) * (NGU / 256), I_GU16 = (D / 64) * (NGU / 256), I_DN16 = (FF / 64) * (D / 256), I_DN8 = (FF / 128) * (D / 256), I_IN16 = (D / 64) * (NIN / 256), I_IN8 = (D / 128) * (NIN / 256), I_OUT = (D / 64) * (D / 256);
    constexpr int C_GU[4] = {(MASK & 1u) ? ((gu8(0) || gui8(0)) ? I_GU8 : I_GU16) : 0, (MASK & 2u) ? (gu8(1) ? I_GU8 : I_GU16) : 0, (MASK & 4u) ? (gu8(2) ? I_GU8 : I_GU16) : 0, (MASK & 8u) ? (gu8(3) ? I_GU8 : I_GU16) : 0};
    constexpr int C_DN[4] = {(MASK & 16u) ? (dn8(0) ? I_DN8 : I_DN16) : 0, (MASK & 32u) ? (dn8(1) ? I_DN8 : I_DN16) : 0, (MASK & 64u) ? (dn8(2) ? I_DN8 : I_DN16) : 0, (MASK & 128u) ? (dn8(3) ? I_DN8 : I_DN16) : 0};
    constexpr int C_IN[2] = {(MASK & 256u) ? (wini8(0) ? I_IN8 : I_IN16) : 0, (MASK & 512u) ? (wini8(1) ? I_IN8 : I_IN16) : 0};
    constexpr int C_OUT[2] = {(MASK & 1024u) ? I_OUT : 0, (MASK & 2048u) ? I_OUT : 0};
    constexpr int I_ALL = C_GU[0] + C_GU[1] + C_GU[2] + C_GU[3] + C_DN[0] + C_DN[1] + C_DN[2] + C_DN[3] + C_IN[0] + C_IN[1] + C_OUT[0] + C_OUT[1];
    for (int it = gw; it < I_ALL; it += NGW) {
        int r = it; bool done = false;
#pragma unroll
        for (int sg = 0; sg < 4; ++sg) {
            if (C_GU[sg] > 0 && !done && r < C_GU[sg]) {
                const int l = sg >> 1, f = sg & 1;
                const int nb = r % (NGU / 256), kb = r / (NGU / 256), n0 = nb * 256;
                const float* gain = (f == 0 ? I.n1 : I.n2) + (size_t)l * D;
                const float* Wg = (f == 0 ? I.g1 : I.g2) + (size_t)l * D * FF; const float* Wu = (f == 0 ? I.u1 : I.u2) + (size_t)l * D * FF;
                if (gui8(sg)) { const float wmax = __uint_as_float(((const unsigned*)F.ctlf)[CW_WMAX]);
                    transpose_item_8<1, true>(Wg, Wu, FF, gain, (unsigned char*)wptr(F, l, f == 0 ? WL_GU1 : WL_GU2), D, n0, kb * 128, lane, 127.0f / wmax); }
                else if (gu8(sg)) transpose_item_8<1>(Wg, Wu, FF, gain, (unsigned char*)wptr(F, l, f == 0 ? WL_GU1 : WL_GU2), D, n0, kb * 128, lane);
                else transpose_item4<1>(Wg, Wu, FF, gain, wptr(F, l, f == 0 ? WL_GU1 : WL_GU2), D, n0, kb * 64, lane);
                done = true;
            }
            if (!done) r -= C_GU[sg];
        }
        if (done) continue;
#pragma unroll
        for (int sg = 0; sg < 4; ++sg) {
            if (C_DN[sg] > 0 && !done && r < C_DN[sg]) {
                const int l = sg >> 1, f = sg & 1;
                const int nb = r % (D / 256), kb = r / (D / 256), n0 = nb * 256;
                const float* W = (f == 0 ? I.d1 : I.d2) + (size_t)l * FF * D;
                if (dn8(sg)) transpose_item_8<0>(W, W, D, nullptr, (unsigned char*)wptr(F, l, f == 0 ? WL_DN1 : WL_DN2), FF, n0, kb * 128, lane);
                else transpose_item4<0>(W, W, D, nullptr, wptr(F, l, f == 0 ? WL_DN1 : WL_DN2), FF, n0, kb * 64, lane);
                done = true;
            }
            if (!done) r -= C_DN[sg];
        }
        if (done) continue;
#pragma unroll
        for (int l = 0; l < 2; ++l) {
            if (C_IN[l] > 0 && !done && r < C_IN[l]) {
                const int nb = r % (NIN / 256), kb = r / (NIN / 256), n0 = nb * 256, k0 = kb * 64;
                const float* W = I.win + (size_t)l * D * NIN_SRC;
                if (wini8(l)) { const float wmax = __uint_as_float(((const unsigned*)F.ctlf)[CW_WMAX + 1 + l]);
                    transpose_item_8<2, true>(W, W, NIN_SRC, I.nm + (size_t)l * D, (unsigned char*)wptr(F, l, WL_IN), D, n0, kb * 128, lane, 127.0f / wmax); }
                else transpose_item4<2>(W, W, NIN_SRC, I.nm + (size_t)l * D, wptr(F, l, WL_IN), D, n0, k0, lane);
                done = true;
            }
            if (!done) r -= C_IN[l];
        }
        if (done) continue;
#pragma unroll
        for (int l = 0; l < 2; ++l) {
            if (C_OUT[l] > 0 && !done && r < C_OUT[l]) {
                const int nb = r % (D / 256), kb = r / (D / 256), n0 = nb * 256, k0 = kb * 64;
                const float* W = I.wout + (size_t)l * D * D;
                const float* gbase = (k0 < 512) ? I.nnsa + (size_t)l * 512 : (k0 < 1024) ? I.nsb + (size_t)l * 512 - 512 : I.nssd + (size_t)l * 1024 - 1024;
                transpose_item4<0>(W, W, D, gbase, wptr(F, l, WL_OUT), D, n0, k0, lane);
                done = true;
            }
            if (!done) r -= C_OUT[l];
        }
    }
}
constexpr unsigned CVM_PRO = 0xFFFu;
constexpr unsigned CVM_GU[4] = {0u, 0u, 0u, 0u};
constexpr unsigned CVM_WIN[2] = {0u, 0u};
static_assert((CVM_PRO | CVM_GU[0] | CVM_GU[1] | CVM_GU[2] | CVM_GU[3] | CVM_WIN[0] | CVM_WIN[1]) == 0xFFFu, "every matrix converted exactly once");
#ifndef COOP_CVT
#define COOP_CVT 1
#endif
constexpr bool COOP_OK = COOP_CVT && GU_I8 && GU8_MASK == 0xE && DN8_MASK == 0xF && (WIN_I8 & ~2) == 0;
struct CvtStep { const float* src; const float* gain; unsigned char* dst; float wsc; int ldw, K, i8, valid, b16; };
constexpr int CS_INB = (D / 64) * (NIN / 256), CS_OUT = (D / 64) * (D / 256);
constexpr int CS_GU = (D / 128) * (NGU / 256), CS_DN = (FF / 128) * (D / 256), CS_IN = (D / 128) * (NIN / 256);
constexpr int CS_ONE = 4 * CS_GU + 4 * CS_DN + (wini8(1) ? CS_IN : 0);
constexpr int CS_ALL = CS_ONE + (wini8(0) ? 0 : CS_INB) + (wini8(1) ? 0 : CS_INB) + 2 * CS_OUT;
__device__ __forceinline__ CvtStep cvt_decode(const Frame& F, const float* Ig1, const float* Iu1, const float* Id1, const float* Ig2, const float* Iu2, const float* Id2, const float* In1, const float* In2, const float* Inm, const float* Iwin,
                                              const float* Iwout, const float* Innsa, const float* Insb, const float* Inssd, int r, int wave, int lane) {
    CvtStep c; c.valid = 1; c.i8 = 0; c.b16 = 0; c.wsc = W8_SCALE; c.gain = nullptr;
    if (r < 4 * CS_GU) {
        const int sg = r / CS_GU, rr = r % CS_GU, l = sg >> 1, f = sg & 1, nb = rr % (NGU / 256), kb = rr / (NGU / 256), nn = nb * 256 + 4 * lane, k0 = kb * 128;
        const float* W = ((nn & 255) >= 128 ? (f == 0 ? Iu1 : Iu2) : (f == 0 ? Ig1 : Ig2)) + (size_t)l * D * FF;
        c.src = W + (size_t)(k0 + 16 * wave) * FF + (nn >> 8) * 128 + (nn & 127); c.ldw = FF; c.gain = (f == 0 ? In1 : In2) + (size_t)l * D + k0 + 16 * wave;
        c.dst = (unsigned char*)wptr(F, l, f == 0 ? WL_GU1 : WL_GU2) + (size_t)(nb * 256) * D + k0; c.K = D;
        if (sg == 0) { c.i8 = 1; c.wsc = 127.0f / __uint_as_float(((const unsigned*)F.ctlf)[CW_WMAX]); }
    } else if (r < 4 * CS_GU + 4 * CS_DN) {
        const int q = r - 4 * CS_GU, sg = q / CS_DN, rr = q % CS_DN, l = sg >> 1, f = sg & 1, nb = rr % (D / 256), kb = rr / (D / 256), nn = nb * 256 + 4 * lane, k0 = kb * 128;
        c.src = (f == 0 ? Id1 : Id2) + (size_t)l * FF * D + (size_t)(k0 + 16 * wave) * D + nn; c.ldw = D;
        c.dst = (unsigned char*)wptr(F, l, f == 0 ? WL_DN1 : WL_DN2) + (size_t)(nb * 256) * FF + k0; c.K = FF;
    } else if (r >= CS_ONE) {
        int q = r - CS_ONE; c.b16 = 1; c.wsc = 1.0f;
        constexpr int NB16 = (wini8(0) ? 0 : 1) + (wini8(1) ? 0 : 1);
        if (q < NB16 * CS_INB) {
            const int l = (NB16 == 2) ? q / CS_INB : (wini8(0) ? 1 : 0), rr = q % CS_INB, nb = rr % (NIN / 256), kb = rr / (NIN / 256), nn = nb * 256 + 4 * lane, k0 = kb * 64, col = win_src_col(nn);
            c.valid = col >= 0;
            c.src = Iwin + (size_t)l * D * NIN_SRC + (size_t)(k0 + 8 * wave) * NIN_SRC + (col >= 0 ? col : 0); c.ldw = NIN_SRC; c.gain = Inm + (size_t)l * D + k0 + 8 * wave;
            c.dst = (unsigned char*)wptr(F, l, WL_IN) + ((size_t)(nb * 256) * D + k0) * 2; c.K = 2 * D;
        } else {
            q -= NB16 * CS_INB;
            const int l = q / CS_OUT, rr = q % CS_OUT, nb = rr % (D / 256), kb = rr / (D / 256), nn = nb * 256 + 4 * lane, k0 = kb * 64;
            c.src = Iwout + (size_t)l * D * D + (size_t)(k0 + 8 * wave) * D + nn; c.ldw = D;
            c.gain = ((k0 < 512) ? Innsa + (size_t)l * 512 : (k0 < 1024) ? Insb + (size_t)l * 512 - 512 : Inssd + (size_t)l * 1024 - 1024) + k0 + 8 * wave;
            c.dst = (unsigned char*)wptr(F, l, WL_OUT) + ((size_t)(nb * 256) * D + k0) * 2; c.K = 2 * D;
        }
    } else {
        const int rr = r - 4 * CS_GU - 4 * CS_DN, l = 1, nb = rr % (NIN / 256), kb = rr / (NIN / 256), nn = nb * 256 + 4 * lane, k0 = kb * 128, col = win_src_col(nn);
        c.valid = col >= 0;
        c.src = Iwin + (size_t)l * D * NIN_SRC + (size_t)(k0 + 16 * wave) * NIN_SRC + (col >= 0 ? col : 0); c.ldw = NIN_SRC; c.gain = Inm + (size_t)l * D + k0 + 16 * wave;
        c.dst = (unsigned char*)wptr(F, l, WL_IN) + (size_t)(nb * 256) * D + k0; c.K = D;
        c.i8 = 1; c.wsc = 127.0f / __uint_as_float(((const unsigned*)F.ctlf)[CW_WMAX + 1 + l]);
    }
    return c;
}
__device__ __forceinline__ void coop_convert(Frame& F, const ProIn PI) {
    constexpr int LSTR = 144;
    const float *Ig1 = PI.g1, *Iu1 = PI.u1, *Id1 = PI.d1, *Ig2 = PI.g2, *Iu2 = PI.u2, *Id2 = PI.d2, *In1 = PI.n1, *In2 = PI.n2, *Inm = PI.nm, *Iwin = PI.win, *Iwout = PI.wout, *Innsa = PI.nnsa, *Insb = PI.nsb, *Inssd = PI.nssd;
    asm volatile("" : "+s"(Ig1), "+s"(Iu1), "+s"(Id1), "+s"(Ig2), "+s"(Iu2), "+s"(Id2), "+s"(In1), "+s"(In2), "+s"(Inm), "+s"(Iwin), "+s"(Iwout), "+s"(Innsa), "+s"(Insb), "+s"(Inssd));
#define CVT_DECODE(rr) cvt_decode(F, Ig1, Iu1, Id1, Ig2, Iu2, Id2, In1, In2, Inm, Iwin, Iwout, Innsa, Insb, Inssd, (rr), wave, lane)
    LAS unsigned char* const l3 = (LAS unsigned char*)F.lds;
    const int lane = F.lane, wave = F.wave, tid = F.tid;
    int r = F.vcu;
    if (r >= CS_ALL) return;
    CvtStep c = CVT_DECODE(r);
    f32x4 v[16];
#pragma unroll
    for (int i = 0; i < 16; ++i) if (i < 8 || !c.b16) v[i] = *(const f32x4*)(c.src + (size_t)i * c.ldw);
    int buf = 0;
#pragma unroll 1
    for (;;) {
        LAS unsigned char* tile = l3 + buf * (256 * LSTR);
#pragma unroll
        for (int i = 0; i < 16; ++i) if (i < 8 || !c.b16) { const float sc = (c.gain ? c.gain[i] : 1.0f) * c.wsc; v[i] = c.valid ? v[i] * sc : (f32x4){0.f, 0.f, 0.f, 0.f}; }
#pragma unroll
        for (int j = 0; j < 4; ++j) { v4u o;
            if (c.b16) { o.x = pk2(v[0][j], v[1][j]); o.y = pk2(v[2][j], v[3][j]); o.z = pk2(v[4][j], v[5][j]); o.w = pk2(v[6][j], v[7][j]); }
            else if (c.i8) { o.x = pk4_i8(v[0][j], v[1][j], v[2][j], v[3][j]); o.y = pk4_i8(v[4][j], v[5][j], v[6][j], v[7][j]); o.z = pk4_i8(v[8][j], v[9][j], v[10][j], v[11][j]); o.w = pk4_i8(v[12][j], v[13][j], v[14][j], v[15][j]); }
            else { o.x = pk4_fp8(v[0][j], v[1][j], v[2][j], v[3][j]); o.y = pk4_fp8(v[4][j], v[5][j], v[6][j], v[7][j]); o.z = pk4_fp8(v[8][j], v[9][j], v[10][j], v[11][j]); o.w = pk4_fp8(v[12][j], v[13][j], v[14][j], v[15][j]); }
            *(LAS v4u*)(tile + (4 * lane + j) * LSTR + 16 * wave) = o; }
        unsigned char* const dst = c.dst; const int K = c.K;
        const int rn = r + F.G; const bool more = rn < CS_ALL;
        if (more) { c = CVT_DECODE(rn);
#pragma unroll
            for (int i = 0; i < 16; ++i) if (i < 8 || !c.b16) v[i] = *(const f32x4*)(c.src + (size_t)i * c.ldw); }
        asm volatile("s_waitcnt lgkmcnt(0)" ::: "memory"); __builtin_amdgcn_s_barrier(); asm volatile("" ::: "memory");
#pragma unroll
        for (int ps = 0; ps < 4; ++ps) { const int row = (tid >> 3) + 64 * ps, q = tid & 7;
            const v4u w = *(const LAS v4u*)(tile + row * LSTR + 16 * q);
            *(v4u*)(dst + (size_t)row * K + 16 * q) = w; }
        if (!more) break;
        r = rn; buf ^= 1;
    }
#undef CVT_DECODE
    __syncthreads();
}
__device__ __forceinline__ void p_prologue_b(Frame& F, const ProIn I) {
    const int gw = F.vcu * NWAVES + F.wave, NGW = F.G * NWAVES;
    if (COOP_OK) coop_convert(F, I);
    else convert_weights<CVM_PRO>(F, I, gw, NGW);
}
__device__ __forceinline__ void p_prologue(Frame& F, const ProIn I) {
    float* scr = (float*)(F.lds + F.wave * 16384);
    const int gw = F.vcu * NWAVES + F.wave, NGW = F.G * NWAVES, lane = F.lane;
    if (GU_I8 || WIN_I8) {
        float wmx = 0.f, wmi0 = 0.f, wmi1 = 0.f;
        if (WIN_I8)
        for (int it = gw; it < DEPTH * D; it += NGW) {
            const int l = it / D, k = it % D;
            if (!((WIN_I8 >> l) & 1)) continue; const f32x4* wr = (const f32x4*)(I.win + ((size_t)l * D + k) * NIN_SRC); float mx = 0.f;
            constexpr int NV = NIN_SRC / 4;
            f32x4 vv[(NV + 63) / 64];
#pragma unroll
            for (int q = 0; q < (NV + 63) / 64; ++q) { const int idx = lane + 64 * q; vv[q] = (idx < NV) ? wr[idx] : (f32x4){0.f, 0.f, 0.f, 0.f}; }
#pragma unroll
            for (int q = 0; q < (NV + 63) / 64; ++q) mx = fmaxf(fmaxf(mx, fmaxf(fabsf(vv[q][0]), fabsf(vv[q][1]))), fmaxf(fabsf(vv[q][2]), fabsf(vv[q][3])));
            mx = wave_max(mx) * fabsf(I.nm[(size_t)l * D + k]);
            if (l == 0) wmi0 = fmaxf(wmi0, mx); else wmi1 = fmaxf(wmi1, mx);
        }
        if (GU_I8)
        for (int rep_m = 0; rep_m < REP_AMAX; ++rep_m)
        for (int it = gw; it < 2 * D; it += NGW) {
            const int mat = it / D, k = it % D; const float* wr = (mat ? I.u1 : I.g1) + (size_t)k * FF; float mx = 0.f;
            f32x4 vv[FF / 256];
#pragma unroll
            for (int q = 0; q < FF / 256; ++q) vv[q] = *((const f32x4*)wr + lane + 64 * q);
#pragma unroll
            for (int q = 0; q < FF / 256; ++q) mx = fmaxf(fmaxf(mx, fmaxf(fabsf(vv[q][0]), fabsf(vv[q][1]))), fmaxf(fabsf(vv[q][2]), fabsf(vv[q][3])));
            wmx = fmaxf(wmx, wave_max(mx) * fabsf(I.n1[k]));
        }
        float* red = (float*)(F.lds + 131072 - 128);
        if (lane == 0) { red[F.wave] = wmx; red[8 + F.wave] = wmi0; red[16 + F.wave] = wmi1; }
        __syncthreads();
        if (F.tid < 3) { float m8 = red[8 * F.tid];
#pragma unroll
            for (int q = 1; q < NWAVES; ++q) m8 = fmaxf(m8, red[8 * F.tid + q]);
            if (F.tid == 0 ? GU_I8 != 0 : WIN_I8 != 0) atomicMax((unsigned*)F.ctlf + CW_WMAX + F.tid, __float_as_uint(m8)); }
        __syncthreads();
    }
    if (blockIdx.x >= 64 && blockIdx.x < 64 + DEPTH * 2 * 16) {
        const int idx = (int)blockIdx.x - 64, mat = idx & 3, sl = idx >> 2, dd = F.tid & 63, sub = F.tid >> 6;
        const float* w = I.cw + (size_t)mat * 2048 * 64; const float* pos = I.cpos + (size_t)mat * 2048;
        float a = 0.f;
#pragma unroll
        for (int k = 0; k < 16; ++k) { const int kk = sl * 128 + sub * 16 + k; a += pos[kk] * w[kk * 64 + dd]; }
        float* red = (float*)F.lds;
        red[F.tid] = a;
        __syncthreads();
        if (F.tid < 64) { float t = 0.f;
#pragma unroll
            for (int q = 0; q < 8; ++q) t += red[q * 64 + F.tid];
            ((float*)(F.ws + WS_TAB + TAB_PB))[(mat * 16 + sl) * 64 + F.tid] = t; }
        __syncthreads();
    }
    if (F.wave == NWAVES - 1)
    for (int it = F.vcu; it < DEPTH * 2 * 64; it += F.G) {
        const int mat = it >> 6, r = it & 63, nb = r & 1, kb = r >> 1;
        transpose_item<true>(I.cw + (size_t)mat * 2048 * 64, 64, nb * 32 + (lane & 31), nullptr, (bf16*)(F.ws + WS_CW) + (size_t)mat * 64 * 2048, 2048, nb * 32, kb * 64, scr, lane);
    }
    {
        const float* x = I.x; bf16* xb = (bf16*)(F.ws + WS_XB); u64* ss0 = ssptr(F, 0);
        for (int m = gw; m < M; m += NGW) {
            const f32x4* xr = (const f32x4*)(x + (size_t)m * D) + lane; float s = 0.f;
            if (gui8(0)) {
                f32x4 v[8]; float mx = 0.f;
#pragma unroll
                for (int j = 0; j < 8; ++j) { v[j] = xr[64 * j]; s += (v[j][0] * v[j][0] + v[j][1] * v[j][1]) + (v[j][2] * v[j][2] + v[j][3] * v[j][3]); mx = fmaxf(fmaxf(mx, fmaxf(fabsf(v[j][0]), fabsf(v[j][1]))), fmaxf(fabsf(v[j][2]), fabsf(v[j][3]))); }
                mx = fmaxf(wave_max(mx), 1e-30f);
                const float inv = 127.0f / mx;
                unsigned* o = (unsigned*)((unsigned char*)xb + (size_t)m * D) + lane;
#pragma unroll
                for (int j = 0; j < 8; ++j) o[64 * j] = pk4_i8(v[j][0] * inv, v[j][1] * inv, v[j][2] * inv, v[j][3] * inv);
                if (lane == 0) ((float*)(F.ws + WS_TAB + TAB_XS))[m] = mx * (1.0f / 127.0f);
            } else if (gu8(0)) {
                unsigned* o = (unsigned*)((unsigned char*)xb + (size_t)m * D) + lane;
#pragma unroll
                for (int j = 0; j < 8; ++j) { const f32x4 v = xr[64 * j]; s += (v[0] * v[0] + v[1] * v[1]) + (v[2] * v[2] + v[3] * v[3]); o[64 * j] = pk4_fp8(v[0] * X8_SCALE, v[1] * X8_SCALE, v[2] * X8_SCALE, v[3] * X8_SCALE); }
            } else {
                v2u* o = (v2u*)(xb + (size_t)m * D) + lane;
#pragma unroll
                for (int j = 0; j < 8; ++j) { const f32x4 v = xr[64 * j]; s += (v[0] * v[0] + v[1] * v[1]) + (v[2] * v[2] + v[3] * v[3]); v2u w; w.x = pk2(v[0], v[1]); w.y = pk2(v[2], v[3]); o[64 * j] = w; }
            }
            s = wave_sum(s);
            if (lane == 0) ss0[m] = (u64)(s * SS_SCALE + 0.5f);
        }
    }
    if (blockIdx.x == 0) {
        float* tab = (float*)(F.ws + WS_TAB);
        for (int i = F.tid; i < 8 * 129; i += NTHR) { const int h = i / 129, dist = i % 129; tab[i] = I.relb[t5_bucket(dist) * 8 + h] * LOG2E; }
    }
}

typedef short bf16x8 __attribute__((ext_vector_type(8)));
typedef float f32x16 __attribute__((ext_vector_type(16)));
__device__ __forceinline__ unsigned cvtpk(float lo, float hi) { unsigned r; asm volatile("v_cvt_pk_bf16_f32 %0, %1, %2" : "=v"(r) : "v"(lo), "v"(hi)); return r; }
__device__ __forceinline__ bf16x8 mk_frag(v2u a, v2u b) { v4u w; w.x = a.x; w.y = a.y; w.z = b.x; w.w = b.y; return __builtin_bit_cast(bf16x8, w); }
__device__ __forceinline__ bf16x8 acc_frag(const f32x16& x, int s) {
    v4u w;
    if (s == 0) { w.x = cvtpk(x[0], x[1]); w.y = cvtpk(x[2], x[3]); w.z = cvtpk(x[4], x[5]); w.w = cvtpk(x[6], x[7]); }
    else        { w.x = cvtpk(x[8], x[9]); w.y = cvtpk(x[10], x[11]); w.z = cvtpk(x[12], x[13]); w.w = cvtpk(x[14], x[15]); }
    return __builtin_bit_cast(bf16x8, w);
}
#define MFMA32(a, b, c) __builtin_amdgcn_mfma_f32_32x32x16_bf16((a), (b), (c), 0, 0, 0)
template <bool DIAG>
__device__ __forceinline__ void sb_block(f32x16& O0, f32x16& O1, float& Rc, const bf16x8 (&Kc)[4], const bf16x8 (&Vc)[4], const bf16x8 (&Qf)[4], int r, int h) {
    f32x16 S;
#pragma unroll
    for (int i = 0; i < 16; ++i) S[i] = 0.f;
#pragma unroll
    for (int s = 0; s < 4; ++s) S = MFMA32(Kc[s], Qf[s], S);
    f32x4 B4[4], W4[4];
#pragma unroll
    for (int k = 0; k < 4; ++k) {
        f32x4 e4;
#pragma unroll
        for (int c = 0; c < 4; ++c) e4[c] = fexp2(__builtin_amdgcn_fmed3f(S[4 * k + c], -100.f, 100.f));
        const f32x4 d4 = e4 + 1.0f;
        f32x4 w4;
#pragma unroll
        for (int c = 0; c < 4; ++c) w4[c] = frcp(d4[c]);
        f32x4 b4 = e4 * w4;
        if (DIAG) {
#pragma unroll
            for (int c = 0; c < 4; ++c) if (c + 8 * k + 4 * h >= r) { w4[c] = 1.f; b4[c] = 0.f; }
        }
        W4[k] = w4; B4[k] = b4;
    }
    float G[4], oth[4];
#pragma unroll
    for (int k = 0; k < 4; ++k) {
        const float s2 = W4[k][3], s1 = s2 * W4[k][2], s0 = s1 * W4[k][1];
        G[k] = s0 * W4[k][0];
        B4[k] = B4[k] * (f32x4){s0, s1, s2, 1.0f};
    }
#pragma unroll
    for (int k = 0; k < 4; ++k) oth[k] = __shfl_xor(G[k], 32);
    const float EO3 = G[3] * oth[3], EO2 = G[2] * oth[2], EO1 = G[1] * oth[1], EO0 = G[0] * oth[0];
    float Tk[4]; Tk[3] = Rc; Tk[2] = EO3 * Rc; Tk[1] = Tk[2] * EO2; Tk[0] = Tk[1] * EO1;
    Rc = Tk[0] * EO0;
#pragma unroll
    for (int k = 0; k < 4; ++k) { const float sk = h == 0 ? Tk[k] * oth[k] : Tk[k]; B4[k] = B4[k] * sk; }
    v4u p0, p1;
    p0.x = cvtpk(B4[0][0], B4[0][1]); p0.y = cvtpk(B4[0][2], B4[0][3]); p0.z = cvtpk(B4[1][0], B4[1][1]); p0.w = cvtpk(B4[1][2], B4[1][3]);
    p1.x = cvtpk(B4[2][0], B4[2][1]); p1.y = cvtpk(B4[2][2], B4[2][3]); p1.z = cvtpk(B4[3][0], B4[3][1]); p1.w = cvtpk(B4[3][2], B4[3][3]);
    const bf16x8 P0 = __builtin_bit_cast(bf16x8, p0), P1 = __builtin_bit_cast(bf16x8, p1);
    O0 = MFMA32(Vc[0], P0, O0); O0 = MFMA32(Vc[1], P1, O0);
    O1 = MFMA32(Vc[2], P0, O1); O1 = MFMA32(Vc[3], P1, O1);
}
__device__ __forceinline__ void m_sb(Frame& F) {
    const bf16* qs = (const bf16*)(F.R + R_QS); const bf16* ks = (const bf16*)(F.R + R_KS); const bf16* vst = (const bf16*)(F.R + R_VST); float* osb = (float*)(F.R + R_OSB);
    const int lane = F.lane, r = lane & 31, h = lane >> 5;
    for (int unit = F.vcu; unit < 256; unit += F.G) {
        const int b = unit >> 6, p = (unit >> 1) & 31, head = (unit & 1) * 4 + (F.wave & 3);
#pragma unroll 1
        for (int pass = 0; pass < 1; ++pass) {
            const int qt = (F.wave >> 2) ? 63 - p : p;
            bf16x8 Qf[4];
            { const bf16* qrow = qs + (size_t)(b * T + 32 * qt + r) * 512 + head * 64 + 8 * h;
#pragma unroll
              for (int s = 0; s < 4; ++s) Qf[s] = *(const bf16x8*)(qrow + 16 * s); }
            const bf16* kbase = ks + (size_t)(b * 8 + head) * (T * 64) + lane * 8;
            const bf16* vbase = vst + (size_t)(b * 8 + head) * (T * 64) + lane * 8;
            f32x16 O0, O1;
#pragma unroll
            for (int i = 0; i < 16; ++i) { O0[i] = 0.f; O1[i] = 0.f; }
            float Rc = 1.f;
#define SB_LOAD(Kx, Vx, kbx) do { _Pragma("unroll") for (int s = 0; s < 4; ++s) { Kx[s] = *(const bf16x8*)(kbase + (size_t)((kbx) * 4 + s) * 512); Vx[s] = *(const bf16x8*)(vbase + (size_t)((kbx) * 4 + s) * 512); } } while (0)
            bf16x8 Kc[4], Vc[4], Kn[4], Vn[4];
            SB_LOAD(Kn, Vn, qt);
            SB_LOAD(Kc, Vc, (qt > 0 ? qt - 1 : 0));
            sb_block<true>(O0, O1, Rc, Kn, Vn, Qf, r, h);
            int kb = qt - 1;
#pragma unroll 1
            for (; kb >= 1; kb -= 2) {
                if (__all(Rc == 0.f)) { kb = -1; break; }
                SB_LOAD(Kn, Vn, kb - 1);
                sb_block<false>(O0, O1, Rc, Kc, Vc, Qf, r, h);
                SB_LOAD(Kc, Vc, (kb >= 2 ? kb - 2 : 0));
                sb_block<false>(O0, O1, Rc, Kn, Vn, Qf, r, h);
            }
            if (kb == 0) sb_block<false>(O0, O1, Rc, Kc, Vc, Qf, r, h);
#undef SB_LOAD
            float* orow = osb + (size_t)(b * T + 32 * qt + r) * 512 + head * 64 + 4 * h;
#pragma unroll
            for (int k = 0; k < 4; ++k) { *(f32x4*)(orow + 8 * k) = (f32x4){O0[4 * k], O0[4 * k + 1], O0[4 * k + 2], O0[4 * k + 3]};
                                          *(f32x4*)(orow + 32 + 8 * k) = (f32x4){O1[4 * k], O1[4 * k + 1], O1[4 * k + 2], O1[4 * k + 3]}; }
        }
    }
}
template <int MODE>
__device__ __forceinline__ void nsa_block(f32x16& O0, f32x16& O1, float& mrun, float& lrun, const bf16x8 (&Kc)[4], const bf16x8 (&Vc)[4], const bf16x8 (&Qf)[4], const LAS float* tabl, float tab128,
                                          int qt, int kb, unsigned msk, int r, int h) {
    f32x16 S;
#pragma unroll
    for (int i = 0; i < 16; ++i) S[i] = 0.f;
#pragma unroll
    for (int s = 0; s < 4; ++s) S = MFMA32(Kc[s], Qf[s], S);
    const int dq = qt - kb;
    const bool bit = MODE == 0 ? ((msk >> (kb >> 1)) & 1u) != 0u : true;
    const bool fast = MODE == 0 ? dq >= 5 : (dq >= 5 && dq <= 15);
    float bm;
    if (fast) {
        const float boff = bit ? tab128 : -3.0e38f;
        S = S + boff;
        bm = fmaxf(fmaxf(fmaxf(S[0], S[1]), fmaxf(S[2], S[3])), fmaxf(fmaxf(S[4], S[5]), fmaxf(S[6], S[7])));
        bm = fmaxf(bm, fmaxf(fmaxf(fmaxf(S[8], S[9]), fmaxf(S[10], S[11])), fmaxf(fmaxf(S[12], S[13]), fmaxf(S[14], S[15]))));
    } else {
        int d0 = 32 * dq + r - 4 * h;
        asm volatile("" : "+v"(d0));
        bm = -3.0e38f;
#pragma unroll
        for (int i = 0; i < 16; ++i) {
            const int dist = d0 - ((i & 3) + 8 * (i >> 2));
            const bool valid = bit && dist >= 0 && (MODE == 0 || dist < 512);
            const float sv = valid ? S[i] + tabl[dist < 0 ? 0 : (dist > 128 ? 128 : dist)] : -3.0e38f;
            S[i] = sv; bm = fmaxf(bm, sv);
        }
    }
    bm = fmaxf(bm, __shfl_xor(bm, 32));
    const float mnew = fmaxf(mrun, bm);
    if (__any(mnew != mrun)) {
        const float alpha = fexp2(mrun - mnew);
        lrun *= alpha; O0 = O0 * alpha; O1 = O1 * alpha; mrun = mnew;
    }
    if (fast) {
        S = S - mrun;
#pragma unroll
        for (int i = 0; i < 16; ++i) S[i] = fexp2(S[i]);
    } else {
#pragma unroll
        for (int i = 0; i < 16; ++i) S[i] = S[i] > -1.0e38f ? fexp2(S[i] - mrun) : 0.f;
    }
    lrun += ((S[0] + S[1]) + (S[2] + S[3])) + ((S[4] + S[5]) + (S[6] + S[7])) + ((S[8] + S[9]) + (S[10] + S[11])) + ((S[12] + S[13]) + (S[14] + S[15]));
    const bf16x8 P0 = acc_frag(S, 0), P1 = acc_frag(S, 1);
    O0 = MFMA32(Vc[0], P0, O0); O0 = MFMA32(Vc[1], P1, O0);
    O1 = MFMA32(Vc[2], P0, O1); O1 = MFMA32(Vc[3], P1, O1);
}
template <int MODE>
__device__ __forceinline__ void nsa_pass(f32x16& Ot0, f32x16& Ot1, const bf16x8 (&Qf)[4], const bf16* kbase, const bf16* vbase, const LAS float* tabl, int qt, int kb_lo, unsigned msk, float gate, int r, int h) {
    f32x16 O0, O1;
#pragma unroll
    for (int i = 0; i < 16; ++i) { O0[i] = 0.f; O1[i] = 0.f; }
    float mrun = -3.0e38f, lrun = 0.f;
    const float tab128 = tabl[128];
#define NSA_LD(X, base, kbx) do { _Pragma("unroll") for (int s = 0; s < 4; ++s) X[s] = *(const bf16x8*)((base) + (size_t)((kbx) * 4 + s) * 512); } while (0)
    bf16x8 Kc[4], Kn[4], Vc[4];
    NSA_LD(Kc, kbase, kb_lo);
    int kb = kb_lo;
#pragma unroll 1
    for (; kb + 1 <= qt; kb += 2) {
        NSA_LD(Vc, vbase, kb); NSA_LD(Kn, kbase, kb + 1);
        nsa_block<MODE>(O0, O1, mrun, lrun, Kc, Vc, Qf, tabl, tab128, qt, kb, msk, r, h);
        NSA_LD(Vc, vbase, kb + 1); NSA_LD(Kc, kbase, (kb + 2 <= qt ? kb + 2 : qt));
        nsa_block<MODE>(O0, O1, mrun, lrun, Kn, Vc, Qf, tabl, tab128, qt, kb + 1, msk, r, h);
    }
    if (kb == qt) { NSA_LD(Vc, vbase, kb); nsa_block<MODE>(O0, O1, mrun, lrun, Kc, Vc, Qf, tabl, tab128, qt, kb, msk, r, h); }
#undef NSA_LD
    lrun += __shfl_xor(lrun, 32);
    const float sc = gate / lrun;
    Ot0 = Ot0 + O0 * sc; Ot1 = Ot1 + O1 * sc;
}
__device__ __forceinline__ void m_nsa(Frame& F) {
    const bf16* qn = (const bf16*)(F.R + R_QN); const bf16* kn = (const bf16*)(F.R + R_KN); const bf16* vnt = (const bf16*)(F.R + R_VNT);
    const bf16* kc = (const bf16*)(F.R + R_KCMP); const bf16* vct = (const bf16*)(F.R + R_VCMPT); const float* dtg = (const float*)(F.R + R_DTG);
    float* onsa = (float*)(F.R + R_ONSA);
    LAS unsigned char* const l3 = (LAS unsigned char*)F.lds;
    LAS float* PS = (LAS float*)l3;
    LAS unsigned* SEL = (LAS unsigned*)(l3 + 32768);
    LAS float* TAB = (LAS float*)(l3 + 33024);
    LAS float* PINV = (LAS float*)(l3 + 37376);
    volatile LAS unsigned* HB = (volatile LAS unsigned*)(l3 + 38400);
    unsigned hb_target = 0u;
#define HALF_BARRIER() do { asm volatile("s_waitcnt vmcnt(0) lgkmcnt(0)" ::: "memory"); hb_target += 4u; if (lane == 0) __hip_atomic_fetch_add((LAS unsigned*)(HB + 16 * half), 1u, __ATOMIC_RELAXED, __HIP_MEMORY_SCOPE_WORKGROUP); \
        while ((unsigned)__builtin_amdgcn_readfirstlane((int)HB[16 * half]) < hb_target) __builtin_amdgcn_s_sleep(1); asm volatile("" ::: "memory"); } while (0)
    const int lane = F.lane, r = lane & 31, h = lane >> 5, g = F.wave & 3, half = F.wave >> 2;
    { const float* tab = (const float*)(F.ws + WS_TAB); for (int i = F.tid; i < 8 * 129; i += NTHR) TAB[i] = tab[i]; }
    __syncthreads();
    if (F.tid < 32) HB[F.tid] = 0u;
    __syncthreads();
    for (int unit = F.vcu; unit < 256; unit += F.G) {
        const int b = unit >> 6, p = (unit >> 1) & 31, hk = unit & 1, head = hk * 4 + g;
        const LAS float* tabl = TAB + head * 129;
#pragma unroll 1
        for (int pass = 0; pass < 1; ++pass) {
            const int qt = half ? 63 - p : p;
            int ln = lane; asm volatile("" : "+v"(ln));
            const int t = 32 * qt + r, row = b * T + 32 * qt + (ln & 31);
            bf16x8 Qf[4];
            { const bf16* qrow = qn + (size_t)row * 512 + head * 64 + 8 * (ln >> 5);
#pragma unroll
              for (int s = 0; s < 4; ++s) Qf[s] = *(const bf16x8*)(qrow + 16 * s); }
            const float* gl = dtg + (size_t)row * 64 + 16 + head * 3;
            const float g0 = sigmoid_f(gl[0]), g1 = sigmoid_f(gl[1]), g2 = sigmoid_f(gl[2]);
            f32x16 Ot0, Ot1;
            {
                const bf16* kcb = kc + (size_t)(b * 2 + hk) * (128 * 64) + ln * 8;
                float mx = -3.0e38f;
                const int ncb = (qt >> 4) + 1 < 4 ? (qt >> 4) + 1 : 4;
#pragma unroll 1
                for (int cb = 0; cb < ncb; ++cb) {
                    f32x16 S;
#pragma unroll
                    for (int i = 0; i < 16; ++i) S[i] = 0.f;
#pragma unroll
                    for (int s = 0; s < 4; ++s) S = MFMA32(*(const bf16x8*)(kcb + (size_t)(cb * 4 + s) * 512), Qf[s], S);
#pragma unroll
                    for (int i = 0; i < 16; ++i) {
                        const int c = 32 * cb + (i & 3) + 8 * (i >> 2) + 4 * h, dist = t - (16 * c + 31);
                        const bool valid = dist >= 0 && c < 127;
                        const float sv = valid ? S[i] + tabl[dist < 0 ? 0 : (dist > 128 ? 128 : dist)] : -3.0e38f;
                        mx = fmaxf(mx, sv);
                    }
                }
                mx = fmaxf(mx, __shfl_xor(mx, 32));
                const bf16* vcb = vct + (size_t)(b * 2 + hk) * (128 * 64) + ln * 8;
                f32x16 O0, O1;
#pragma unroll
                for (int i = 0; i < 16; ++i) { O0[i] = 0.f; O1[i] = 0.f; }
                float sum = 0.f, carry = 0.f;
                LAS float* psw = PS + ((half * 4 + g) * 32) * 32 + r;
#pragma unroll 1
                for (int cb = 0; cb < 4; ++cb) {
                    f32x16 S;
#pragma unroll
                    for (int i = 0; i < 16; ++i) S[i] = 0.f;
#pragma unroll
                    for (int s = 0; s < 4; ++s) S = MFMA32(*(const bf16x8*)(kcb + (size_t)(cb * 4 + s) * 512), Qf[s], S);
#pragma unroll
                    for (int i = 0; i < 16; ++i) {
                        const int c = 32 * cb + (i & 3) + 8 * (i >> 2) + 4 * h, dist = t - (16 * c + 31);
                        const bool valid = dist >= 0 && c < 127;
                        const float pv = valid ? fexp2(S[i] + tabl[dist < 0 ? 0 : (dist > 128 ? 128 : dist)] - mx) : 0.f;
                        S[i] = pv; sum += pv;
                    }
                    float pco[4];
#pragma unroll
                    for (int k = 0; k < 4; ++k) pco[k] = __shfl_xor(0.5f * S[4 * k + 3], 32);
#pragma unroll
                    for (int k = 0; k < 4; ++k) {
                        const float own = S[4 * k] + S[4 * k + 1] + S[4 * k + 2] + 0.5f * S[4 * k + 3];
                        const float cin = h ? pco[k] : (k > 0 ? pco[k > 0 ? k - 1 : 0] : carry);
                        psw[(8 * cb + 2 * k + h) * 32] = own + cin;
                    }
                    carry = pco[3];
#pragma unroll
                    for (int s = 0; s < 2; ++s) {
                        const bf16x8 Pf = acc_frag(S, s);
                        O0 = MFMA32(*(const bf16x8*)(vcb + (size_t)((cb * 2 + 0) * 2 + s) * 512), Pf, O0);
                        O1 = MFMA32(*(const bf16x8*)(vcb + (size_t)((cb * 2 + 1) * 2 + s) * 512), Pf, O1);
                    }
                }
                sum += __shfl_xor(sum, 32);
                const float inv = sum > 0.f ? 1.0f / sum : 0.f;
                if (h == 0) PINV[(half * 4 + g) * 32 + r] = inv;
                const float gi = g0 * inv;
#pragma unroll
                for (int i = 0; i < 16; ++i) { Ot0[i] = gi * O0[i]; Ot1[i] = gi * O1[i]; }
            }
            HALF_BARRIER();
            {
                const int tt = 8 * g + (ln >> 3), s8 = ln & 7, tq = 32 * qt + tt, cur = tq >> 6;
                const float iv0 = PINV[(half * 4 + 0) * 32 + tt], iv1 = PINV[(half * 4 + 1) * 32 + tt], iv2 = PINV[(half * 4 + 2) * 32 + tt], iv3 = PINV[(half * 4 + 3) * 32 + tt];
                float sc[4];
#pragma unroll
                for (int i = 0; i < 4; ++i) {
                    const int j = s8 + 8 * i;
                    const LAS float* pp = PS + ((half * 4) * 32 + j) * 32 + tt;
                    const float v = (pp[0] * iv0 + pp[1024] * iv1) + (pp[2048] * iv2 + pp[3072] * iv3);
                    sc[i] = (64 * j <= tq) ? v + ((j == 0 || j == cur || j == cur - 1) ? 1000.f : 0.f) : -3.0e38f;
                }
                unsigned mk = 0u;
#pragma unroll 1
                for (int it = 0; it < 8; ++it) {
                    float bv = sc[0]; int bj = s8;
#pragma unroll
                    for (int i = 1; i < 4; ++i) if (sc[i] > bv) { bv = sc[i]; bj = s8 + 8 * i; }
#pragma unroll
                    for (int off = 1; off < 8; off <<= 1) { const float ov = __shfl_xor(bv, off); const int oj = __shfl_xor(bj, off); if (ov > bv || (ov == bv && oj < bj)) { bv = ov; bj = oj; } }
                    if (bv > -1.0e38f) mk |= 1u << bj;
                    const bool mine = (bj & 7) == s8;
#pragma unroll
                    for (int i = 0; i < 4; ++i) sc[i] = (mine && (bj >> 3) == i) ? -3.0e38f : sc[i];
                }
                if (s8 == 0) SEL[half * 32 + tt] = mk;
            }
            HALF_BARRIER();
            const unsigned msk = SEL[half * 32 + r];
            nsa_pass<0>(Ot0, Ot1, Qf, kn + (size_t)(b * 4 + hk) * (T * 64) + ln * 8, vnt + (size_t)(b * 4 + hk) * (T * 64) + ln * 8, tabl, qt, 0, msk, g1, r, h);
            nsa_pass<1>(Ot0, Ot1, Qf, kn + (size_t)(b * 4 + 2 + hk) * (T * 64) + ln * 8, vnt + (size_t)(b * 4 + 2 + hk) * (T * 64) + ln * 8, tabl, qt, qt > 16 ? qt - 16 : 0, 0u, g2, r, h);
            float* orow = onsa + (size_t)row * 512 + head * 64 + 4 * (ln >> 5);
#pragma unroll
            for (int k = 0; k < 4; ++k) { *(f32x4*)(orow + 8 * k) = (f32x4){Ot0[4 * k], Ot0[4 * k + 1], Ot0[4 * k + 2], Ot0[4 * k + 3]};
                                          *(f32x4*)(orow + 32 + 8 * k) = (f32x4){Ot1[4 * k], Ot1[4 * k + 1], Ot1[4 * k + 2], Ot1[4 * k + 3]}; }
            HALF_BARRIER();
        }
    }
}
#undef HALF_BARRIER
__device__ __forceinline__ void m_compress(Frame& F, int layer) {
    const bf16* raw = (const bf16*)(F.R + R_CMPRAW); bf16* kc = (bf16*)(F.R + R_KCMP); bf16* vct = (bf16*)(F.R + R_VCMPT);
    LAS float* RED = (LAS float*)(LAS unsigned char*)F.lds;
    const int lane = F.lane, w = F.wave;
    for (int item = F.vcu; item < 128; item += F.G) {
        const int dt = item & 1, rest = item >> 1, ct = rest & 3, hk = (rest >> 2) & 1, b = (rest >> 3) & 3, kind = rest >> 5, mat = layer * 2 + kind;
        const bf16* ap = raw + ((size_t)(((kind * 2 + hk) * 4 + b) * 4 + ct) * 128 + 16 * w) * 512 + lane * 8;
        const bf16* bp = (const bf16*)(F.ws + WS_CW) + (size_t)mat * (64 * 2048) + (size_t)(128 * dt + 16 * w) * 512 + lane * 8;
        const float* pb = (const float*)(F.ws + WS_TAB + TAB_PB) + mat * 16 * 64 + 32 * dt + (lane & 31);
        float pbv = 0.f;
#pragma unroll
        for (int sl = 0; sl < 16; ++sl) pbv += pb[sl * 64];
        f32x16 a0;
        for (int rep_a = 0; rep_a < REP_CMPA; ++rep_a) {
#pragma unroll
        for (int i = 0; i < 16; ++i) a0[i] = 0.f;
#pragma unroll
        for (int s = 0; s < 16; ++s) a0 = MFMA32(*(const bf16x8*)(ap + (size_t)s * 512), *(const bf16x8*)(bp + (size_t)s * 512), a0);
        }
        for (int rep_b = 0; rep_b < REP_CMPB; ++rep_b) {
#pragma unroll
        for (int i = 0; i < 16; ++i) RED[(w * 16 + i) * 64 + lane] = a0[i];
        __syncthreads();
#pragma unroll
        for (int q = 0; q < 2; ++q) {
            const int o = F.tid + NTHR * q, ln = o & 63, i = (o >> 6) & 15;
            float sum = 0.f;
#pragma unroll
            for (int ww = 0; ww < 8; ++ww) sum += RED[(ww * 16 + i) * 64 + ln];
            const int c = 32 * ct + (i & 3) + 8 * (i >> 2) + 4 * (ln >> 5), dd = 32 * dt + (ln & 31);
            const float val = c < 127 ? sum + pbv : 0.f;
            if (kind == 0) kc[(size_t)(b * 2 + hk) * (128 * 64) + kfrag_off(c, dd & ~7) + (dd & 7)] = (bf16)f2bf(val);
            else vct[(size_t)(b * 2 + hk) * (128 * 64) + vfrag_off(c, dd)] = (bf16)f2bf(val);
        }
        __syncthreads();
        }
    }
}
constexpr int SL = 64, SNC = T / SL;
__device__ __forceinline__ void m_ssd_s1(Frame& F, int layer, const float* conv_w, const float* conv_b, const float* dt_bias, const float* a_log) {
    const bf16* xbc = (const bf16*)(F.R + R_XBC); const float* dtg = (const float*)(F.R + R_DTG);
    bf16* xt = (bf16*)(F.R + R_XT); bf16* bm = (bf16*)(F.R + R_BM); bf16* cm = (bf16*)(F.R + R_CM); float* dtb = (float*)(F.R + R_DT); float* acsb = (float*)(F.R + R_ACS); float* aend = (float*)(F.R + R_AEND);
    bf16* st = (bf16*)(F.R + R_ST);
    const float* cw = conv_w + (size_t)layer * 4 * 1536; const float* cb = conv_b + (size_t)layer * 1536;
    LAS unsigned char* const l3 = (LAS unsigned char*)F.lds;
    LAS bf16* XTL = (LAS bf16*)l3;
    LAS bf16* BMTL = (LAS bf16*)(l3 + 73728);
    LAS float* SCL = (LAS float*)(l3 + 92160);
    const int lane = F.lane, r = lane & 31, h = lane >> 5, e = F.wave;
    for (int item = F.vcu; item < BATCH * SNC * 2; item += F.G) {
        const int g = item & 1, c = (item >> 1) & (SNC - 1), b = item >> 6, t0 = c * SL;
        for (int rep_a = 0; rep_a < REP_S1A; ++rep_a)
#pragma unroll 1
        for (int id = F.tid; id < 96 * 16; id += NTHR) {
            const int c8 = id % 96, q = id / 96;
            const int col = c8 < 64 ? 512 * g + 8 * c8 : (c8 < 80 ? 1024 + 128 * g + 8 * (c8 - 64) : 1280 + 128 * g + 8 * (c8 - 80));
            float u[7][8];
#pragma unroll
            for (int i = 0; i < 7; ++i) {
                const int tt = t0 + 4 * q - 3 + i;
                v4u w = (v4u){0u, 0u, 0u, 0u};
                if (tt >= 0) w = *(const v4u*)(xbc + ((size_t)b * T + tt) * 1536 + col);
                u[i][0] = __uint_as_float(w.x << 16); u[i][1] = __uint_as_float(w.x & 0xffff0000u); u[i][2] = __uint_as_float(w.y << 16); u[i][3] = __uint_as_float(w.y & 0xffff0000u);
                u[i][4] = __uint_as_float(w.z << 16); u[i][5] = __uint_as_float(w.z & 0xffff0000u); u[i][6] = __uint_as_float(w.w << 16); u[i][7] = __uint_as_float(w.w & 0xffff0000u);
            }
            float wk[4][8], bias[8];
#pragma unroll
            for (int k = 0; k < 4; ++k) { const f32x4 a0 = *(const f32x4*)(cw + k * 1536 + col), a1 = *(const f32x4*)(cw + k * 1536 + col + 4);
                wk[k][0] = a0[0]; wk[k][1] = a0[1]; wk[k][2] = a0[2]; wk[k][3] = a0[3]; wk[k][4] = a1[0]; wk[k][5] = a1[1]; wk[k][6] = a1[2]; wk[k][7] = a1[3]; }
            { const f32x4 a0 = *(const f32x4*)(cb + col), a1 = *(const f32x4*)(cb + col + 4);
              bias[0] = a0[0]; bias[1] = a0[1]; bias[2] = a0[2]; bias[3] = a0[3]; bias[4] = a1[0]; bias[5] = a1[1]; bias[6] = a1[2]; bias[7] = a1[3]; }
            float y[4][8];
#pragma unroll
            for (int j = 0; j < 4; ++j)
#pragma unroll
                for (int i = 0; i < 8; ++i) y[j][i] = silu_f(bias[i] + wk[0][i] * u[j][i] + wk[1][i] * u[j + 1][i] + wk[2][i] * u[j + 2][i] + wk[3][i] * u[j + 3][i]);
            if (c8 < 64) {
                const int he = c8 >> 3, p0 = 8 * (c8 & 7);
#pragma unroll
                for (int i = 0; i < 8; ++i) { v2u pk; pk.x = pk2(y[0][i], y[1][i]); pk.y = pk2(y[2][i], y[3][i]);
                    *(LAS v2u*)(XTL + (he * 64 + p0 + i) * 72 + 4 * q) = pk; }
            } else {
                const int n0 = 8 * (c8 < 80 ? c8 - 64 : c8 - 80);
                if (c8 < 80) {
#pragma unroll
                    for (int i = 0; i < 8; ++i) { v2u pk; pk.x = pk2(y[0][i], y[1][i]); pk.y = pk2(y[2][i], y[3][i]); *(LAS v2u*)(BMTL + (n0 + i) * 72 + 4 * q) = pk; }
                }
                bf16* dst = (c8 < 80 ? bm : cm) + ((size_t)((((b * 2 + g) * SNC + c) * 2 + (q >> 3)) * 8 + (n0 >> 4)) * 64 + 32 * ((n0 >> 3) & 1) + 4 * (q & 7)) * 8;
#pragma unroll
                for (int j = 0; j < 4; ++j) { v4u pk; pk.x = pk2(y[j][0], y[j][1]); pk.y = pk2(y[j][2], y[j][3]); pk.z = pk2(y[j][4], y[j][5]); pk.w = pk2(y[j][6], y[j][7]); *(v4u*)(dst + 8 * j) = pk; }
            }
        }
        for (int rep_b = 0; rep_b < REP_S1B; ++rep_b) {
            const int hd = 8 * g + e;
            const float v = dtg[((size_t)b * T + t0 + lane) * 64 + hd] + dt_bias[layer * 16 + hd];
            const float dtv = v > 20.f ? v : log1pf(expf(v));
            const float a = -expf(a_log[layer * 16 + hd]);
            float cs = dtv * a;
#pragma unroll
            for (int off = 1; off < 64; off <<= 1) { const float up = __shfl_up(cs, off); if (lane >= off) cs += up; }
            const float cend = __shfl(cs, 63);
            dtb[(size_t)(b * 16 + hd) * T + t0 + lane] = dtv; acsb[(size_t)(b * 16 + hd) * T + t0 + lane] = cs;
            if (lane == 0) aend[(size_t)(b * 16 + hd) * SNC + c] = cend;
            SCL[e * 64 + lane] = dtv * fexp2((cend - cs) * LOG2E);
        }
        __syncthreads();
#pragma unroll
        for (int ps = 0; ps < 8; ++ps) { const int row = (F.tid >> 3) + 64 * ps, q8 = F.tid & 7;
            const v4u wv = *(const LAS v4u*)(XTL + row * 72 + 8 * q8);
            *(v4u*)(xt + ((size_t)(b * 16 + 8 * g) * 64 + row) * T + t0 + 8 * q8) = wv; }
        for (int rep_c = 0; rep_c < REP_S1C; ++rep_c)
#pragma unroll 1
        for (int nh = 0; nh < 2; ++nh) {
            f32x16 acc[2][2];
#pragma unroll
            for (int a = 0; a < 2; ++a)
#pragma unroll
                for (int q = 0; q < 2; ++q)
#pragma unroll
                    for (int i = 0; i < 16; ++i) acc[a][q][i] = 0.f;
#pragma unroll
            for (int s = 0; s < 4; ++s) {
                bf16x8 Af[2], Bf[2];
#pragma unroll
                for (int pt = 0; pt < 2; ++pt) Af[pt] = *(const LAS bf16x8*)(XTL + (e * 64 + 32 * pt + r) * 72 + 16 * s + 8 * h);
                const f32x4 sc0 = *(const LAS f32x4*)(SCL + e * 64 + 16 * s + 8 * h), sc1 = *(const LAS f32x4*)(SCL + e * 64 + 16 * s + 8 * h + 4);
#pragma unroll
                for (int nt = 0; nt < 2; ++nt) {
                    const v4u raw = *(const LAS v4u*)(BMTL + (64 * nh + 32 * nt + r) * 72 + 16 * s + 8 * h);
                    v4u w;
                    w.x = cvtpk(__uint_as_float(raw.x << 16) * sc0[0], __uint_as_float(raw.x & 0xffff0000u) * sc0[1]);
                    w.y = cvtpk(__uint_as_float(raw.y << 16) * sc0[2], __uint_as_float(raw.y & 0xffff0000u) * sc0[3]);
                    w.z = cvtpk(__uint_as_float(raw.z << 16) * sc1[0], __uint_as_float(raw.z & 0xffff0000u) * sc1[1]);
                    w.w = cvtpk(__uint_as_float(raw.w << 16) * sc1[2], __uint_as_float(raw.w & 0xffff0000u) * sc1[3]);
                    Bf[nt] = __builtin_bit_cast(bf16x8, w);
                }
#pragma unroll
                for (int pt = 0; pt < 2; ++pt)
#pragma unroll
                    for (int nt = 0; nt < 2; ++nt) acc[pt][nt] = MFMA32(Af[pt], Bf[nt], acc[pt][nt]);
            }
            bf16* sp = st + ((size_t)((b * SNC + c) * 16 + 8 * g + e) * 64) * 128 + 64 * nh + r;
#pragma unroll
            for (int pt = 0; pt < 2; ++pt)
#pragma unroll
                for (int nt = 0; nt < 2; ++nt)
#pragma unroll
                    for (int i = 0; i < 16; ++i) sp[(size_t)(32 * pt + (i & 3) + 8 * (i >> 2) + 4 * h) * 128 + 32 * nt] = (bf16)f2bf(acc[pt][nt][i]);
        }
        __syncthreads();
    }
}
__device__ __forceinline__ void m_ssd_s2(Frame& F) {
    const bf16* st = (const bf16*)(F.R + R_ST); const float* aend = (const float*)(F.R + R_AEND); bf16* hin = (bf16*)(F.R + R_HIN);
    for (int gid = F.vcu * NTHR + F.tid; gid < BATCH * 16 * 64 * 32; gid += F.G * NTHR) {
        const int n4 = gid & 31, p = (gid >> 5) & 63, hd = (gid >> 11) & 15, b = gid >> 15;
        f32x4 hv = (f32x4){0.f, 0.f, 0.f, 0.f};
        const size_t cstride = (size_t)16 * 64 * 128;
        size_t off = ((size_t)(b * SNC * 16 + hd) * 64 + p) * 128 + 4 * n4;
        size_t hoff = (size_t)(b * SNC * 16 + hd) * (64 * 128) + ((size_t)((p >> 5) * 8 + (n4 >> 2)) * 64 + 32 * ((n4 >> 1) & 1) + (p & 31)) * 8 + 4 * (n4 & 1);
#pragma unroll
        for (int c = 0; c < SNC; ++c) {
            v2u w; w.x = pk2(hv[0], hv[1]); w.y = pk2(hv[2], hv[3]);
            *(v2u*)(hin + hoff) = w; hoff += cstride;
            const float dec = fexp2(aend[(size_t)(b * 16 + hd) * SNC + c] * LOG2E);
            const v2u sw = *(const v2u*)(st + off);
            const f32x4 sv = (f32x4){__uint_as_float(sw.x << 16), __uint_as_float(sw.x & 0xffff0000u), __uint_as_float(sw.y << 16), __uint_as_float(sw.y & 0xffff0000u)};
            hv = hv * dec + sv; off += cstride;
        }
    }
}
__device__ __forceinline__ void m_ssd_s3(Frame& F, int layer, const float* d_skip) {
    const bf16* xt = (const bf16*)(F.R + R_XT); const bf16* bm = (const bf16*)(F.R + R_BM); const bf16* cm = (const bf16*)(F.R + R_CM); const float* dtb = (const float*)(F.R + R_DT); const float* acsb = (const float*)(F.R + R_ACS);
    const bf16* hin = (const bf16*)(F.R + R_HIN); const bf16* zb = (const bf16*)(F.R + R_Z); bf16* mixed = (bf16*)(F.R + R_MIXED);
    LAS unsigned char* const l3 = (LAS unsigned char*)F.lds;
    LAS float* DTL = (LAS float*)l3;
    LAS float* ACL = (LAS float*)(l3 + 2048);
    LAS float* SSQ = (LAS float*)(l3 + 4096);
    LAS unsigned char* const OTL = l3 + 8192;
    const int lane = F.lane, r = lane & 31, h = lane >> 5, e = F.wave;
    for (int item = F.vcu; item < BATCH * SNC * 2; item += F.G) {
        const int g = item & 1, c = (item >> 1) & (SNC - 1), b = item >> 6, t0 = c * SL, hd = 8 * g + e;
        DTL[e * 64 + lane] = dtb[(size_t)(b * 16 + hd) * T + t0 + lane];
        ACL[e * 64 + lane] = acsb[(size_t)(b * 16 + hd) * T + t0 + lane];
        f32x16 cbt[3], yo[2][2];
#pragma unroll
        for (int i = 0; i < 16; ++i) { cbt[0][i] = 0.f; cbt[1][i] = 0.f; cbt[2][i] = 0.f; yo[0][0][i] = 0.f; yo[0][1][i] = 0.f; yo[1][0][i] = 0.f; yo[1][1][i] = 0.f; }
        const bf16* bmp = bm + (size_t)((b * 2 + g) * SNC + c) * (64 * 128) + lane * 8;
        const bf16* cmp_ = cm + (size_t)((b * 2 + g) * SNC + c) * (64 * 128) + lane * 8;
        const bf16* hp = hin + (size_t)((b * SNC + c) * 16 + hd) * (64 * 128) + lane * 8;
#pragma unroll 2
        for (int k = 0; k < 8; ++k) {
            const bf16x8 b0 = *(const bf16x8*)(bmp + (size_t)k * 512), b1 = *(const bf16x8*)(bmp + (size_t)(8 + k) * 512);
            const bf16x8 c0 = *(const bf16x8*)(cmp_ + (size_t)k * 512), c1 = *(const bf16x8*)(cmp_ + (size_t)(8 + k) * 512);
            const bf16x8 h0 = *(const bf16x8*)(hp + (size_t)k * 512), h1 = *(const bf16x8*)(hp + (size_t)(8 + k) * 512);
            cbt[0] = MFMA32(b0, c0, cbt[0]); cbt[1] = MFMA32(b0, c1, cbt[1]); cbt[2] = MFMA32(b1, c1, cbt[2]);
            yo[0][0] = MFMA32(h0, c0, yo[0][0]); yo[0][1] = MFMA32(h0, c1, yo[0][1]); yo[1][0] = MFMA32(h1, c0, yo[1][0]); yo[1][1] = MFMA32(h1, c1, yo[1][1]);
        }
        __builtin_amdgcn_wave_barrier(); LDS_WAIT();
        const float Dk = d_skip[layer * 16 + hd];
        const float acl0 = ACL[e * 64 + r], acl1 = ACL[e * 64 + 32 + r];
        { const float e0 = fexp2(acl0 * LOG2E), e1 = fexp2(acl1 * LOG2E);
#pragma unroll
          for (int i = 0; i < 16; ++i) { yo[0][0][i] *= e0; yo[1][0][i] *= e0; yo[0][1][i] *= e1; yo[1][1][i] *= e1; } }
#pragma unroll
        for (int tl = 0; tl < 3; ++tl) {
            const int stl = tl == 2 ? 1 : 0, ltl = tl == 0 ? 0 : 1;
            const float al = ltl ? acl1 : acl0;
#pragma unroll
            for (int i = 0; i < 16; ++i) {
                const int sidx = 32 * stl + (i & 3) + 8 * (i >> 2) + 4 * h, lidx = 32 * ltl + r;
                const float as = ACL[e * 64 + sidx], ds = DTL[e * 64 + sidx];
                float v = sidx <= lidx ? cbt[tl][i] * fexp2((al - as) * LOG2E) * ds : 0.f;
                if (sidx == lidx) v += Dk;
                cbt[tl][i] = v;
            }
        }
        const bf16* xp = xt + ((size_t)(b * 16 + hd) * 64 + r) * T + t0 + 4 * h;
#pragma unroll
        for (int pt = 0; pt < 2; ++pt) {
            const bf16* xq = xp + (size_t)(32 * pt) * T;
#pragma unroll
            for (int k2 = 0; k2 < 2; ++k2) {
                const bf16x8 a0 = mk_frag(*(const v2u*)(xq + 16 * k2), *(const v2u*)(xq + 16 * k2 + 8));
                const bf16x8 a1 = mk_frag(*(const v2u*)(xq + 32 + 16 * k2), *(const v2u*)(xq + 32 + 16 * k2 + 8));
                yo[pt][0] = MFMA32(a0, acc_frag(cbt[0], k2), yo[pt][0]);
                yo[pt][1] = MFMA32(a0, acc_frag(cbt[1], k2), yo[pt][1]);
                yo[pt][1] = MFMA32(a1, acc_frag(cbt[2], k2), yo[pt][1]);
            }
        }
        float ssq[2] = {0.f, 0.f};
#pragma unroll
        for (int lt = 0; lt < 2; ++lt) {
            const bf16* zp = zb + ((size_t)b * T + t0 + 32 * lt + r) * 1024 + hd * 64 + 4 * h;
#pragma unroll
            for (int pt = 0; pt < 2; ++pt)
#pragma unroll
                for (int k = 0; k < 4; ++k) {
                    const v2u zz = *(const v2u*)(zp + 32 * pt + 8 * k);
                    const float z0 = __uint_as_float(zz.x << 16), z1 = __uint_as_float(zz.x & 0xffff0000u), z2 = __uint_as_float(zz.y << 16), z3 = __uint_as_float(zz.y & 0xffff0000u);
                    float v0 = yo[pt][lt][4 * k] * silu_f(z0), v1 = yo[pt][lt][4 * k + 1] * silu_f(z1), v2 = yo[pt][lt][4 * k + 2] * silu_f(z2), v3 = yo[pt][lt][4 * k + 3] * silu_f(z3);
                    yo[pt][lt][4 * k] = v0; yo[pt][lt][4 * k + 1] = v1; yo[pt][lt][4 * k + 2] = v2; yo[pt][lt][4 * k + 3] = v3;
                    ssq[lt] += (v0 * v0 + v1 * v1) + (v2 * v2 + v3 * v3);
                }
            ssq[lt] += __shfl_xor(ssq[lt], 32);
        }
        if (h == 0) { SSQ[e * 64 + r] = ssq[0]; SSQ[e * 64 + 32 + r] = ssq[1]; }
        __syncthreads();
#pragma unroll
        for (int lt = 0; lt < 2; ++lt) {
            float tot = 0.f;
#pragma unroll
            for (int w = 0; w < 8; ++w) tot += SSQ[w * 64 + 32 * lt + r];
            const float rs = rsqrtf(tot * (1.0f / 512.0f) + EPS);
            LAS unsigned char* wr = OTL + e * 9216 + (32 * lt + r) * 144 + 8 * h;
#pragma unroll
            for (int pt = 0; pt < 2; ++pt)
#pragma unroll
                for (int k = 0; k < 4; ++k) { v2u w; w.x = pk2(yo[pt][lt][4 * k] * rs, yo[pt][lt][4 * k + 1] * rs); w.y = pk2(yo[pt][lt][4 * k + 2] * rs, yo[pt][lt][4 * k + 3] * rs); *(LAS v2u*)(wr + 64 * pt + 16 * k) = w; }
        }
        __builtin_amdgcn_wave_barrier(); LDS_WAIT();
#pragma unroll
        for (int ps = 0; ps < 8; ++ps) { const int tok = (lane >> 3) + 8 * ps, pc = lane & 7;
            const v4u wv = *(const LAS v4u*)(OTL + e * 9216 + tok * 144 + 16 * pc);
            *(v4u*)(mixed + ((size_t)b * T + t0 + tok) * D + 1024 + hd * 64 + 8 * pc) = wv; }
        __syncthreads();
    }
}
__device__ __forceinline__ void m_norms2(Frame& F) {
    const float* onsa = (const float*)(F.R + R_ONSA); const float* osb = (const float*)(F.R + R_OSB); bf16* mixed = (bf16*)(F.R + R_MIXED);
    const int gw = F.vcu * NWAVES + F.wave, NGW = F.G * NWAVES, lane = F.lane;
    for (int w = gw; w < M * 2; w += NGW) {
        const int seg = w & 1, row = w >> 1;
        const float* src = (seg == 0 ? onsa : osb) + (size_t)row * 512;
        const f32x4 v0 = *((const f32x4*)src + lane), v1 = *((const f32x4*)src + 64 + lane);
        float sq = (v0[0] * v0[0] + v0[1] * v0[1]) + (v0[2] * v0[2] + v0[3] * v0[3]) + (v1[0] * v1[0] + v1[1] * v1[1]) + (v1[2] * v1[2] + v1[3] * v1[3]);
        sq = wave_sum(sq);
        const float rr = rsqrtf(sq * (1.0f / 512.0f) + EPS);
        bf16* dst = mixed + (size_t)row * D + seg * 512;
        v2u w0; w0.x = pk2(v0[0] * rr, v0[1] * rr); w0.y = pk2(v0[2] * rr, v0[3] * rr); *((v2u*)dst + lane) = w0;
        v2u w1; w1.x = pk2(v1[0] * rr, v1[1] * rr); w1.y = pk2(v1[2] * rr, v1[3] * rr); *((v2u*)dst + 64 + lane) = w1;
    }
}
__device__ __forceinline__ void p_quant_x(Frame& F) {
    const int gw = F.vcu * NWAVES + F.wave, NGW = F.G * NWAVES, lane = F.lane;
    float* xsc = (float*)(F.ws + WS_TAB + TAB_XS);
    for (int m = gw; m < M; m += 2 * NGW) {
        const int m2 = m + NGW; const bool two = m2 < M;
        const f32x4* xr = (const f32x4*)(F.out + (size_t)m * D) + lane; const f32x4* xr2 = (const f32x4*)(F.out + (size_t)(two ? m2 : m) * D) + lane;
        f32x4 v[8], w[8]; float mx = 0.f, mx2 = 0.f;
#pragma unroll
        for (int j = 0; j < 8; ++j) { v[j] = xr[64 * j]; w[j] = xr2[64 * j]; }
#pragma unroll
        for (int j = 0; j < 8; ++j) { mx = fmaxf(fmaxf(mx, fmaxf(fabsf(v[j][0]), fabsf(v[j][1]))), fmaxf(fabsf(v[j][2]), fabsf(v[j][3])));
                                      mx2 = fmaxf(fmaxf(mx2, fmaxf(fabsf(w[j][0]), fabsf(w[j][1]))), fmaxf(fabsf(w[j][2]), fabsf(w[j][3]))); }
        mx = fmaxf(wave_max(mx), 1e-30f); mx2 = fmaxf(wave_max(mx2), 1e-30f);
        const float inv = 127.0f / mx, inv2 = 127.0f / mx2;
        unsigned* o = (unsigned*)(F.ws + WS_XB + (size_t)m * D) + lane;
#pragma unroll
        for (int j = 0; j < 8; ++j) o[64 * j] = pk4_i8(v[j][0] * inv, v[j][1] * inv, v[j][2] * inv, v[j][3] * inv);
        if (lane == 0) xsc[m] = mx * (1.0f / 127.0f);
        if (two) {
            unsigned* o2 = (unsigned*)(F.ws + WS_XB + (size_t)m2 * D) + lane;
#pragma unroll
            for (int j = 0; j < 8; ++j) o2[64 * j] = pk4_i8(w[j][0] * inv2, w[j][1] * inv2, w[j][2] * inv2, w[j][3] * inv2);
            if (lane == 0) xsc[m2] = mx2 * (1.0f / 127.0f);
        }
    }
}
__device__ __forceinline__ void p_final(Frame& F, const float* gain) {
    const u64* ssf = ssptr(F, 6);
    const int gw = F.vcu * NWAVES + F.wave, NGW = F.G * NWAVES, lane = F.lane;
    for (int m = gw; m < M; m += NGW) {
        const float r = rstd_of(ssf[m]);
        f32x4* xr = (f32x4*)(F.out + (size_t)m * D) + lane;
#pragma unroll
        for (int j = 0; j < 8; ++j) { const f32x4 g = *((const f32x4*)gain + 64 * j + lane); f32x4 v = xr[64 * j]; v = v * r * g; xr[64 * j] = v; }
    }
}

#define SEG_BODY(SEGNO) do { constexpr int seg = (SEGNO); \
        const int layer = seg >> 1, second = seg & 1; \
        if (IN_PH()) { \
            FRAME(); \
            { pg8::Gemm g{(const bf16*)(F.ws + WS_XB), wptr(F, layer, second ? WL_GU2 : WL_GU1), M, NGU, (gu8(seg) || gui8(seg)) ? D / 2 : D}; pg8::StaticOrder S; S.init(M, NGU, F.G, F.vcu); \
            EpiGateUp E{(bf16*)(F.R + R_H), ssptr(F, 3 * layer + (second ? 2 : 0)), gui8(seg) ? __uint_as_float(((const unsigned*)F.ctlf)[CW_WMAX]) * (1.0f / 127.0f) : (gu8(seg) ? GU8_UNSCALE : 1.0f), dn8(seg) ? 1 : 0, \
                        (const float*)(F.ws + WS_TAB + TAB_XS), gui8(seg) ? 1 : 0}; \
            REPEAT(REP_GU, pg8::gemm_phase<EpiGateUp, pg8::StaticOrder, true, GEMM_SP2, gui8(seg) ? 2 : (gu8(seg) ? 1 : 0)>(glds, g, S, E)); } \
            if (CVM_GU[seg] != 0u && F.vcu >= F.G / 2) { \
                KArgs kb = kargs(); Frame F2 = make_frame(kb->ws, kb->out, lds); \
                ProIn I{kb->in[0], kb->in[1], kb->in[2], kb->in[3], kb->in[4], kb->in[5], kb->in[6], kb->in[7], kb->in[8], kb->in[11], kb->in[12], kb->in[18], kb->in[19], kb->in[20], kb->in[21], kb->in[22], kb->in[9], kb->in[10]}; \
                convert_weights<CVM_GU[seg]>(F2, I, (F2.vcu - F2.G / 2) * NWAVES + F2.wave, (F2.G / 2) * NWAVES); \
            } \
        } \
        END_PH(); \
        if (IN_PH()) { \
            FRAME(); \
            pg8::Gemm g{(const bf16*)(F.R + R_H), wptr(F, layer, second ? WL_DN2 : WL_DN1), M, D, dn8(seg) ? FF / 2 : FF}; pg8::StaticOrder S; S.init(M, D, F.G, F.vcu); \
            if (FUSE_X && seg == 3) { \
                EpiResidFin E{(const float*)F.out, F.out, INP(23), dn8(seg) ? 0.5f * DN8_UNSCALE : 0.5f, PanelX{(float*)(F.ws + WS_TAB + TAB_PX) + (size_t)M * 8, (unsigned*)F.ctlf + CW_PX + 2048}}; \
                pg8::gemm_phase<EpiResidFin, pg8::StaticOrder, true, GEMM_SP2, dn8(seg) ? 1 : 0>(glds, g, S, E); \
            } else if (FUSE_X && !second && wini8(layer)) { \
                EpiResidQ8 E{seg == 0 ? INP(0) : (const float*)F.out, F.out, (unsigned char*)(F.ws + WS_XB), (float*)(F.ws + WS_TAB + TAB_XS), ssptr(F, 3 * layer + 1), dn8(seg) ? 0.5f * DN8_UNSCALE : 0.5f, \
                             PanelX{(float*)(F.ws + WS_TAB + TAB_PX), (unsigned*)F.ctlf + CW_PX}}; \
                pg8::gemm_phase<EpiResidQ8, pg8::StaticOrder, true, GEMM_SP2, dn8(seg) ? 1 : 0>(glds, g, S, E); \
            } else { \
            EpiResid E{seg == 0 ? INP(0) : (const float*)F.out, F.out, (bf16*)(F.ws + WS_XB), ssptr(F, second ? 3 * (layer + 1) : 3 * layer + 1), dn8(seg) ? 0.5f * DN8_UNSCALE : 0.5f, (second && gu8(seg + 1)) ? 1 : ((!second && wini8(layer)) ? 2 : 0)}; \
            pg8::gemm_phase<EpiResid, pg8::StaticOrder, true, GEMM_SP2, dn8(seg) ? 1 : 0>(glds, g, S, E); } \
        } \
        END_PH(); \
        if (!second) { \
            if (wini8(layer) && !FUSE_X) { \
                if (IN_PH()) { FRAME(); p_quant_x(F); } \
                END_PH(); \
            } \
            if (IN_PH()) { \
                FRAME(); \
                { pg8::Gemm g{(const bf16*)(F.ws + WS_XB), wptr(F, layer, WL_IN), M, NIN, wini8(layer) ? D / 2 : D}; pg8::StaticOrder S; S.init(M, NIN, F.G, F.vcu); \
                EpiWin E{F.R, ssptr(F, 3 * layer + 1), (const float*)(F.ws + WS_TAB + TAB_XS), wini8(layer) ? __uint_as_float(((const unsigned*)F.ctlf)[CW_WMAX + 1 + layer]) * (1.0f / 127.0f) : 1.0f, wini8(layer) ? 1 : 0}; \
                REPEAT(REP_WIN, pg8::gemm_phase<EpiWin, pg8::StaticOrder, true, GEMM_SP2, wini8(layer) ? 2 : 0>(glds, g, S, E)); } \
                if (CVM_WIN[layer] != 0u && F.vcu >= (F.G * 3) / 4) { \
                    KArgs kb = kargs(); Frame F2 = make_frame(kb->ws, kb->out, lds); \
                    ProIn I{kb->in[0], kb->in[1], kb->in[2], kb->in[3], kb->in[4], kb->in[5], kb->in[6], kb->in[7], kb->in[8], kb->in[11], kb->in[12], kb->in[18], kb->in[19], kb->in[20], kb->in[21], kb->in[22], kb->in[9], kb->in[10]}; \
                    convert_weights<CVM_WIN[layer]>(F2, I, (F2.vcu - (F2.G * 3) / 4) * NWAVES + F2.wave, (F2.G / 4) * NWAVES); \
                } \
            } \
            END_PH(); \
            if (IN_PH()) { FRAME(); REPEAT(REP_M1, REPEAT(REP_CMP, m_compress(F, layer)); REPEAT(REP_S1, m_ssd_s1(F, layer, INP(13), INP(14), INP(15), INP(16))); REPEAT(REP_SB, m_sb(F))); } \
            END_PH(); \
            if (IN_PH()) { FRAME(); REPEAT(REP_M2, REPEAT(REP_S2, m_ssd_s2(F)); REPEAT(REP_NSA, m_nsa(F))); } \
            END_PH(); \
            if (IN_PH()) { FRAME(); REPEAT(REP_M3, REPEAT(REP_S3, m_ssd_s3(F, layer, INP(17))); REPEAT(REP_N2, m_norms2(F))); } \
            END_PH(); \
             \
            if (IN_PH()) { \
                FRAME(); \
                pg8::Gemm g{(const bf16*)(F.R + R_MIXED), wptr(F, layer, WL_OUT), M, D, D}; pg8::StaticOrder S; S.init(M, D, F.G, F.vcu); \
                EpiResid E{F.out, F.out, (bf16*)(F.ws + WS_XB), ssptr(F, 3 * layer + 2), 1.0f, gu8(seg + 1) ? 1 : 0}; \
                pg8::gemm_phase<EpiResid, pg8::StaticOrder, true, GEMM_SP2>(glds, g, S, E); \
            } \
            END_PH(); \
        } \
     \
    } while (0)
__global__ void __launch_bounds__(NTHR, 2) mega_fwd(Args args) {
    extern __shared__ __attribute__((aligned(16))) unsigned char lds[];
    volatile LAS unsigned* MISC = (volatile LAS unsigned*)((LAS unsigned char*)lds + MISC_OFF);
    if (threadIdx.x < 64) MISC[threadIdx.x] = 0u;
    __syncthreads();
    if (MK_ONE_LAUNCH) (void)xcd_barrier_post((unsigned*)(args.ws + WS_CTL) + CW_BAR, MISC + 8);
    int pc = 0;
#define IN_PH() ({ KArgs _k = kargs(); (_k->ph_lo <= pc && pc < _k->ph_hi); })
#define END_PH() do { KArgs _k = kargs(); \
        if (MK_ONE_LAUNCH && pc + 1 < _k->ph_hi && pc >= _k->ph_lo) { XcdBarrier _b; _b.bar = (unsigned*)(_k->ws + WS_CTL) + CW_BAR; _b.x = xb_xcc_id(); _b.st = MISC + 8; xcd_barrier(_b); } \
        ++pc; } while (0)
#define FRAME() KArgs ka = kargs(); Frame F = make_frame(ka->ws, ka->out, lds)
#define INP(k) (ka->in[k])
    LAS unsigned char* glds = (LAS unsigned char*)lds;

    if (IN_PH()) { FRAME();
        ProIn I{INP(0), INP(1), INP(2), INP(3), INP(4), INP(5), INP(6), INP(7), INP(8), INP(11), INP(12), INP(18), INP(19), INP(20), INP(21), INP(22), INP(9), INP(10)};
        REPEAT(REP_PRO, REPEAT(REP_PA, p_prologue(F, I))); }
    END_PH();
    if (IN_PH()) { FRAME();
        ProIn I{INP(0), INP(1), INP(2), INP(3), INP(4), INP(5), INP(6), INP(7), INP(8), INP(11), INP(12), INP(18), INP(19), INP(20), INP(21), INP(22), INP(9), INP(10)};
        REPEAT(REP_PRO, REPEAT(REP_PB, p_prologue_b(F, I))); }
    END_PH();
    SEG_BODY(0); SEG_BODY(1); SEG_BODY(2); SEG_BODY(3);
    if (!FUSE_X) {
    if (IN_PH()) { FRAME(); p_final(F, INP(23)); }
    END_PH();
    }
#undef IN_PH
#undef END_PH
#undef FRAME
#undef INP
#undef SEG_BODY
}
constexpr int N_PHASES = 2 + 4 * 2 + 2 * 5 + (FUSE_X ? 0 : (wini8(0) ? 1 : 0) + (wini8(1) ? 1 : 0) + 1);

extern "C" void kernel_launch(void* const* d_in, const int* in_sizes, int n_in, void* d_out, int out_size, void* d_ws, size_t ws_size, hipStream_t stream) {
    static int grid = 0;
    if (grid == 0) {
        if (n_in != 24 || in_sizes[0] != M * D || out_size != M * D || ws_size < WS_END) {
            fprintf(stderr, "kernel_launch: shape/workspace mismatch: n_in %d in0 %d out %d ws %zu (need %zu); nothing launched\n", n_in, n_in > 0 ? in_sizes[0] : -1, out_size, ws_size, (size_t)WS_END);
            grid = -1; return; }
        int dev = 0, cus = 0, per_cu = 0;
        if (hipGetDevice(&dev) != hipSuccess || hipDeviceGetAttribute(&cus, hipDeviceAttributeMultiprocessorCount, dev) != hipSuccess) { grid = -1; return; }
        if (hipFuncSetAttribute((const void*)mega_fwd, hipFuncAttributeMaxDynamicSharedMemorySize, LDS_BYTES) != hipSuccess) { fprintf(stderr, "kernel_launch: hipFuncSetAttribute failed\n"); grid = -1; return; }
        if (hipOccupancyMaxActiveBlocksPerMultiprocessor(&per_cu, (const void*)mega_fwd, NTHR, LDS_BYTES) != hipSuccess || per_cu < 1) { fprintf(stderr, "kernel_launch: occupancy query reports %d\n", per_cu); }
        (void)hipGetLastError();
        if (FUSE_X && cus != 256) { fprintf(stderr, "kernel_launch: the fused down-GEMM epilogues need exactly 256 workgroups (one output tile each), this device has %d CUs; nothing launched\n", cus); grid = -1; return; }
        grid = cus;
    }
    if (grid < 0) return;
    (void)hipMemsetAsync((char*)d_ws + WS_CTL, 0, CTL_ZERO_BYTES, stream);
    Args a{};
    for (int i = 0; i < 24; ++i) a.in[i] = (const float*)d_in[i];
    a.out = (float*)d_out; a.ws = (unsigned char*)d_ws;
#if MK_ONE_LAUNCH
    a.ph_lo = 0; a.ph_hi = N_PHASES;
    hipLaunchKernelGGL(mega_fwd, dim3(grid), dim3(NTHR), LDS_BYTES, stream, a);
#else
    for (int p = 0; p < N_PHASES; ++p) { a.ph_lo = p; a.ph_hi = p + 1; hipLaunchKernelGGL(mega_fwd, dim3(grid), dim3(NTHR), LDS_BYTES, stream, a); }
#endif
}
```
